# Optimizing an MI355X kernel written in HIP

```python
import math
import jax, jax.numpy as jnp
from jax import lax
import numpy as np

D_MODEL = 1024
BATCH = 32
SEQ = 2048
DEPTH = 2

N_MIXERS = 2
N_META = 16
N_HEADS = 8
HEAD_DIM = 64
V_DIM = 2 * HEAD_DIM
QKV_DIM = 3 * N_HEADS * 2 * HEAD_DIM
ROPE_THETA = 10000.0
CONV_WIDTH = 3
D_FF = -(-8 * D_MODEL // (3 * 256)) * 256
Q_BLOCK = 128
EPS = 1e-6
N_ATTN_LAYERS = (DEPTH + 1) // 2
N_CONV_LAYERS = DEPTH // 2

kernel_name = "hybrid_diffattn_shortconv_meta"


def rms_norm(x, g):
    xf = x.astype(jnp.float32)
    y = xf * lax.rsqrt(jnp.mean(xf * xf, axis=-1, keepdims=True) + EPS)
    return (y * g.astype(jnp.float32)).astype(x.dtype)


def rope_tables(length):
    inv = 1.0 / (ROPE_THETA ** (jnp.arange(0, HEAD_DIM, 2, dtype=jnp.float32) / HEAD_DIM))
    pos = jnp.arange(length, dtype=jnp.float32)
    ang = pos[:, None] * inv[None, :]
    return jnp.cos(ang), jnp.sin(ang)


def apply_rope(x, cos, sin):
    xf = x.astype(jnp.float32)
    x1, x2 = jnp.split(xf, 2, axis=-1)
    out = jnp.concatenate([x1 * cos - x2 * sin, x2 * cos + x1 * sin], axis=-1)
    return out.astype(x.dtype)


def diff_attention(h, w_qkv, q_gain, k_gain, lam_q1, lam_k1, lam_q2, lam_k2,
                   sub_gain, w_o, lambda_init):
    b, length, _ = h.shape
    qkv = h @ w_qkv
    q, k, v = jnp.split(qkv, 3, axis=-1)
    q = q.reshape(b, length, N_HEADS, 2, HEAD_DIM).transpose(0, 2, 3, 1, 4)
    k = k.reshape(b, length, N_HEADS, 2, HEAD_DIM).transpose(0, 2, 3, 1, 4)
    v = v.reshape(b, length, N_HEADS, V_DIM).transpose(0, 2, 1, 3)
    cos, sin = rope_tables(length)
    q = apply_rope(rms_norm(q, q_gain), cos, sin) * (HEAD_DIM ** -0.5)
    k = apply_rope(rms_norm(k, k_gain), cos, sin)
    lam = (jnp.exp(jnp.sum(lam_q1.astype(jnp.float32) * lam_k1.astype(jnp.float32)))
           - jnp.exp(jnp.sum(lam_q2.astype(jnp.float32) * lam_k2.astype(jnp.float32)))
           + lambda_init)
    bounds = [(0, N_META)] + [(s, s + Q_BLOCK) for s in range(N_META, length, Q_BLOCK)]
    outs = []
    for qs, qe in bounds:
        qb = q[:, :, :, qs:qe]
        kb = k[:, :, :, :qe]
        vb = v[:, :, :qe]
        s = jnp.einsum('bhcqd,bhckd->bhcqk', qb, kb).astype(jnp.float32)
        mask = jnp.arange(qs, qe)[:, None] >= jnp.arange(qe)[None, :]
        s = jnp.where(mask, s, -jnp.inf)
        p = jax.nn.softmax(s, axis=-1)
        a = p[:, :, 0] - lam * p[:, :, 1]
        outs.append(jnp.einsum('bhqk,bhkd->bhqd', a.astype(vb.dtype), vb))
    o = jnp.concatenate(outs, axis=2)
    o = rms_norm(o, sub_gain) * (1.0 - lambda_init)
    o = o.transpose(0, 2, 1, 3).reshape(b, length, N_HEADS * V_DIM)
    return o @ w_o


def short_conv(h, w_in, conv_w, w_out):
    bcu = h @ w_in
    gate_b, gate_c, u = jnp.split(bcu, 3, axis=-1)
    z = gate_c * u
    zc = lax.conv_general_dilated(
        z, conv_w.astype(z.dtype), window_strides=(1,),
        padding=[(CONV_WIDTH - 1, 0)],
        dimension_numbers=('NWC', 'WIO', 'NWC'),
        feature_group_count=D_MODEL)
    return (gate_b * zc) @ w_out


def swiglu(h, w_gate_up, w_down):
    g, u = jnp.split(h @ w_gate_up, 2, axis=-1)
    return (jax.nn.silu(g) * u) @ w_down


def setup_inputs(seed: int = 0) -> dict:
    key = jax.random.key(seed)
    ks = jax.random.split(key, 20)
    f32 = jnp.float32
    nrm = lambda k, shape, scale: jax.random.normal(k, shape, f32) * scale
    gain = lambda k, shape: 1.0 + 0.02 * jax.random.normal(k, shape, f32)
    return {
        "x": nrm(ks[0], (BATCH, SEQ, D_MODEL), 1.0),
        "meta_tokens": nrm(ks[1], (N_META, D_MODEL), 1.0),
        "mixer_norm_g": gain(ks[2], (DEPTH, D_MODEL)),
        "ffn_norm_g": gain(ks[3], (DEPTH, D_MODEL)),
        "attn_w_qkv": nrm(ks[4], (N_ATTN_LAYERS, D_MODEL, QKV_DIM), D_MODEL ** -0.5),
        "attn_q_gain": gain(ks[5], (N_ATTN_LAYERS, HEAD_DIM)),
        "attn_k_gain": gain(ks[6], (N_ATTN_LAYERS, HEAD_DIM)),
        "attn_lambda_q1": nrm(ks[7], (N_ATTN_LAYERS, HEAD_DIM), 0.1),
        "attn_lambda_k1": nrm(ks[8], (N_ATTN_LAYERS, HEAD_DIM), 0.1),
        "attn_lambda_q2": nrm(ks[9], (N_ATTN_LAYERS, HEAD_DIM), 0.1),
        "attn_lambda_k2": nrm(ks[10], (N_ATTN_LAYERS, HEAD_DIM), 0.1),
        "attn_sub_gain": gain(ks[11], (N_ATTN_LAYERS, V_DIM)),
        "attn_w_o": nrm(ks[12], (N_ATTN_LAYERS, N_HEADS * V_DIM, D_MODEL), (N_HEADS * V_DIM) ** -0.5),
        "conv_w_in": nrm(ks[13], (N_CONV_LAYERS, D_MODEL, 3 * D_MODEL), D_MODEL ** -0.5),
        "conv_w": nrm(ks[14], (N_CONV_LAYERS, CONV_WIDTH, 1, D_MODEL), CONV_WIDTH ** -0.5),
        "conv_w_out": nrm(ks[15], (N_CONV_LAYERS, D_MODEL, D_MODEL), D_MODEL ** -0.5),
        "ffn_w_gate_up": nrm(ks[16], (DEPTH, D_MODEL, 2 * D_FF), D_MODEL ** -0.5),
        "ffn_w_down": nrm(ks[17], (DEPTH, D_FF, D_MODEL), D_FF ** -0.5),
    }


def reference(x, meta_tokens, mixer_norm_g, ffn_norm_g, attn_w_qkv, attn_q_gain,
              attn_k_gain, attn_lambda_q1, attn_lambda_k1, attn_lambda_q2,
              attn_lambda_k2, attn_sub_gain, attn_w_o, conv_w_in, conv_w,
              conv_w_out, ffn_w_gate_up, ffn_w_down):
    b = x.shape[0]
    meta = jnp.broadcast_to(meta_tokens.astype(x.dtype)[None], (b, N_META, D_MODEL))
    h = jnp.concatenate([meta, x], axis=1)
    for i in range(DEPTH):
        hn = rms_norm(h, mixer_norm_g[i])
        j = i // N_MIXERS
        if i % N_MIXERS == 0:
            lambda_init = 0.8 - 0.6 * math.exp(-0.3 * i)
            h = h + diff_attention(hn, attn_w_qkv[j], attn_q_gain[j], attn_k_gain[j],
                                   attn_lambda_q1[j], attn_lambda_k1[j],
                                   attn_lambda_q2[j], attn_lambda_k2[j],
                                   attn_sub_gain[j], attn_w_o[j], lambda_init)
        else:
            h = h + short_conv(hn, conv_w_in[j], conv_w[j], conv_w_out[j])
        h = h + swiglu(rms_norm(h, ffn_norm_g[i]), ffn_w_gate_up[i], ffn_w_down[i])
    return h[:, N_META:]
```

```cpp
#include <hip/hip_runtime.h>
#include <hip/hip_cooperative_groups.h>
#include <cstdio>
#include <cstdint>
namespace cg = cooperative_groups;
namespace pg8 {
#define PG8_LAS __attribute__((address_space(3)))
typedef unsigned short bf16_t;
typedef short bf16x8 __attribute__((ext_vector_type(8)));
typedef float f32x4 __attribute__((ext_vector_type(4)));
typedef unsigned u32x4 __attribute__((ext_vector_type(4)));
constexpr int BM = 256, BK = 64, HALF = 128, HTB = HALF * BK * 2  , STAGE_BYTES = 8 * HTB, NXCD = 8, WGM = 8;

__host__ __device__ __forceinline__ int lds_byte(int r, int c) { const int st = (r >> 4) * 2 + (c >> 5), rr = r & 15, cc = c & 31, ob = rr * 64 + cc * 2; return st * 1024 + (ob ^ (((ob >> 9) & 1) << 5)); }
__host__ __device__ __forceinline__ void stage_rc(int b, int& R, int& C) { const int st = b / 1024, sb = b % 1024, swz = sb ^ (((sb >> 9) & 1) << 5); R = (st >> 1) * 16 + swz / 64; C = (st & 1) * 32 + (swz % 64) / 2; }
__host__ __device__ __forceinline__ int perm32(int rho) { const int n = rho >> 4, i = rho & 15; return 8 * (i >> 2) + 4 * n + (i & 3); }

struct Unit { int pm, pn; };
struct Gemm { const bf16_t* A; const bf16_t* Bt; int M, N, K; };

struct StaticOrder {
    int nM, nN, nwg, G, c;
    __host__ __device__ void init(int M, int N, int G_, int c_) { nM = M / BM; nN = N / BM; nwg = nM * nN; G = G_; c = c_; }
    __host__ __device__ bool next(int i, Unit& u) const {
        const long L = (long)i * G + c; if (L >= nwg) return false;
        int wgid = (int)L; { const int q = nwg / NXCD, r = nwg % NXCD, xcd = wgid % NXCD, off = wgid / NXCD; wgid = (xcd < r ? xcd * (q + 1) : r * (q + 1) + (xcd - r) * q) + off; }
        const int nig = WGM * nN, gid = wgid / nig, fm = gid * WGM, gsz = (nM - fm) < WGM ? (nM - fm) : WGM;
        u.pm = fm + ((wgid % nig) % gsz); u.pn = (wgid % nig) / gsz; return true;
    }
    __device__ __forceinline__ void a_ready(const Unit&) const {}
    __device__ __forceinline__ void done(const Unit&) const {}
};
__device__ __forceinline__ unsigned cvt_pk_bf16(float lo, float hi) { unsigned r; asm volatile("v_cvt_pk_bf16_f32 %0, %1, %2" : "=v"(r) : "v"(lo), "v"(hi)); return r; }
typedef unsigned u32x2 __attribute__((ext_vector_type(2)));
__device__ __forceinline__ int lane_id_v() { int l; asm volatile("v_mbcnt_lo_u32_b32 %0, -1, 0\n\tv_mbcnt_hi_u32_b32 %0, -1, %0" : "=v"(l)); return l; }
constexpr int LP_ = 2112, PADF_ = 48, LTOK_ = 2064;
constexpr float QSCALE_ = 0.125f * 1.4426950408889634f;
__device__ __forceinline__ float row_rstd(const float* ssp, int row) {
    const f32x4* p = (const f32x4*)(ssp + (size_t)row * 16);
    const f32x4 a = p[0], b = p[1], c = p[2], d = p[3];
    const float s = (((a[0] + a[1]) + (a[2] + a[3])) + ((b[0] + b[1]) + (b[2] + b[3]))) + (((c[0] + c[1]) + (c[2] + c[3])) + ((d[0] + d[1]) + (d[2] + d[3])));
    return rsqrtf(s * (1.0f / 1024.0f) + 1e-6f);
}
__device__ __forceinline__ u32x4 pack8(const f32x4 v0, const f32x4 v1) { u32x4 w; w.x = cvt_pk_bf16(v0[0], v0[1]); w.y = cvt_pk_bf16(v0[2], v0[3]); w.z = cvt_pk_bf16(v1[0], v1[1]); w.w = cvt_pk_bf16(v1[2], v1[3]); return w; }

struct EpiQKV {
    static constexpr bool PERM = true, AFTER_DRAIN = false;
    bf16_t* QKV; const float* ssp; const float* rope; const float* qg; const float* kg;
    __device__ __forceinline__ void operator()(const f32x4 (&acc)[2][2][4][2], const Unit& u, int wr, int wc, int fr, int fq) const {
        const int row0 = u.pm * BM + wr * 64 + fr, pn = u.pn;
        const int colbase = pn * 256 + wc * 64 + 8 * fq;
        if (pn < 8) {
            const float* gp = (pn < 4) ? qg : kg; const float osc = (pn < 4) ? QSCALE_ : 1.0f;
            f32x4 g[2][2];
#pragma unroll
            for (int bj = 0; bj < 2; ++bj)
#pragma unroll
                for (int n = 0; n < 2; ++n) g[bj][n] = *(const f32x4*)(gp + 32 * bj + 8 * fq + 4 * n);
#pragma unroll
            for (int ai = 0; ai < 2; ++ai)
#pragma unroll
                for (int m = 0; m < 4; ++m) {
                    const int row = row0 + ai * HALF + m * 16; const float rs = row_rstd(ssp, row);
                    f32x4 v[2][2]; float ss = 0.f;
#pragma unroll
                    for (int bj = 0; bj < 2; ++bj)
#pragma unroll
                        for (int n = 0; n < 2; ++n) { v[bj][n] = acc[ai][bj][m][n] * rs; const f32x4 x = v[bj][n]; ss += (x[0] * x[0] + x[1] * x[1]) + (x[2] * x[2] + x[3] * x[3]); }
                    ss += __shfl_xor(ss, 16); ss += __shfl_xor(ss, 32);
                    const float rn = rsqrtf(ss * (1.0f / 64.0f) + 1e-6f);
#pragma unroll
                    for (int bj = 0; bj < 2; ++bj)
#pragma unroll
                        for (int n = 0; n < 2; ++n) v[bj][n] = v[bj][n] * rn * g[bj][n];
                    int pos = (row % LP_) - PADF_; pos = pos < 0 ? 0 : pos;
                    const f32x4* rp = (const f32x4*)(rope + ((size_t)pos * 32 + 8 * fq) * 2);
                    f32x4 o1[2], o2[2];
#pragma unroll
                    for (int n = 0; n < 2; ++n) { const f32x4 ca = rp[2 * n], cb = rp[2 * n + 1];
                        const f32x4 x1 = v[0][n], x2 = v[1][n];
                        o1[n][0] = (x1[0] * ca[0] - x2[0] * ca[1]) * osc; o2[n][0] = (x2[0] * ca[0] + x1[0] * ca[1]) * osc;
                        o1[n][1] = (x1[1] * ca[2] - x2[1] * ca[3]) * osc; o2[n][1] = (x2[1] * ca[2] + x1[1] * ca[3]) * osc;
                        o1[n][2] = (x1[2] * cb[0] - x2[2] * cb[1]) * osc; o2[n][2] = (x2[2] * cb[0] + x1[2] * cb[1]) * osc;
                        o1[n][3] = (x1[3] * cb[2] - x2[3] * cb[3]) * osc; o2[n][3] = (x2[3] * cb[2] + x1[3] * cb[3]) * osc; }
                    bf16_t* rowp = QKV + (size_t)row * 3072 + colbase;
                    *(u32x4*)(rowp) = pack8(o1[0], o1[1]); *(u32x4*)(rowp + 32) = pack8(o2[0], o2[1]);
                }
        } else {
#pragma unroll
            for (int ai = 0; ai < 2; ++ai)
#pragma unroll
                for (int m = 0; m < 4; ++m) {
                    const int row = row0 + ai * HALF + m * 16; const float rs = row_rstd(ssp, row);
                    bf16_t* rowp = QKV + (size_t)row * 3072 + colbase;
#pragma unroll
                    for (int bj = 0; bj < 2; ++bj) *(u32x4*)(rowp + 32 * bj) = pack8(acc[ai][bj][m][0] * rs, acc[ai][bj][m][1] * rs);
                }
        }
    }
};
struct EpiGateUp {
    static constexpr bool PERM = true, AFTER_DRAIN = false;
    bf16_t* HID; const float* ssp;
    __device__ __forceinline__ void operator()(const f32x4 (&acc)[2][2][4][2], const Unit& u, int wr, int wc, int fr, int fq) const {
        const int row0 = u.pm * BM + wr * 64 + fr; const int col = u.pn * 128 + wc * 32 + 8 * fq;
#pragma unroll
        for (int ai = 0; ai < 2; ++ai)
#pragma unroll
            for (int m = 0; m < 4; ++m) {
                const int row = row0 + ai * HALF + m * 16; const float rs = row_rstd(ssp, row);
                f32x4 hv[2];
#pragma unroll
                for (int n = 0; n < 2; ++n) { const f32x4 g = acc[ai][0][m][n] * rs, uu = acc[ai][1][m][n] * rs;
#pragma unroll
                    for (int e = 0; e < 4; ++e) { const float sg = __builtin_amdgcn_rcpf(1.0f + __expf(-g[e])); hv[n][e] = g[e] * sg * uu[e]; } }
                *(u32x4*)(HID + (size_t)row * 2816 + col) = pack8(hv[0], hv[1]);
            }
    }
};
struct EpiWin {
    static constexpr bool PERM = true, AFTER_DRAIN = false;
    bf16_t* Z; bf16_t* GB; const float* ssp;
    __device__ __forceinline__ void operator()(const f32x4 (&acc)[2][2][4][2], const Unit& u, int wr, int wc, int fr, int fq) const {
        const int row0 = u.pm * BM + wr * 64 + fr, pn = u.pn;
#pragma unroll
        for (int ai = 0; ai < 2; ++ai)
#pragma unroll
            for (int m = 0; m < 4; ++m) {
                const int row = row0 + ai * HALF + m * 16; const float rs = row_rstd(ssp, row);
                if (pn < 8) {
                    const float rs2 = rs * rs;
                    *(u32x4*)(Z + (size_t)row * 1024 + pn * 128 + wc * 32 + 8 * fq) = pack8(acc[ai][0][m][0] * acc[ai][1][m][0] * rs2, acc[ai][0][m][1] * acc[ai][1][m][1] * rs2);
                } else {
                    bf16_t* rowp = GB + (size_t)row * 1024 + (pn - 8) * 256 + wc * 32 + 8 * fq;
#pragma unroll
                    for (int bj = 0; bj < 2; ++bj) *(u32x4*)(rowp + 128 * bj) = pack8(acc[ai][bj][m][0] * rs, acc[ai][bj][m][1] * rs);
                }
            }
    }
};
template <bool FINAL> struct EpiRes {
    static constexpr bool PERM = true, AFTER_DRAIN = false;
    float* H; bf16_t* XB; float* ssp; float* out;
    __device__ __forceinline__ void operator()(const f32x4 (&acc)[2][2][4][2], const Unit& u, int wr, int wc, int fr, int fq) const {
        const int row0 = u.pm * BM + wr * 64 + fr; const int c0 = u.pn * 256 + wc * 32 + 8 * fq;
#pragma unroll
        for (int ai = 0; ai < 2; ++ai)
#pragma unroll
            for (int m = 0; m < 4; ++m) {
                const int row = row0 + ai * HALF + m * 16; float ss = 0.f;
                const float* hp = H + (size_t)row * 1024 + c0;
                f32x4 nv[2][2];
#pragma unroll
                for (int bj = 0; bj < 2; ++bj) { nv[bj][0] = *(const f32x4*)(hp + 128 * bj) + acc[ai][bj][m][0]; nv[bj][1] = *(const f32x4*)(hp + 128 * bj + 4) + acc[ai][bj][m][1]; }
                if (!FINAL) {
#pragma unroll
                    for (int bj = 0; bj < 2; ++bj) {
                        *(f32x4*)(H + (size_t)row * 1024 + c0 + 128 * bj) = nv[bj][0]; *(f32x4*)(H + (size_t)row * 1024 + c0 + 128 * bj + 4) = nv[bj][1];
                        *(u32x4*)(XB + (size_t)row * 1024 + c0 + 128 * bj) = pack8(nv[bj][0], nv[bj][1]);
#pragma unroll
                        for (int n = 0; n < 2; ++n) { const f32x4 x = nv[bj][n]; ss += (x[0] * x[0] + x[1] * x[1]) + (x[2] * x[2] + x[3] * x[3]); }
                    }
                    ss += __shfl_xor(ss, 16); ss += __shfl_xor(ss, 32);
                    if (fq == 0) ssp[(size_t)row * 16 + 4 * u.pn + wc] = ss;
                } else {
                    const int b = row / LP_, p = row - b * LP_;
                    if (p >= 64) { float* op = out + ((size_t)b * 2048 + (p - 64)) * 1024 + c0;
#pragma unroll
                        for (int bj = 0; bj < 2; ++bj) { *(f32x4*)(op + 128 * bj) = nv[bj][0]; *(f32x4*)(op + 128 * bj + 4) = nv[bj][1]; } }
                }
            }
    }
};
template <class Epi, class Sched, bool ALIGN_EPI = false, bool SP2 = false>
__device__ __forceinline__ void gemm_phase(PG8_LAS unsigned char* lds, const Gemm g, const Sched& S, const Epi& E, const int wid) {
    const int lane = lane_id_v(), tid = wid * 64 + lane, wr = wid >> 2, wc = wid & 3, fr = lane & 15, fq = lane >> 4;
    const int K = g.K, nt = K / BK;
    unsigned voffA[2], voffB[2];
#pragma unroll
    for (int i = 0; i < 2; ++i) { int R, C; stage_rc(tid * 16 + i * 8192, R, C); const int Rb = Epi::PERM ? ((R & ~31) + perm32(R & 31)) : R;
        voffA[i] = (unsigned)(R * K + C) * 2u; voffB[i] = (unsigned)(Rb * K + C) * 2u; }
    const size_t kstep = (size_t)(BK * 2);
    const size_t hstep = (size_t)HALF * K * 2;
    const size_t tstep = 2 * hstep;
    const unsigned ldsw = (unsigned)wid * 1024u;
    const int aoff = lds_byte(wr * 64 + fr, fq * 8), boff = lds_byte(wc * 32 + fr, fq * 8);
#define PG8_SA(b, h) (((b) * 2 + (h)) * HTB)
#define PG8_SB(b, h) ((4 + (b) * 2 + (h)) * HTB)
#define PG8_STAGE(bufoff, gbase, voff) do { _Pragma("unroll") for (int _i = 0; _i < 2; ++_i) \
        __builtin_amdgcn_global_load_lds((const unsigned*)((const char*)(gbase) + (voff)[_i]), (PG8_LAS unsigned*)(lds + (bufoff) + ldsw + _i * 8192), 16, 0, 0); } while (0)
#define PG8_LDA(dst, b, h) do { _Pragma("unroll") for (int m = 0; m < 4; ++m) _Pragma("unroll") for (int k = 0; k < 2; ++k) dst[m][k] = *(const PG8_LAS bf16x8*)(lds + PG8_SA(b, h) + aoff + m * 2048 + k * 1024); } while (0)
#define PG8_LDB(dst, b, h) do { _Pragma("unroll") for (int n = 0; n < 2; ++n) _Pragma("unroll") for (int k = 0; k < 2; ++k) dst[n][k] = *(const PG8_LAS bf16x8*)(lds + PG8_SB(b, h) + boff + n * 2048 + k * 1024); } while (0)
#define PG8_MMA(ai, bj, At, Bt) do { __builtin_amdgcn_s_setprio(1); _Pragma("unroll") for (int m = 0; m < 4; ++m) _Pragma("unroll") for (int n = 0; n < 2; ++n) _Pragma("unroll") for (int k = 0; k < 2; ++k) \
        acc[ai][bj][m][n] = __builtin_amdgcn_mfma_f32_16x16x32_bf16(Bt[n][k], At[m][k], acc[ai][bj][m][n], 0, 0, 0); __builtin_amdgcn_s_setprio(0); } while (0)
#define PG8_WAIT_V(n) asm volatile("s_waitcnt vmcnt(" #n ")" ::: "memory")
#define PG8_WAIT_L(n) asm volatile("s_waitcnt lgkmcnt(" #n ")" ::: "memory")
#define PG8_BAR __builtin_amdgcn_s_barrier()
#define PG8_SCHED __builtin_amdgcn_sched_barrier(0)
    Unit cur, nxt; int ui = 0;
    if (!S.next(0, cur)) return;
    f32x4 acc[2][2][4][2];
#pragma unroll
    for (int a = 0; a < 2; ++a)
#pragma unroll
        for (int b = 0; b < 2; ++b)
#pragma unroll
            for (int m = 0; m < 4; ++m)
#pragma unroll
                for (int n = 0; n < 2; ++n) acc[a][b][m][n] = (f32x4){0.f, 0.f, 0.f, 0.f};
    bf16x8 At[4][2], B0[2][2], B1[2][2];
    const char* cA = (const char*)g.A + (size_t)cur.pm * tstep; const char* cB = (const char*)g.Bt + (size_t)cur.pn * tstep;
    S.a_ready(cur);
    if constexpr (SP2) {
        PG8_STAGE(PG8_SB(0, 0), cB, voffB); PG8_STAGE(PG8_SB(0, 1), cB + hstep, voffB); PG8_STAGE(PG8_SA(0, 0), cA, voffA); PG8_STAGE(PG8_SA(0, 1), cA + hstep, voffA);
        if (wr == 1) PG8_BAR;
        PG8_WAIT_V(2); PG8_BAR;
        PG8_STAGE(PG8_SB(1, 0), cB + kstep, voffB); PG8_STAGE(PG8_SA(1, 0), cA + kstep, voffA); PG8_STAGE(PG8_SB(1, 1), cB + hstep + kstep, voffB);
        PG8_WAIT_V(6); PG8_BAR;
    } else {
        PG8_STAGE(PG8_SB(0, 0), cB, voffB); PG8_STAGE(PG8_SA(0, 0), cA, voffA); PG8_STAGE(PG8_SB(0, 1), cB + hstep, voffB); PG8_STAGE(PG8_SA(0, 1), cA + hstep, voffA);
        if (wr == 1) PG8_BAR;
        PG8_WAIT_V(4); PG8_BAR;
        PG8_STAGE(PG8_SB(1, 0), cB + kstep, voffB); PG8_STAGE(PG8_SA(1, 0), cA + kstep, voffA); PG8_STAGE(PG8_SB(1, 1), cB + hstep + kstep, voffB);
        PG8_WAIT_V(6); PG8_BAR;
    }
    for (;;) {
        const bool has_next = S.next(ui + 1, nxt);
        const char* nA = has_next ? (const char*)g.A + (size_t)nxt.pm * tstep : cA; const char* nB = has_next ? (const char*)g.Bt + (size_t)nxt.pn * tstep : cB;
        for (int t = 0; t < nt; t += 2) {
            const bool last = (t == nt - 2);
            const char* a1 = cA + (size_t)(t + 1) * kstep;
            const char* a2 = last ? nA : cA + (size_t)(t + 2) * kstep; const char* b2 = last ? nB : cB + (size_t)(t + 2) * kstep;
            const char* a3 = a2 + kstep; const char* b3 = b2 + kstep;
            if (last && has_next) S.a_ready(nxt);
            if constexpr (SP2) {
            PG8_LDB(B0, 0, 0); PG8_LDB(B1, 0, 1); PG8_SCHED; PG8_LDA(At, 0, 0); PG8_STAGE(PG8_SA(1, 1), a1 + hstep, voffA);
            PG8_WAIT_V(8); PG8_WAIT_L(0); PG8_BAR; PG8_MMA(0, 0, At, B0); PG8_MMA(0, 1, At, B1); PG8_BAR; PG8_SCHED;
            PG8_LDA(At, 0, 1); PG8_STAGE(PG8_SB(0, 0), b2, voffB); PG8_STAGE(PG8_SB(0, 1), b2 + hstep, voffB); PG8_STAGE(PG8_SA(0, 0), a2, voffA);
            PG8_WAIT_V(8); PG8_WAIT_L(0); PG8_BAR; PG8_MMA(1, 0, At, B0); PG8_MMA(1, 1, At, B1); PG8_BAR; PG8_SCHED;
            PG8_LDB(B0, 1, 0); PG8_LDB(B1, 1, 1); PG8_SCHED; PG8_LDA(At, 1, 0); PG8_STAGE(PG8_SA(0, 1), a2 + hstep, voffA);
            PG8_WAIT_V(8); PG8_WAIT_L(0); PG8_BAR; PG8_MMA(0, 0, At, B0); PG8_MMA(0, 1, At, B1); PG8_BAR; PG8_SCHED;
            PG8_LDA(At, 1, 1); PG8_STAGE(PG8_SB(1, 0), b3, voffB); PG8_STAGE(PG8_SB(1, 1), b3 + hstep, voffB); PG8_STAGE(PG8_SA(1, 0), a3, voffA);
            PG8_WAIT_V(8); PG8_WAIT_L(0); PG8_BAR; PG8_MMA(1, 0, At, B0); PG8_MMA(1, 1, At, B1); PG8_BAR; PG8_SCHED;
            } else {
            PG8_LDB(B0, 0, 0); PG8_SCHED; PG8_LDA(At, 0, 0); PG8_STAGE(PG8_SA(1, 1), a1 + hstep, voffA);
            PG8_WAIT_L(8); PG8_BAR; PG8_WAIT_L(0); PG8_MMA(0, 0, At, B0); PG8_BAR; PG8_SCHED;
            PG8_LDB(B1, 0, 1); PG8_STAGE(PG8_SB(0, 0), b2, voffB);
            PG8_BAR; PG8_WAIT_L(0); PG8_MMA(0, 1, At, B1); PG8_BAR;
            PG8_LDA(At, 0, 1); PG8_STAGE(PG8_SA(0, 0), a2, voffA);
            PG8_BAR; PG8_WAIT_L(0); PG8_MMA(1, 0, At, B0); PG8_BAR; PG8_SCHED;
            PG8_STAGE(PG8_SB(0, 1), b2 + hstep, voffB);
            PG8_WAIT_V(6); PG8_BAR; PG8_MMA(1, 1, At, B1); PG8_BAR;
            PG8_LDB(B0, 1, 0); PG8_SCHED; PG8_LDA(At, 1, 0); PG8_STAGE(PG8_SA(0, 1), a2 + hstep, voffA);
            PG8_WAIT_L(8); PG8_BAR; PG8_WAIT_L(0); PG8_MMA(0, 0, At, B0); PG8_BAR; PG8_SCHED;
            PG8_LDB(B1, 1, 1); PG8_STAGE(PG8_SB(1, 0), b3, voffB);
            PG8_BAR; PG8_WAIT_L(0); PG8_MMA(0, 1, At, B1); PG8_BAR;
            PG8_LDA(At, 1, 1); PG8_STAGE(PG8_SA(1, 0), a3, voffA);
            PG8_BAR; PG8_WAIT_L(0); PG8_MMA(1, 0, At, B0); PG8_BAR; PG8_SCHED;
            PG8_STAGE(PG8_SB(1, 1), b3 + hstep, voffB);
            PG8_WAIT_V(6); PG8_BAR; PG8_MMA(1, 1, At, B1); PG8_BAR;
            }
        }
        if constexpr (ALIGN_EPI) { if (wr == 0) PG8_BAR; }
        if constexpr (!Epi::AFTER_DRAIN) { E(acc, cur, wr, wc, fr, fq); S.done(cur); }
        if (!has_next) break;
#pragma unroll
        for (int a = 0; a < 2; ++a)
#pragma unroll
            for (int b = 0; b < 2; ++b)
#pragma unroll
                for (int m = 0; m < 4; ++m)
#pragma unroll
                    for (int n = 0; n < 2; ++n) acc[a][b][m][n] = (f32x4){0.f, 0.f, 0.f, 0.f};
        cur = nxt; cA = nA; cB = nB; ++ui;
        if constexpr (ALIGN_EPI) { if (wr == 1) PG8_BAR; }
    }
    PG8_WAIT_V(0);
    if constexpr (!ALIGN_EPI) { if (wr == 0) PG8_BAR; }
    PG8_BAR;
    if constexpr (Epi::AFTER_DRAIN) { E.fused(acc, cur, wr, wc, fr, fq, lds, wid, lane); S.done(cur); }
#undef PG8_SA
#undef PG8_SB
#undef PG8_STAGE
#undef PG8_LDA
#undef PG8_LDB
#undef PG8_MMA
#undef PG8_WAIT_V
#undef PG8_WAIT_L
#undef PG8_BAR
#undef PG8_SCHED
}
}
namespace att {
#define LAS __attribute__((address_space(3)))
typedef unsigned short bf16_t;
typedef short bf16x8 __attribute__((ext_vector_type(8)));
typedef short s16x4 __attribute__((ext_vector_type(4)));
typedef float f32x16 __attribute__((ext_vector_type(16)));
typedef float f32x4 __attribute__((ext_vector_type(4)));
typedef unsigned u32x4 __attribute__((ext_vector_type(4)));
constexpr int LP = 2112, PADF = 48, PITCH = 3072;
constexpr int KV_BUF = 32768, V_OFF = 16384, OST_OFF = 65536, OST_PITCH = 272, OST_WAVE = 32 * OST_PITCH, WSF_OFF = OST_OFF + 8 * OST_WAVE, ATT_LDS = WSF_OFF + 8 * 256;
__device__ __forceinline__ int crow(int r, int hi) { return (r & 3) + 8 * (r >> 2) + 4 * hi; }
__device__ __forceinline__ unsigned cvtpk(float lo, float hi) { unsigned r; asm volatile("v_cvt_pk_bf16_f32 %0, %1, %2" : "=v"(r) : "v"(lo), "v"(hi)); return r; }
__device__ __forceinline__ s16x4 vtr(const LAS unsigned char* p) { return __builtin_bit_cast(s16x4, __builtin_amdgcn_ds_read_tr16_b64_v4i16((LAS s16x4*)p)); }

__device__ __forceinline__ void stage_tile(LAS unsigned char* lds, int bufoff, const bf16_t* QKV, long rowbase, int h, int t, int wid, int lane) {
#pragma unroll
    for (int i = 0; i < 2; ++i) {
        const int ci = 2 * wid + i;
        const bf16_t* ks = QKV + (size_t)(rowbase + 64 * t + lane) * PITCH + 1024 + h * 128 + ci * 8;
        __builtin_amdgcn_global_load_lds((const unsigned*)ks, (LAS unsigned*)(lds + bufoff + ci * 1024), 16, 0, 0);
    }
#pragma unroll
    for (int i = 0; i < 2; ++i) {
        const int pi = 2 * wid + i, db = pi >> 2, kg = pi & 3;
        const bf16_t* vs = QKV + (size_t)(rowbase + 64 * t + 16 * kg + (lane >> 2)) * PITCH + 2048 + h * 128 + db * 32 + (lane & 3) * 8;
        __builtin_amdgcn_global_load_lds((const unsigned*)vs, (LAS unsigned*)(lds + bufoff + V_OFF + pi * 1024), 16, 0, 0);
    }
}

__device__ __forceinline__ void attn_unit(LAS unsigned char* lds, const bf16_t* QKV, bf16_t* O, int b, int h, int q0, int nqw, float lam, const float* subg, const int wid) {
    const int lane = pg8::lane_id_v(), r32 = lane & 31, hi = lane >> 5;
    const long rowbase = (long)b * LP;
    const int NT = (q0 + 32 * nqw) >> 6;
    const bool active = wid < nqw;
    const int qabs = q0 + 32 * wid + r32, qfirst = q0 + 32 * wid, qlast = qfirst + 31;
    LAS unsigned char* qw = lds + OST_OFF + wid * OST_WAVE + lane * 16;
    {
        const bf16_t* qp = QKV + (size_t)(rowbase + (active ? qabs : 0)) * PITCH + h * 128 + hi * 8;
#pragma unroll
        for (int j = 0; j < 8; ++j) *(LAS bf16x8*)(qw + j * 1024) = *(const bf16x8*)(qp + (j >> 2) * 64 + (j & 3) * 16);
    }
    f32x16 o[2][4];
#pragma unroll
    for (int c = 0; c < 2; ++c)
#pragma unroll
        for (int db = 0; db < 4; ++db)
#pragma unroll
            for (int r = 0; r < 16; ++r) o[c][db][r] = 0.f;
    float lsum[2] = {0.f, 0.f};
    stage_tile(lds, 0, QKV, rowbase, h, 0, wid, lane);
    for (int t = 0; t < NT; ++t) {
        __syncthreads();
        const int buf = (t & 1) * KV_BUF;
        if (t + 1 < NT) stage_tile(lds, ((t + 1) & 1) * KV_BUF, QKV, rowbase, h, t + 1, wid, lane);
        if (active && 64 * t <= qlast) {
            const bool needmask = (t == 0) || (64 * t + 63 > qfirst);
            const LAS unsigned char* kb = lds + buf + hi * 1024 + r32 * 16;
            const LAS unsigned char* vp = lds + buf + V_OFF + ((lane >> 4) & 1) * 32 + (lane & 3) * 8 + (4 * hi + ((lane & 15) >> 2)) * 64;
            int mhi = qabs - 64 * t - 4 * hi, mlo = PADF - 64 * t - 4 * hi;
            asm volatile("" : "+v"(mhi), "+v"(mlo));
#pragma unroll
            for (int c = 0; c < 2; ++c) {
                f32x16 p0, p1;
#pragma unroll
                for (int r = 0; r < 16; ++r) { p0[r] = 0.f; p1[r] = 0.f; }
#pragma unroll
                for (int d0 = 0; d0 < 4; ++d0) {
                    const bf16x8 k0 = *(const LAS bf16x8*)(kb + (c * 8 + 2 * d0) * 1024);
                    const bf16x8 k1 = *(const LAS bf16x8*)(kb + (c * 8 + 2 * d0) * 1024 + 512);
                    const bf16x8 qv = *(const LAS bf16x8*)(qw + (c * 4 + d0) * 1024);
                    p0 = __builtin_amdgcn_mfma_f32_32x32x16_bf16(k0, qv, p0, 0, 0, 0);
                    p1 = __builtin_amdgcn_mfma_f32_32x32x16_bf16(k1, qv, p1, 0, 0, 0);
                    if (d0 == 1) __builtin_amdgcn_sched_barrier(0);
                }
#pragma unroll
                for (int r = 0; r < 16; ++r) { p0[r] = __builtin_amdgcn_exp2f(p0[r]); p1[r] = __builtin_amdgcn_exp2f(p1[r]); }
                if (needmask) {
#pragma unroll
                    for (int r = 0; r < 16; ++r) { const int cr = (r & 3) + 8 * (r >> 2);
                        if (cr > mhi) p0[r] = 0.f;
                        if (cr + 32 > mhi) p1[r] = 0.f; }
                    if (t == 0) {
#pragma unroll
                        for (int r = 0; r < 16; ++r) { const int cr = (r & 3) + 8 * (r >> 2);
                            if (cr < mlo) p0[r] = 0.f;
                            if (cr + 32 < mlo) p1[r] = 0.f; }
                    }
                }
                float s = 0.f;
#pragma unroll
                for (int r = 0; r < 16; ++r) s += p0[r] + p1[r];
                lsum[c] += s;
                u32x4 pw[4];
                pw[0] = (u32x4){cvtpk(p0[0], p0[1]), cvtpk(p0[2], p0[3]), cvtpk(p0[4], p0[5]), cvtpk(p0[6], p0[7])};
                pw[1] = (u32x4){cvtpk(p0[8], p0[9]), cvtpk(p0[10], p0[11]), cvtpk(p0[12], p0[13]), cvtpk(p0[14], p0[15])};
                pw[2] = (u32x4){cvtpk(p1[0], p1[1]), cvtpk(p1[2], p1[3]), cvtpk(p1[4], p1[5]), cvtpk(p1[6], p1[7])};
                pw[3] = (u32x4){cvtpk(p1[8], p1[9]), cvtpk(p1[10], p1[11]), cvtpk(p1[12], p1[13]), cvtpk(p1[14], p1[15])};
                __builtin_amdgcn_sched_barrier(0);
#pragma unroll
                for (int db = 0; db < 4; ++db) {
#pragma unroll
                    for (int ks = 0; ks < 4; ++ks) {
                        const s16x4 lo = vtr(vp + db * 4096 + ks * 1024), hh = vtr(vp + db * 4096 + ks * 1024 + 512);
                        const bf16x8 vf = (bf16x8){lo[0], lo[1], lo[2], lo[3], hh[0], hh[1], hh[2], hh[3]};
                        o[c][db] = __builtin_amdgcn_mfma_f32_32x32x16_bf16(__builtin_bit_cast(bf16x8, pw[ks]), vf, o[c][db], 0, 0, 0);
                    }
                    __builtin_amdgcn_sched_barrier(0);
                }
            }
        }
    }
    if (active) {
        float l0 = lsum[0], l1 = lsum[1];
        l0 += __shfl_xor(l0, 32); l1 += __shfl_xor(l1, 32);
        LAS float* wsf = (LAS float*)(lds + WSF_OFF) + wid * 64;
        if (hi == 0) { wsf[r32] = l0; wsf[32 + r32] = l1; }
        asm volatile("s_waitcnt lgkmcnt(0)" ::: "memory");
#pragma unroll
        for (int r = 0; r < 16; ++r) { const float a0 = wsf[crow(r, hi)], a1 = wsf[32 + crow(r, hi)];
            const float rl0 = a0 > 0.f ? 1.0f / a0 : 0.f, rl1 = a1 > 0.f ? lam / a1 : 0.f; float s = 0.f;
#pragma unroll
            for (int db = 0; db < 4; ++db) { const float v = o[0][db][r] * rl0 - o[1][db][r] * rl1; o[0][db][r] = v; s += v * v; }
            s += __shfl_xor(s, 1); s += __shfl_xor(s, 2); s += __shfl_xor(s, 4); s += __shfl_xor(s, 8); s += __shfl_xor(s, 16);
            const float rn = rsqrtf(s * (1.0f / 128.0f) + 1e-6f) * 0.8f;
#pragma unroll
            for (int db = 0; db < 4; ++db) o[0][db][r] *= rn; }
        LAS unsigned short* stg = (LAS unsigned short*)(lds + OST_OFF + wid * OST_WAVE);
#pragma unroll
        for (int db = 0; db < 4; ++db) { const float sg = subg[db * 32 + r32];
#pragma unroll
            for (int r = 0; r < 16; ++r) { const unsigned w = cvtpk(o[0][db][r] * sg, 0.f); stg[crow(r, hi) * (OST_PITCH / 2) + db * 32 + r32] = (unsigned short)(w & 0xffffu); } }
        asm volatile("s_waitcnt lgkmcnt(0)" ::: "memory");
        int lsel = lane; asm volatile("" : "+v"(lsel));
        bf16_t* Ow = O + (size_t)(rowbase + qfirst + (lsel >> 4)) * 1024 + h * 128 + (lsel & 15) * 8;
        const LAS unsigned char* sp = (const LAS unsigned char*)stg + (lsel >> 4) * OST_PITCH + (lsel & 15) * 16;
#pragma unroll
        for (int it = 0; it < 8; ++it) { const u32x4 v = *(const LAS u32x4*)(sp + it * 4 * OST_PITCH); *(u32x4*)Ow = v; Ow += 4 * 1024; asm volatile("" : "+v"(Ow)); }
    }
    __syncthreads();
}
}
typedef unsigned short bf16;
typedef unsigned v4u __attribute__((ext_vector_type(4)));
typedef float f32x4 __attribute__((ext_vector_type(4)));
constexpr int NWAVES = 8;
#ifndef MK_PER_PHASE
#define MK_PER_PHASE 0
#endif
constexpr int NPHASE = 11;
constexpr int D = 1024, NB = 32, SEQ = 2048, LTOK = 2064, PADF = 48, LP = 2112, MP = NB * LP;
constexpr int NQKV = 3072, DFF = 2816, NGU = 5632;
constexpr size_t al256(size_t x) { return (x + 255) & ~(size_t)255; }
constexpr size_t WS_WQKV = 0;
constexpr size_t WS_WO   = WS_WQKV + (size_t)NQKV * D * 2;
constexpr size_t WS_WGU0 = WS_WO + (size_t)D * D * 2;
constexpr size_t WS_WD0  = WS_WGU0 + (size_t)NGU * D * 2;
constexpr size_t WS_WIN  = WS_WD0 + (size_t)D * DFF * 2;
constexpr size_t WS_WOUT = WS_WIN + (size_t)NQKV * D * 2;
constexpr size_t WS_WGU1 = WS_WOUT + (size_t)D * D * 2;
constexpr size_t WS_WD1  = WS_WGU1 + (size_t)NGU * D * 2;
constexpr size_t WS_ROPE = WS_WD1 + (size_t)D * DFF * 2;
constexpr size_t WS_SSP  = WS_ROPE + al256((size_t)LTOK * 32 * 2 * 4);
constexpr size_t WS_H    = WS_SSP + (size_t)MP * 16 * 4;
constexpr size_t WS_XB   = WS_H + (size_t)MP * D * 4;
constexpr size_t WS_BIG  = WS_XB + (size_t)MP * D * 2;
constexpr size_t WS_O    = WS_BIG + (size_t)MP * NQKV * 2;
constexpr size_t WS_END  = WS_O + (size_t)MP * D * 2;
constexpr int LDS_BYTES = 147456;
static_assert(att::ATT_LDS <= LDS_BYTES && pg8::STAGE_BYTES <= LDS_BYTES, "LDS map");

__device__ __forceinline__ unsigned f2bf(float f) { unsigned u = __builtin_bit_cast(unsigned, f); return (u + 0x7fffu + ((u >> 16) & 1u)) >> 16; }
__device__ __forceinline__ unsigned pk2(float lo, float hi) { return f2bf(lo) | (f2bf(hi) << 16); }
__device__ __forceinline__ float wave_sum(float v) {
#pragma unroll
    for (int o = 1; o < 64; o <<= 1) v += __shfl_xor(v, o);
    return v;
}
__device__ __forceinline__ float wave_max(float v) {
#pragma unroll
    for (int o = 1; o < 64; o <<= 1) v = fmaxf(v, __shfl_xor(v, o));
    return v;
}
__device__ __forceinline__ int col_perm(int mode, int n) {
    if (mode == 1) return (n & ~255) + 128 * ((n >> 5) & 1) + 32 * ((n >> 6) & 3) + (n & 31);
    if (mode == 2) { const int up = n >= DFF ? 1 : 0, j = n - up * DFF; return 256 * (j >> 7) + 128 * up + (j & 127); }
    if (mode == 3) { if (n < 1024) return 2048 + n; const int up = n >= 2048 ? 1 : 0, j = (n - 1024) & 1023; return 256 * (j >> 7) + 128 * up + (j & 127); }
    return n;
}
__device__ __forceinline__ void transpose_item(const float* W, int K, int N, bf16* WT, const float* gain, int mode, LAS float* scr, int item, int lane) {
    const int nblk = N / 32, kb = item / nblk, nb = item % nblk, k0 = 64 * kb, n0 = 32 * nb;
#pragma unroll 8
    for (int i = 0; i < 32; ++i) { const int kk = 2 * i + (lane >> 5); scr[kk * 33 + (lane & 31)] = W[(size_t)(k0 + kk) * N + n0 + (lane & 31)]; }
    asm volatile("s_waitcnt lgkmcnt(0)" ::: "memory");
    const int c = lane & 7;
    float gv[8];
#pragma unroll
    for (int e = 0; e < 8; ++e) gv[e] = gain ? gain[k0 + 8 * c + e] : 1.0f;
#pragma unroll
    for (int j = 0; j < 4; ++j) { const int n = (lane >> 3) + 8 * j; const LAS float* s = scr + (8 * c) * 33 + n;
        v4u o; o.x = pk2(s[0 * 33] * gv[0], s[1 * 33] * gv[1]); o.y = pk2(s[2 * 33] * gv[2], s[3 * 33] * gv[3]); o.z = pk2(s[4 * 33] * gv[4], s[5 * 33] * gv[5]); o.w = pk2(s[6 * 33] * gv[6], s[7 * 33] * gv[7]);
        *(v4u*)(WT + (size_t)col_perm(mode, n0 + n) * K + k0 + 8 * c) = o; }
    asm volatile("s_waitcnt lgkmcnt(0)" ::: "memory");
}
__device__ __forceinline__ void sincos_acc(float angf, float& c, float& s) {
    const double TWO_PI = 6.283185307179586476925286766559;
    double a = (double)angf; const double n = rint(a / TWO_PI); double r = a - n * TWO_PI;
    const double r2 = r * r; double cs = 1.0, sn = r, tc = 1.0, ts = r;
#pragma unroll 1
    for (int k = 1; k <= 14; ++k) { tc = -tc * r2 / (double)((2 * k - 1) * (2 * k)); ts = -ts * r2 / (double)((2 * k) * (2 * k + 1)); cs += tc; sn += ts; }
    c = (float)cs; s = (float)sn;
}

struct Args { const float* in[18]; float* out; unsigned char* ws; int ph_lo, ph_hi; };

__device__ __forceinline__ void prologue(const Args& a, LAS unsigned char* lds, int wave, int lane, int gw, int NGW) {
    unsigned char* ws = a.ws;
    LAS float* scr = (LAS float*)(lds + wave * 16384);
    const float* mix_g = a.in[2]; const float* ffn_g = a.in[3];
    constexpr int I_QKV = (D / 64) * (NQKV / 32), I_O = (D / 64) * (D / 32), I_GU = (D / 64) * (NGU / 32), I_DN = (DFF / 64) * (D / 32);
    constexpr int NITEMS = 2 * I_QKV + 2 * I_O + 2 * I_GU + 2 * I_DN;
    for (int it = gw; it < NITEMS; it += NGW) {
        int r = it;
        if (r < I_QKV) { transpose_item(a.in[4], D, NQKV, (bf16*)(ws + WS_WQKV), mix_g, 1, scr, r, lane); continue; } r -= I_QKV;
        if (r < I_O)   { transpose_item(a.in[12], D, D, (bf16*)(ws + WS_WO), nullptr, 0, scr, r, lane); continue; } r -= I_O;
        if (r < I_GU)  { transpose_item(a.in[16], D, NGU, (bf16*)(ws + WS_WGU0), ffn_g, 2, scr, r, lane); continue; } r -= I_GU;
        if (r < I_DN)  { transpose_item(a.in[17], DFF, D, (bf16*)(ws + WS_WD0), nullptr, 0, scr, r, lane); continue; } r -= I_DN;
        if (r < I_QKV) { transpose_item(a.in[13], D, NQKV, (bf16*)(ws + WS_WIN), mix_g + D, 3, scr, r, lane); continue; } r -= I_QKV;
        if (r < I_O)   { transpose_item(a.in[15], D, D, (bf16*)(ws + WS_WOUT), nullptr, 0, scr, r, lane); continue; } r -= I_O;
        if (r < I_GU)  { transpose_item(a.in[16] + (size_t)D * NGU, D, NGU, (bf16*)(ws + WS_WGU1), ffn_g + D, 2, scr, r, lane); continue; } r -= I_GU;
        transpose_item(a.in[17] + (size_t)DFF * D, DFF, D, (bf16*)(ws + WS_WD1), nullptr, 0, scr, r, lane);
    }
    { float* rope = (float*)(ws + WS_ROPE);
      for (int e = gw * 64 + lane; e < LTOK * 32; e += NGW * 64) { const int pos = e >> 5, i = e & 31;
          const float inv = (float)exp(-9.210340371976184 * (double)(2 * i) / 64.0);
          const float ang = (float)pos * inv; float c, s; sincos_acc(ang, c, s); rope[2 * e] = c; rope[2 * e + 1] = s; } }
    { const float* x = a.in[0]; const float* meta = a.in[1]; float* H = (float*)(ws + WS_H); bf16* XB = (bf16*)(ws + WS_XB); float* ssp = (float*)(ws + WS_SSP);
      for (int m = gw; m < MP; m += NGW) { const int b = m / LP, p = m - b * LP;
          const float* src = p < PADF ? nullptr : (p < 64 ? meta + (size_t)(p - PADF) * D : x + ((size_t)b * SEQ + (p - 64)) * D);
          f32x4 v[4]; float s = 0.f;
#pragma unroll
          for (int j = 0; j < 4; ++j) { v[j] = src ? *((const f32x4*)src + 64 * j + lane) : (f32x4){0.f, 0.f, 0.f, 0.f}; s += (v[j][0] * v[j][0] + v[j][1] * v[j][1]) + (v[j][2] * v[j][2] + v[j][3] * v[j][3]); }
          s = wave_sum(s);
#pragma unroll
          for (int j = 0; j < 4; ++j) { *((f32x4*)(H + (size_t)m * D) + 64 * j + lane) = v[j];
              *((unsigned long long*)(XB + (size_t)m * D) + 64 * j + lane) = (unsigned long long)pk2(v[j][0], v[j][1]) | ((unsigned long long)pk2(v[j][2], v[j][3]) << 32); }
          if (lane < 16) ssp[(size_t)m * 16 + lane] = lane == 0 ? s : 0.f; } }
}
__device__ __forceinline__ void conv_phase(const Args& a, int lane, int gw, int NGW) {
    const bf16* Z = (const bf16*)(a.ws + WS_BIG); const bf16* GB = Z + (size_t)MP * D; bf16* Y = (bf16*)(a.ws + WS_O); const float* cw = a.in[14];
    for (int it = gw; it < (MP / 16) * 2; it += NGW) {
        const int rb = it >> 1, col = (it & 1) * 512 + lane * 8, row0 = rb * 16, p0 = row0 % LP;
        float w0[8], w1[8], w2[8], zm2[8], zm1[8];
#pragma unroll
        for (int e = 0; e < 8; ++e) { w0[e] = cw[col + e]; w1[e] = cw[D + col + e]; w2[e] = cw[2 * D + col + e]; zm2[e] = 0.f; zm1[e] = 0.f; }
        if (p0 != 0) { const v4u a2 = *(const v4u*)(Z + (size_t)(row0 - 2) * D + col), a1 = *(const v4u*)(Z + (size_t)(row0 - 1) * D + col);
#pragma unroll
            for (int e = 0; e < 4; ++e) { zm2[2 * e] = __uint_as_float(a2[e] << 16); zm2[2 * e + 1] = __uint_as_float(a2[e] & 0xffff0000u); zm1[2 * e] = __uint_as_float(a1[e] << 16); zm1[2 * e + 1] = __uint_as_float(a1[e] & 0xffff0000u); } }
#pragma unroll 4
        for (int i = 0; i < 16; ++i) { const size_t off = (size_t)(row0 + i) * D + col; const v4u zz = *(const v4u*)(Z + off), gg = *(const v4u*)(GB + off);
            float z[8], g[8], y[8];
#pragma unroll
            for (int e = 0; e < 4; ++e) { z[2 * e] = __uint_as_float(zz[e] << 16); z[2 * e + 1] = __uint_as_float(zz[e] & 0xffff0000u); g[2 * e] = __uint_as_float(gg[e] << 16); g[2 * e + 1] = __uint_as_float(gg[e] & 0xffff0000u); }
#pragma unroll
            for (int e = 0; e < 8; ++e) { y[e] = g[e] * (w0[e] * zm2[e] + w1[e] * zm1[e] + w2[e] * z[e]); zm2[e] = zm1[e]; zm1[e] = z[e]; }
            v4u o; o.x = pk2(y[0], y[1]); o.y = pk2(y[2], y[3]); o.z = pk2(y[4], y[5]); o.w = pk2(y[6], y[7]);
            *(v4u*)(Y + off) = o; }
    }
}

__global__ void __launch_bounds__(NWAVES * 64, 2) mega_fwd(Args args) {
    extern __shared__ __attribute__((aligned(16))) unsigned char lds_raw[];
    LAS unsigned char* lds = (LAS unsigned char*)lds_raw;
    cg::grid_group grid = cg::this_grid();
    const int wave = __builtin_amdgcn_readfirstlane(threadIdx.x >> 6);
    const int G = gridDim.x, gw = blockIdx.x * NWAVES + wave, NGW = G * NWAVES;
    unsigned char* ws = args.ws;
    float* H = (float*)(ws + WS_H); bf16* XB = (bf16*)(ws + WS_XB); float* SSP = (float*)(ws + WS_SSP); bf16* BIG = (bf16*)(ws + WS_BIG); bf16* OB = (bf16*)(ws + WS_O);
    const int lo = args.ph_lo, hi = args.ph_hi;
#ifndef PHASE_MASK
#define PHASE_MASK 0x7ff
#endif
#define IN(k) (((PHASE_MASK >> (k)) & 1) && lo <= (k) && (k) < hi)
#define SEAM(k) do { if (IN(k) && IN((k) + 1)) grid.sync(); } while (0)
    if (IN(0)) { prologue(args, lds, wave, pg8::lane_id_v(), gw, NGW); }
    SEAM(0);
    if (IN(1)) {
        pg8::Gemm g{XB, (const bf16*)(ws + WS_WQKV), MP, NQKV, D}; pg8::StaticOrder S; S.init(MP, NQKV, G, (int)blockIdx.x);
        pg8::EpiQKV E{BIG, SSP, (const float*)(ws + WS_ROPE), args.in[5], args.in[6]};
        pg8::gemm_phase<pg8::EpiQKV, pg8::StaticOrder, true, true>(lds, g, S, E, wave);
    }
    SEAM(1);
    if (IN(2)) {
        const int lane = pg8::lane_id_v();
        float s1 = wave_sum(args.in[7][lane] * args.in[8][lane]), s2 = wave_sum(args.in[9][lane] * args.in[10][lane]);
        const float lam = expf(s1) - expf(s2) + 0.2f;
        for (int bh = blockIdx.x; bh < NB * 8; bh += G) { const int b = bh >> 3, h = bh & 7;
#pragma unroll 1
            for (int j = -1; j < 8; ++j) att::attn_unit(lds, BIG, OB, b, h, j < 0 ? 0 : 64 + 256 * j, j < 0 ? 2 : 8, lam, args.in[11], wave); }
    }
    SEAM(2);
    if (IN(3)) {
        pg8::Gemm g{OB, (const bf16*)(ws + WS_WO), MP, D, D}; pg8::StaticOrder S; S.init(MP, D, G, (int)blockIdx.x);
        pg8::EpiRes<false> E{H, XB, SSP, nullptr};
        pg8::gemm_phase<pg8::EpiRes<false>, pg8::StaticOrder, true, true>(lds, g, S, E, wave);
    }
    SEAM(3);
    if (IN(4)) {
        pg8::Gemm g{XB, (const bf16*)(ws + WS_WGU0), MP, NGU, D}; pg8::StaticOrder S; S.init(MP, NGU, G, (int)blockIdx.x);
        pg8::EpiGateUp E{BIG, SSP};
        pg8::gemm_phase<pg8::EpiGateUp, pg8::StaticOrder, true, true>(lds, g, S, E, wave);
    }
    SEAM(4);
    if (IN(5)) {
        pg8::Gemm g{BIG, (const bf16*)(ws + WS_WD0), MP, D, DFF}; pg8::StaticOrder S; S.init(MP, D, G, (int)blockIdx.x);
        pg8::EpiRes<false> E{H, XB, SSP, nullptr};
        pg8::gemm_phase<pg8::EpiRes<false>, pg8::StaticOrder, true, true>(lds, g, S, E, wave);
    }
    SEAM(5);
    if (IN(6)) {
        pg8::Gemm g{XB, (const bf16*)(ws + WS_WIN), MP, NQKV, D}; pg8::StaticOrder S; S.init(MP, NQKV, G, (int)blockIdx.x);
        pg8::EpiWin E{BIG, BIG + (size_t)MP * D, SSP};
        pg8::gemm_phase<pg8::EpiWin, pg8::StaticOrder, true, true>(lds, g, S, E, wave);
    }
    SEAM(6);
    if (IN(7)) { conv_phase(args, pg8::lane_id_v(), gw, NGW); }
    SEAM(7);
    if (IN(8)) {
        pg8::Gemm g{OB, (const bf16*)(ws + WS_WOUT), MP, D, D}; pg8::StaticOrder S; S.init(MP, D, G, (int)blockIdx.x);
        pg8::EpiRes<false> E{H, XB, SSP, nullptr};
        pg8::gemm_phase<pg8::EpiRes<false>, pg8::StaticOrder, true, true>(lds, g, S, E, wave);
    }
    SEAM(8);
    if (IN(9)) {
        pg8::Gemm g{XB, (const bf16*)(ws + WS_WGU1), MP, NGU, D}; pg8::StaticOrder S; S.init(MP, NGU, G, (int)blockIdx.x);
        pg8::EpiGateUp E{BIG, SSP};
        pg8::gemm_phase<pg8::EpiGateUp, pg8::StaticOrder, true, true>(lds, g, S, E, wave);
    }
    SEAM(9);
    if (IN(10)) {
        pg8::Gemm g{BIG, (const bf16*)(ws + WS_WD1), MP, D, DFF}; pg8::StaticOrder S; S.init(MP, D, G, (int)blockIdx.x);
        pg8::EpiRes<true> E{H, nullptr, nullptr, args.out};
        pg8::gemm_phase<pg8::EpiRes<true>, pg8::StaticOrder, true, true>(lds, g, S, E, wave);
    }
#undef IN
#undef SEAM
}

extern "C" void kernel_launch(void* const* d_in, const int* in_sizes, int n_in, void* d_out, int out_size, void* d_ws, size_t ws_size, hipStream_t stream) {
    static int grid = 0;
    if (grid == 0) {
        if (n_in != 18 || ws_size < WS_END) { fprintf(stderr, "kernel_launch: need 18 inputs and %zu bytes of workspace (got %d, %zu)\n", (size_t)WS_END, n_in, ws_size); grid = -1; return; }
        int dev = 0, cus = 0, per_cu = 0;
        hipGetDevice(&dev); hipDeviceGetAttribute(&cus, hipDeviceAttributeMultiprocessorCount, dev);
        if (hipFuncSetAttribute((const void*)mega_fwd, hipFuncAttributeMaxDynamicSharedMemorySize, LDS_BYTES) != hipSuccess) { fprintf(stderr, "kernel_launch: hipFuncSetAttribute failed\n"); grid = -1; return; }
        if (hipOccupancyMaxActiveBlocksPerMultiprocessor(&per_cu, (const void*)mega_fwd, NWAVES * 64, LDS_BYTES) != hipSuccess || per_cu < 1) { fprintf(stderr, "kernel_launch: occupancy query says %d\n", per_cu); per_cu = 1; }
        (void)hipGetLastError();
        grid = cus * per_cu;
    }
    if (grid < 0) return;
    Args a{};
    for (int i = 0; i < 18; ++i) a.in[i] = (const float*)d_in[i];
    a.out = (float*)d_out; a.ws = (unsigned char*)d_ws;
#if MK_PER_PHASE
    for (int p = 0; p < NPHASE; ++p) { a.ph_lo = p; a.ph_hi = p + 1; hipLaunchKernelGGL(mega_fwd, dim3(grid), dim3(NWAVES * 64), LDS_BYTES, stream, a); }
#else
    a.ph_lo = 0; a.ph_hi = NPHASE;
    void* kargs[] = {&a};
    hipError_t e = hipLaunchCooperativeKernel((const void*)mega_fwd, dim3(grid), dim3(NWAVES * 64), kargs, LDS_BYTES, stream);
    if (e != hipSuccess) fprintf(stderr, "kernel_launch: cooperative launch failed: %s (grid %d)\n", hipGetErrorString(e), grid);
#endif
}
```

```cpp
#include <hip/hip_runtime.h>
#include <hip/hip_cooperative_groups.h>
#include <cstdio>
#include <cstdint>
namespace cg = cooperative_groups;
namespace pg8 {
#define PG8_LAS __attribute__((address_space(3)))
typedef unsigned short bf16_t;
typedef short bf16x8 __attribute__((ext_vector_type(8)));
typedef float f32x4 __attribute__((ext_vector_type(4)));
typedef unsigned u32x4 __attribute__((ext_vector_type(4)));
constexpr int BM = 256, BK = 64, HALF = 128, HTB = HALF * BK * 2  , STAGE_BYTES = 8 * HTB, NXCD = 8, WGM = 8;

__host__ __device__ __forceinline__ int lds_byte(int r, int c) { const int st = (r >> 4) * 2 + (c >> 5), rr = r & 15, cc = c & 31, ob = rr * 64 + cc * 2; return st * 1024 + (ob ^ (((ob >> 9) & 1) << 5)); }
__host__ __device__ __forceinline__ void stage_rc(int b, int& R, int& C) { const int st = b / 1024, sb = b % 1024, swz = sb ^ (((sb >> 9) & 1) << 5); R = (st >> 1) * 16 + swz / 64; C = (st & 1) * 32 + (swz % 64) / 2; }
__host__ __device__ __forceinline__ int perm32(int rho) { const int n = rho >> 4, i = rho & 15; return 8 * (i >> 2) + 4 * n + (i & 3); }

struct Unit { int pm, pn; };
struct Gemm { const bf16_t* A; const bf16_t* Bt; int M, N, K; };

struct StaticOrder {
    int nM, nN, nwg, G, c;
    __host__ __device__ void init(int M, int N, int G_, int c_) { nM = M / BM; nN = N / BM; nwg = nM * nN; G = G_; c = c_; }
    __host__ __device__ bool next(int i, Unit& u) const {
        const long L = (long)i * G + c; if (L >= nwg) return false;
        int wgid = (int)L; { const int q = nwg / NXCD, r = nwg % NXCD, xcd = wgid % NXCD, off = wgid / NXCD; wgid = (xcd < r ? xcd * (q + 1) : r * (q + 1) + (xcd - r) * q) + off; }
        const int nig = WGM * nN, gid = wgid / nig, fm = gid * WGM, gsz = (nM - fm) < WGM ? (nM - fm) : WGM;
        u.pm = fm + ((wgid % nig) % gsz); u.pn = (wgid % nig) / gsz; return true;
    }
    __device__ __forceinline__ void a_ready(const Unit&) const {}
    __device__ __forceinline__ void done(const Unit&) const {}
};
__device__ __forceinline__ unsigned cvt_pk_bf16(float lo, float hi) { unsigned r; asm volatile("v_cvt_pk_bf16_f32 %0, %1, %2" : "=v"(r) : "v"(lo), "v"(hi)); return r; }
typedef unsigned u32x2 __attribute__((ext_vector_type(2)));
__device__ __forceinline__ int lane_id_v() { int l; asm volatile("v_mbcnt_lo_u32_b32 %0, -1, 0\n\tv_mbcnt_hi_u32_b32 %0, -1, %0" : "=v"(l)); return l; }
constexpr int LP_ = 2112, PADF_ = 48, LTOK_ = 2064;
constexpr float QSCALE_ = 0.125f * 1.4426950408889634f;
__device__ __forceinline__ float row_rstd(const float* ssp, int row) {
    const f32x4* p = (const f32x4*)(ssp + (size_t)row * 16);
    const f32x4 a = p[0], b = p[1], c = p[2], d = p[3];
    const float s = (((a[0] + a[1]) + (a[2] + a[3])) + ((b[0] + b[1]) + (b[2] + b[3]))) + (((c[0] + c[1]) + (c[2] + c[3])) + ((d[0] + d[1]) + (d[2] + d[3])));
    return rsqrtf(s * (1.0f / 1024.0f) + 1e-6f);
}
__device__ __forceinline__ u32x4 pack8(const f32x4 v0, const f32x4 v1) { u32x4 w; w.x = cvt_pk_bf16(v0[0], v0[1]); w.y = cvt_pk_bf16(v0[2], v0[3]); w.z = cvt_pk_bf16(v1[0], v1[1]); w.w = cvt_pk_bf16(v1[2], v1[3]); return w; }

struct EpiQKV {
    static constexpr bool PERM = true, AFTER_DRAIN = false;
    bf16_t* QKV; const float* ssp; const float* rope; const float* qg; const float* kg;
    __device__ __forceinline__ void operator()(const f32x4 (&acc)[2][2][4][2], const Unit& u, int wr, int wc, int fr, int fq) const {
        const int row0 = u.pm * BM + wr * 64 + fr, pn = u.pn;
        const int colbase = pn * 256 + wc * 64 + 8 * fq;
        if (pn < 8) {
            const float* gp = (pn < 4) ? qg : kg; const float osc = (pn < 4) ? QSCALE_ : 1.0f;
            f32x4 g[2][2];
#pragma unroll
            for (int bj = 0; bj < 2; ++bj)
#pragma unroll
                for (int n = 0; n < 2; ++n) g[bj][n] = *(const f32x4*)(gp + 32 * bj + 8 * fq + 4 * n);
#pragma unroll
            for (int ai = 0; ai < 2; ++ai)
#pragma unroll
                for (int m = 0; m < 4; ++m) {
                    const int row = row0 + ai * HALF + m * 16; const float rs = row_rstd(ssp, row);
                    f32x4 v[2][2]; float ss = 0.f;
#pragma unroll
                    for (int bj = 0; bj < 2; ++bj)
#pragma unroll
                        for (int n = 0; n < 2; ++n) { v[bj][n] = acc[ai][bj][m][n] * rs; const f32x4 x = v[bj][n]; ss += (x[0] * x[0] + x[1] * x[1]) + (x[2] * x[2] + x[3] * x[3]); }
                    ss += __shfl_xor(ss, 16); ss += __shfl_xor(ss, 32);
                    const float rn = rsqrtf(ss * (1.0f / 64.0f) + 1e-6f);
#pragma unroll
                    for (int bj = 0; bj < 2; ++bj)
#pragma unroll
                        for (int n = 0; n < 2; ++n) v[bj][n] = v[bj][n] * rn * g[bj][n];
                    int pos = (row % LP_) - PADF_; pos = pos < 0 ? 0 : pos;
                    const f32x4* rp = (const f32x4*)(rope + ((size_t)pos * 32 + 8 * fq) * 2);
                    f32x4 o1[2], o2[2];
#pragma unroll
                    for (int n = 0; n < 2; ++n) { const f32x4 ca = rp[2 * n], cb = rp[2 * n + 1];
                        const f32x4 x1 = v[0][n], x2 = v[1][n];
                        o1[n][0] = (x1[0] * ca[0] - x2[0] * ca[1]) * osc; o2[n][0] = (x2[0] * ca[0] + x1[0] * ca[1]) * osc;
                        o1[n][1] = (x1[1] * ca[2] - x2[1] * ca[3]) * osc; o2[n][1] = (x2[1] * ca[2] + x1[1] * ca[3]) * osc;
                        o1[n][2] = (x1[2] * cb[0] - x2[2] * cb[1]) * osc; o2[n][2] = (x2[2] * cb[0] + x1[2] * cb[1]) * osc;
                        o1[n][3] = (x1[3] * cb[2] - x2[3] * cb[3]) * osc; o2[n][3] = (x2[3] * cb[2] + x1[3] * cb[3]) * osc; }
                    bf16_t* rowp = QKV + (size_t)row * 3072 + colbase;
                    *(u32x4*)(rowp) = pack8(o1[0], o1[1]); *(u32x4*)(rowp + 32) = pack8(o2[0], o2[1]);
                }
        } else {
#pragma unroll
            for (int ai = 0; ai < 2; ++ai)
#pragma unroll
                for (int m = 0; m < 4; ++m) {
                    const int row = row0 + ai * HALF + m * 16; const float rs = row_rstd(ssp, row);
                    bf16_t* rowp = QKV + (size_t)row * 3072 + colbase;
#pragma unroll
                    for (int bj = 0; bj < 2; ++bj) *(u32x4*)(rowp + 32 * bj) = pack8(acc[ai][bj][m][0] * rs, acc[ai][bj][m][1] * rs);
                }
        }
    }
};
struct EpiGateUp {
    static constexpr bool PERM = true, AFTER_DRAIN = false;
    bf16_t* HID; const float* ssp;
    __device__ __forceinline__ void operator()(const f32x4 (&acc)[2][2][4][2], const Unit& u, int wr, int wc, int fr, int fq) const {
        const int row0 = u.pm * BM + wr * 64 + fr; const int col = u.pn * 128 + wc * 32 + 8 * fq;
#pragma unroll
        for (int ai = 0; ai < 2; ++ai)
#pragma unroll
            for (int m = 0; m < 4; ++m) {
                const int row = row0 + ai * HALF + m * 16; const float rs = row_rstd(ssp, row);
                f32x4 hv[2];
#pragma unroll
                for (int n = 0; n < 2; ++n) { const f32x4 g = acc[ai][0][m][n] * rs, uu = acc[ai][1][m][n] * rs;
#pragma unroll
                    for (int e = 0; e < 4; ++e) { const float sg = __builtin_amdgcn_rcpf(1.0f + __expf(-g[e])); hv[n][e] = g[e] * sg * uu[e]; } }
                *(u32x4*)(HID + (size_t)row * 2816 + col) = pack8(hv[0], hv[1]);
            }
    }
};
struct EpiWin {
    static constexpr bool PERM = true, AFTER_DRAIN = false;
    bf16_t* Z; bf16_t* GB; const float* ssp;
    __device__ __forceinline__ void operator()(const f32x4 (&acc)[2][2][4][2], const Unit& u, int wr, int wc, int fr, int fq) const {
        const int row0 = u.pm * BM + wr * 64 + fr, pn = u.pn;
#pragma unroll
        for (int ai = 0; ai < 2; ++ai)
#pragma unroll
            for (int m = 0; m < 4; ++m) {
                const int row = row0 + ai * HALF + m * 16; const float rs = row_rstd(ssp, row);
                if (pn < 8) {
                    const float rs2 = rs * rs;
                    *(u32x4*)(Z + (size_t)row * 1024 + pn * 128 + wc * 32 + 8 * fq) = pack8(acc[ai][0][m][0] * acc[ai][1][m][0] * rs2, acc[ai][0][m][1] * acc[ai][1][m][1] * rs2);
                } else {
                    bf16_t* rowp = GB + (size_t)row * 1024 + (pn - 8) * 256 + wc * 32 + 8 * fq;
#pragma unroll
                    for (int bj = 0; bj < 2; ++bj) *(u32x4*)(rowp + 128 * bj) = pack8(acc[ai][bj][m][0] * rs, acc[ai][bj][m][1] * rs);
                }
            }
    }
};
template <bool FINAL> struct EpiRes {
    static constexpr bool PERM = true, AFTER_DRAIN = false;
    float* H; bf16_t* XB; float* ssp; float* out;
    __device__ __forceinline__ void operator()(const f32x4 (&acc)[2][2][4][2], const Unit& u, int wr, int wc, int fr, int fq) const {
        const int row0 = u.pm * BM + wr * 64 + fr; const int c0 = u.pn * 256 + wc * 32 + 8 * fq;
#pragma unroll
        for (int ai = 0; ai < 2; ++ai)
#pragma unroll
            for (int m = 0; m < 4; ++m) {
                const int row = row0 + ai * HALF + m * 16; float ss = 0.f;
                const float* hp = H + (size_t)row * 1024 + c0;
                f32x4 nv[2][2];
#pragma unroll
                for (int bj = 0; bj < 2; ++bj) { nv[bj][0] = *(const f32x4*)(hp + 128 * bj) + acc[ai][bj][m][0]; nv[bj][1] = *(const f32x4*)(hp + 128 * bj + 4) + acc[ai][bj][m][1]; }
                if (!FINAL) {
#pragma unroll
                    for (int bj = 0; bj < 2; ++bj) {
                        *(f32x4*)(H + (size_t)row * 1024 + c0 + 128 * bj) = nv[bj][0]; *(f32x4*)(H + (size_t)row * 1024 + c0 + 128 * bj + 4) = nv[bj][1];
                        *(u32x4*)(XB + (size_t)row * 1024 + c0 + 128 * bj) = pack8(nv[bj][0], nv[bj][1]);
#pragma unroll
                        for (int n = 0; n < 2; ++n) { const f32x4 x = nv[bj][n]; ss += (x[0] * x[0] + x[1] * x[1]) + (x[2] * x[2] + x[3] * x[3]); }
                    }
                    ss += __shfl_xor(ss, 16); ss += __shfl_xor(ss, 32);
                    if (fq == 0) ssp[(size_t)row * 16 + 4 * u.pn + wc] = ss;
                } else {
                    const int b = row / LP_, p = row - b * LP_;
                    if (p >= 64) { float* op = out + ((size_t)b * 2048 + (p - 64)) * 1024 + c0;
#pragma unroll
                        for (int bj = 0; bj < 2; ++bj) { *(f32x4*)(op + 128 * bj) = nv[bj][0]; *(f32x4*)(op + 128 * bj + 4) = nv[bj][1]; } }
                }
            }
    }
};
template <class Epi, class Sched, bool ALIGN_EPI = false, bool SP2 = false>
__device__ __forceinline__ void gemm_phase(PG8_LAS unsigned char* lds, const Gemm g, const Sched& S, const Epi& E, const int wid) {
    const int lane = lane_id_v(), tid = wid * 64 + lane, wr = wid >> 2, wc = wid & 3, fr = lane & 15, fq = lane >> 4;
    const int K = g.K, nt = K / BK;
    unsigned voffA[2], voffB[2];
#pragma unroll
    for (int i = 0; i < 2; ++i) { int R, C; stage_rc(tid * 16 + i * 8192, R, C); const int Rb = Epi::PERM ? ((R & ~31) + perm32(R & 31)) : R;
        voffA[i] = (unsigned)(R * K + C) * 2u; voffB[i] = (unsigned)(Rb * K + C) * 2u; }
    const size_t kstep = (size_t)(BK * 2);
    const size_t hstep = (size_t)HALF * K * 2;
    const size_t tstep = 2 * hstep;
    const unsigned ldsw = (unsigned)wid * 1024u;
    const int aoff = lds_byte(wr * 64 + fr, fq * 8), boff = lds_byte(wc * 32 + fr, fq * 8);
#define PG8_SA(b, h) (((b) * 2 + (h)) * HTB)
#define PG8_SB(b, h) ((4 + (b) * 2 + (h)) * HTB)
#define PG8_STAGE(bufoff, gbase, voff) do { _Pragma("unroll") for (int _i = 0; _i < 2; ++_i) \
        __builtin_amdgcn_global_load_lds((const unsigned*)((const char*)(gbase) + (voff)[_i]), (PG8_LAS unsigned*)(lds + (bufoff) + ldsw + _i * 8192), 16, 0, 0); } while (0)
#define PG8_LDA(dst, b, h) do { _Pragma("unroll") for (int m = 0; m < 4; ++m) _Pragma("unroll") for (int k = 0; k < 2; ++k) dst[m][k] = *(const PG8_LAS bf16x8*)(lds + PG8_SA(b, h) + aoff + m * 2048 + k * 1024); } while (0)
#define PG8_LDB(dst, b, h) do { _Pragma("unroll") for (int n = 0; n < 2; ++n) _Pragma("unroll") for (int k = 0; k < 2; ++k) dst[n][k] = *(const PG8_LAS bf16x8*)(lds + PG8_SB(b, h) + boff + n * 2048 + k * 1024); } while (0)
#define PG8_MMA(ai, bj, At, Bt) do { __builtin_amdgcn_s_setprio(1); _Pragma("unroll") for (int m = 0; m < 4; ++m) _Pragma("unroll") for (int n = 0; n < 2; ++n) _Pragma("unroll") for (int k = 0; k < 2; ++k) \
        acc[ai][bj][m][n] = __builtin_amdgcn_mfma_f32_16x16x32_bf16(Bt[n][k], At[m][k], acc[ai][bj][m][n], 0, 0, 0); __builtin_amdgcn_s_setprio(0); } while (0)
#define PG8_WAIT_V(n) asm volatile("s_waitcnt vmcnt(" #n ")" ::: "memory")
#define PG8_WAIT_L(n) asm volatile("s_waitcnt lgkmcnt(" #n ")" ::: "memory")
#define PG8_BAR __builtin_amdgcn_s_barrier()
#define PG8_SCHED __builtin_amdgcn_sched_barrier(0)
    Unit cur, nxt; int ui = 0;
    if (!S.next(0, cur)) return;
    f32x4 acc[2][2][4][2];
#pragma unroll
    for (int a = 0; a < 2; ++a)
#pragma unroll
        for (int b = 0; b < 2; ++b)
#pragma unroll
            for (int m = 0; m < 4; ++m)
#pragma unroll
                for (int n = 0; n < 2; ++n) acc[a][b][m][n] = (f32x4){0.f, 0.f, 0.f, 0.f};
    bf16x8 At[4][2], B0[2][2], B1[2][2];
    const char* cA = (const char*)g.A + (size_t)cur.pm * tstep; const char* cB = (const char*)g.Bt + (size_t)cur.pn * tstep;
    S.a_ready(cur);
    if constexpr (SP2) {
        PG8_STAGE(PG8_SB(0, 0), cB, voffB); PG8_STAGE(PG8_SB(0, 1), cB + hstep, voffB); PG8_STAGE(PG8_SA(0, 0), cA, voffA); PG8_STAGE(PG8_SA(0, 1), cA + hstep, voffA);
        if (wr == 1) PG8_BAR;
        PG8_WAIT_V(2); PG8_BAR;
        PG8_STAGE(PG8_SB(1, 0), cB + kstep, voffB); PG8_STAGE(PG8_SA(1, 0), cA + kstep, voffA); PG8_STAGE(PG8_SB(1, 1), cB + hstep + kstep, voffB);
        PG8_WAIT_V(6); PG8_BAR;
    } else {
        PG8_STAGE(PG8_SB(0, 0), cB, voffB); PG8_STAGE(PG8_SA(0, 0), cA, voffA); PG8_STAGE(PG8_SB(0, 1), cB + hstep, voffB); PG8_STAGE(PG8_SA(0, 1), cA + hstep, voffA);
        if (wr == 1) PG8_BAR;
        PG8_WAIT_V(4); PG8_BAR;
        PG8_STAGE(PG8_SB(1, 0), cB + kstep, voffB); PG8_STAGE(PG8_SA(1, 0), cA + kstep, voffA); PG8_STAGE(PG8_SB(1, 1), cB + hstep + kstep, voffB);
        PG8_WAIT_V(6); PG8_BAR;
    }
    for (;;) {
        const bool has_next = S.next(ui + 1, nxt);
        const char* nA = has_next ? (const char*)g.A + (size_t)nxt.pm * tstep : cA; const char* nB = has_next ? (const char*)g.Bt + (size_t)nxt.pn * tstep : cB;
        for (int t = 0; t < nt; t += 2) {
            const bool last = (t == nt - 2);
            const char* a1 = cA + (size_t)(t + 1) * kstep;
            const char* a2 = last ? nA : cA + (size_t)(t + 2) * kstep; const char* b2 = last ? nB : cB + (size_t)(t + 2) * kstep;
            const char* a3 = a2 + kstep; const char* b3 = b2 + kstep;
            if (last && has_next) S.a_ready(nxt);
            if constexpr (SP2) {
            PG8_LDB(B0, 0, 0); PG8_LDB(B1, 0, 1); PG8_SCHED; PG8_LDA(At, 0, 0); PG8_STAGE(PG8_SA(1, 1), a1 + hstep, voffA);
            PG8_WAIT_V(8); PG8_WAIT_L(0); PG8_BAR; PG8_MMA(0, 0, At, B0); PG8_MMA(0, 1, At, B1); PG8_BAR; PG8_SCHED;
            PG8_LDA(At, 0, 1); PG8_STAGE(PG8_SB(0, 0), b2, voffB); PG8_STAGE(PG8_SB(0, 1), b2 + hstep, voffB); PG8_STAGE(PG8_SA(0, 0), a2, voffA);
            PG8_WAIT_V(8); PG8_WAIT_L(0); PG8_BAR; PG8_MMA(1, 0, At, B0); PG8_MMA(1, 1, At, B1); PG8_BAR; PG8_SCHED;
            PG8_LDB(B0, 1, 0); PG8_LDB(B1, 1, 1); PG8_SCHED; PG8_LDA(At, 1, 0); PG8_STAGE(PG8_SA(0, 1), a2 + hstep, voffA);
            PG8_WAIT_V(8); PG8_WAIT_L(0); PG8_BAR; PG8_MMA(0, 0, At, B0); PG8_MMA(0, 1, At, B1); PG8_BAR; PG8_SCHED;
            PG8_LDA(At, 1, 1); PG8_STAGE(PG8_SB(1, 0), b3, voffB); PG8_STAGE(PG8_SB(1, 1), b3 + hstep, voffB); PG8_STAGE(PG8_SA(1, 0), a3, voffA);
            PG8_WAIT_V(8); PG8_WAIT_L(0); PG8_BAR; PG8_MMA(1, 0, At, B0); PG8_MMA(1, 1, At, B1); PG8_BAR; PG8_SCHED;
            } else {
            PG8_LDB(B0, 0, 0); PG8_SCHED; PG8_LDA(At, 0, 0); PG8_STAGE(PG8_SA(1, 1), a1 + hstep, voffA);
            PG8_WAIT_L(8); PG8_BAR; PG8_WAIT_L(0); PG8_MMA(0, 0, At, B0); PG8_BAR; PG8_SCHED;
            PG8_LDB(B1, 0, 1); PG8_STAGE(PG8_SB(0, 0), b2, voffB);
            PG8_BAR; PG8_WAIT_L(0); PG8_MMA(0, 1, At, B1); PG8_BAR;
            PG8_LDA(At, 0, 1); PG8_STAGE(PG8_SA(0, 0), a2, voffA);
            PG8_BAR; PG8_WAIT_L(0); PG8_MMA(1, 0, At, B0); PG8_BAR; PG8_SCHED;
            PG8_STAGE(PG8_SB(0, 1), b2 + hstep, voffB);
            PG8_WAIT_V(6); PG8_BAR; PG8_MMA(1, 1, At, B1); PG8_BAR;
            PG8_LDB(B0, 1, 0); PG8_SCHED; PG8_LDA(At, 1, 0); PG8_STAGE(PG8_SA(0, 1), a2 + hstep, voffA);
            PG8_WAIT_L(8); PG8_BAR; PG8_WAIT_L(0); PG8_MMA(0, 0, At, B0); PG8_BAR; PG8_SCHED;
            PG8_LDB(B1, 1, 1); PG8_STAGE(PG8_SB(1, 0), b3, voffB);
            PG8_BAR; PG8_WAIT_L(0); PG8_MMA(0, 1, At, B1); PG8_BAR;
            PG8_LDA(At, 1, 1); PG8_STAGE(PG8_SA(1, 0), a3, voffA);
            PG8_BAR; PG8_WAIT_L(0); PG8_MMA(1, 0, At, B0); PG8_BAR; PG8_SCHED;
            PG8_STAGE(PG8_SB(1, 1), b3 + hstep, voffB);
            PG8_WAIT_V(6); PG8_BAR; PG8_MMA(1, 1, At, B1); PG8_BAR;
            }
        }
        if constexpr (ALIGN_EPI) { if (wr == 0) PG8_BAR; }
        if constexpr (!Epi::AFTER_DRAIN) { E(acc, cur, wr, wc, fr, fq); S.done(cur); }
        if (!has_next) break;
#pragma unroll
        for (int a = 0; a < 2; ++a)
#pragma unroll
            for (int b = 0; b < 2; ++b)
#pragma unroll
                for (int m = 0; m < 4; ++m)
#pragma unroll
                    for (int n = 0; n < 2; ++n) acc[a][b][m][n] = (f32x4){0.f, 0.f, 0.f, 0.f};
        cur = nxt; cA = nA; cB = nB; ++ui;
        if constexpr (ALIGN_EPI) { if (wr == 1) PG8_BAR; }
    }
    PG8_WAIT_V(0);
    if constexpr (!ALIGN_EPI) { if (wr == 0) PG8_BAR; }
    PG8_BAR;
    if constexpr (Epi::AFTER_DRAIN) { E.fused(acc, cur, wr, wc, fr, fq, lds, wid, lane); S.done(cur); }
#undef PG8_SA
#undef PG8_SB
#undef PG8_STAGE
#undef PG8_LDA
#undef PG8_LDB
#undef PG8_MMA
#undef PG8_WAIT_V
#undef PG8_WAIT_L
#undef PG8_BAR
#undef PG8_SCHED
}
}
namespace att {
#define LAS __attribute__((address_space(3)))
typedef unsigned short bf16_t;
typedef short bf16x8 __attribute__((ext_vector_type(8)));
typedef short s16x4 __attribute__((ext_vector_type(4)));
typedef float f32x16 __attribute__((ext_vector_type(16)));
typedef float f32x4 __attribute__((ext_vector_type(4)));
typedef unsigned u32x4 __attribute__((ext_vector_type(4)));
constexpr int LP = 2112, PADF = 48, PITCH = 3072;
constexpr int KV_BUF = 32768, V_OFF = 16384, OST_OFF = 65536, OST_PITCH = 272, OST_WAVE = 32 * OST_PITCH, WSF_OFF = OST_OFF + 8 * OST_WAVE, ATT_LDS = WSF_OFF + 8 * 256;
__device__ __forceinline__ int crow(int r, int hi) { return (r & 3) + 8 * (r >> 2) + 4 * hi; }
__device__ __forceinline__ unsigned cvtpk(float lo, float hi) { unsigned r; asm volatile("v_cvt_pk_bf16_f32 %0, %1, %2" : "=v"(r) : "v"(lo), "v"(hi)); return r; }
__device__ __forceinline__ s16x4 vtr(const LAS unsigned char* p) { return __builtin_bit_cast(s16x4, __builtin_amdgcn_ds_read_tr16_b64_v4i16((LAS s16x4*)p)); }

__device__ __forceinline__ void stage_tile(LAS unsigned char* lds, int bufoff, const bf16_t* QKV, long rowbase, int h, int t, int wid, int lane) {
#pragma unroll
    for (int i = 0; i < 2; ++i) {
        const int ci = 2 * wid + i;
        const bf16_t* ks = QKV + (size_t)(rowbase + 64 * t + lane) * PITCH + 1024 + h * 128 + ci * 8;
        __builtin_amdgcn_global_load_lds((const unsigned*)ks, (LAS unsigned*)(lds + bufoff + ci * 1024), 16, 0, 0);
    }
#pragma unroll
    for (int i = 0; i < 2; ++i) {
        const int pi = 2 * wid + i, db = pi >> 2, kg = pi & 3;
        const bf16_t* vs = QKV + (size_t)(rowbase + 64 * t + 16 * kg + (lane >> 2)) * PITCH + 2048 + h * 128 + db * 32 + (lane & 3) * 8;
        __builtin_amdgcn_global_load_lds((const unsigned*)vs, (LAS unsigned*)(lds + bufoff + V_OFF + pi * 1024), 16, 0, 0);
    }
}

__device__ __forceinline__ void attn_unit(LAS unsigned char* lds, const bf16_t* QKV, bf16_t* O, int b, int h, int q0, int nqw, float lam, const float* subg, const int wid) {
    const int lane = pg8::lane_id_v(), r32 = lane & 31, hi = lane >> 5;
    const long rowbase = (long)b * LP;
    const int NT = (q0 + 32 * nqw) >> 6;
    const bool active = wid < nqw;
    const int qabs = q0 + 32 * wid + r32, qfirst = q0 + 32 * wid, qlast = qfirst + 31;
    LAS unsigned char* qw = lds + OST_OFF + wid * OST_WAVE + lane * 16;
    {
        const bf16_t* qp = QKV + (size_t)(rowbase + (active ? qabs : 0)) * PITCH + h * 128 + hi * 8;
#pragma unroll
        for (int j = 0; j < 8; ++j) *(LAS bf16x8*)(qw + j * 1024) = *(const bf16x8*)(qp + (j >> 2) * 64 + (j & 3) * 16);
    }
    f32x16 o[2][4];
#pragma unroll
    for (int c = 0; c < 2; ++c)
#pragma unroll
        for (int db = 0; db < 4; ++db)
#pragma unroll
            for (int r = 0; r < 16; ++r) o[c][db][r] = 0.f;
    float lsum[2] = {0.f, 0.f};
    stage_tile(lds, 0, QKV, rowbase, h, 0, wid, lane);
    for (int t = 0; t < NT; ++t) {
        __syncthreads();
        const int buf = (t & 1) * KV_BUF;
        if (t + 1 < NT) stage_tile(lds, ((t + 1) & 1) * KV_BUF, QKV, rowbase, h, t + 1, wid, lane);
        if (active && 64 * t <= qlast) {
            const bool needmask = (t == 0) || (64 * t + 63 > qfirst);
            const LAS unsigned char* kb = lds + buf + hi * 1024 + r32 * 16;
            const LAS unsigned char* vp = lds + buf + V_OFF + ((lane >> 4) & 1) * 32 + (lane & 3) * 8 + (4 * hi + ((lane & 15) >> 2)) * 64;
            int mhi = qabs - 64 * t - 4 * hi, mlo = PADF - 64 * t - 4 * hi;
            asm volatile("" : "+v"(mhi), "+v"(mlo));
#pragma unroll
            for (int c = 0; c < 2; ++c) {
                f32x16 p0, p1;
#pragma unroll
                for (int r = 0; r < 16; ++r) { p0[r] = 0.f; p1[r] = 0.f; }
#pragma unroll
                for (int d0 = 0; d0 < 4; ++d0) {
                    const bf16x8 k0 = *(const LAS bf16x8*)(kb + (c * 8 + 2 * d0) * 1024);
                    const bf16x8 k1 = *(const LAS bf16x8*)(kb + (c * 8 + 2 * d0) * 1024 + 512);
                    const bf16x8 qv = *(const LAS bf16x8*)(qw + (c * 4 + d0) * 1024);
                    p0 = __builtin_amdgcn_mfma_f32_32x32x16_bf16(k0, qv, p0, 0, 0, 0);
                    p1 = __builtin_amdgcn_mfma_f32_32x32x16_bf16(k1, qv, p1, 0, 0, 0);
                    if (d0 == 1) __builtin_amdgcn_sched_barrier(0);
                }
#pragma unroll
                for (int r = 0; r < 16; ++r) { p0[r] = __builtin_amdgcn_exp2f(p0[r]); p1[r] = __builtin_amdgcn_exp2f(p1[r]); }
                if (needmask) {
#pragma unroll
                    for (int r = 0; r < 16; ++r) { const int cr = (r & 3) + 8 * (r >> 2);
                        if (cr > mhi) p0[r] = 0.f;
                        if (cr + 32 > mhi) p1[r] = 0.f; }
                    if (t == 0) {
#pragma unroll
                        for (int r = 0; r < 16; ++r) { const int cr = (r & 3) + 8 * (r >> 2);
                            if (cr < mlo) p0[r] = 0.f;
                            if (cr + 32 < mlo) p1[r] = 0.f; }
                    }
                }
                float s = 0.f;
#pragma unroll
                for (int r = 0; r < 16; ++r) s += p0[r] + p1[r];
                lsum[c] += s;
                u32x4 pw[4];
                pw[0] = (u32x4){cvtpk(p0[0], p0[1]), cvtpk(p0[2], p0[3]), cvtpk(p0[4], p0[5]), cvtpk(p0[6], p0[7])};
                pw[1] = (u32x4){cvtpk(p0[8], p0[9]), cvtpk(p0[10], p0[11]), cvtpk(p0[12], p0[13]), cvtpk(p0[14], p0[15])};
                pw[2] = (u32x4){cvtpk(p1[0], p1[1]), cvtpk(p1[2], p1[3]), cvtpk(p1[4], p1[5]), cvtpk(p1[6], p1[7])};
                pw[3] = (u32x4){cvtpk(p1[8], p1[9]), cvtpk(p1[10], p1[11]), cvtpk(p1[12], p1[13]), cvtpk(p1[14], p1[15])};
                __builtin_amdgcn_sched_barrier(0);
#pragma unroll
                for (int db = 0; db < 4; ++db) {
#pragma unroll
                    for (int ks = 0; ks < 4; ++ks) {
                        const s16x4 lo = vtr(vp + db * 4096 + ks * 1024), hh = vtr(vp + db * 4096 + ks * 1024 + 512);
                        const bf16x8 vf = (bf16x8){lo[0], lo[1], lo[2], lo[3], hh[0], hh[1], hh[2], hh[3]};
                        o[c][db] = __builtin_amdgcn_mfma_f32_32x32x16_bf16(__builtin_bit_cast(bf16x8, pw[ks]), vf, o[c][db], 0, 0, 0);
                    }
                    __builtin_amdgcn_sched_barrier(0);
                }
            }
        }
    }
    if (active) {
        float l0 = lsum[0], l1 = lsum[1];
        l0 += __shfl_xor(l0, 32); l1 += __shfl_xor(l1, 32);
        LAS float* wsf = (LAS float*)(lds + WSF_OFF) + wid * 64;
        if (hi == 0) { wsf[r32] = l0; wsf[32 + r32] = l1; }
        asm volatile("s_waitcnt lgkmcnt(0)" ::: "memory");
#pragma unroll
        for (int r = 0; r < 16; ++r) { const float a0 = wsf[crow(r, hi)], a1 = wsf[32 + crow(r, hi)];
            const float rl0 = a0 > 0.f ? 1.0f / a0 : 0.f, rl1 = a1 > 0.f ? lam / a1 : 0.f; float s = 0.f;
#pragma unroll
            for (int db = 0; db < 4; ++db) { const float v = o[0][db][r] * rl0 - o[1][db][r] * rl1; o[0][db][r] = v; s += v * v; }
            s += __shfl_xor(s, 1); s += __shfl_xor(s, 2); s += __shfl_xor(s, 4); s += __shfl_xor(s, 8); s += __shfl_xor(s, 16);
            const float rn = rsqrtf(s * (1.0f / 128.0f) + 1e-6f) * 0.8f;
#pragma unroll
            for (int db = 0; db < 4; ++db) o[0][db][r] *= rn; }
        LAS unsigned short* stg = (LAS unsigned short*)(lds + OST_OFF + wid * OST_WAVE);
#pragma unroll
        for (int db = 0; db < 4; ++db) { const float sg = subg[db * 32 + r32];
#pragma unroll
            for (int r = 0; r < 16; ++r) { const unsigned w = cvtpk(o[0][db][r] * sg, 0.f); stg[crow(r, hi) * (OST_PITCH / 2) + db * 32 + r32] = (unsigned short)(w & 0xffffu); } }
        asm volatile("s_waitcnt lgkmcnt(0)" ::: "memory");
        int lsel = lane; asm volatile("" : "+v"(lsel));
        bf16_t* Ow = O + (size_t)(rowbase + qfirst + (lsel >> 4)) * 1024 + h * 128 + (lsel & 15) * 8;
        const LAS unsigned char* sp = (const LAS unsigned char*)stg + (lsel >> 4) * OST_PITCH + (lsel & 15) * 16;
#pragma unroll
        for (int it = 0; it < 8; ++it) { const u32x4 v = *(const LAS u32x4*)(sp + it * 4 * OST_PITCH); *(u32x4*)Ow = v; Ow += 4 * 1024; asm volatile("" : "+v"(Ow)); }
    }
    __syncthreads();
}
}
typedef unsigned short bf16;
typedef unsigned v4u __attribute__((ext_vector_type(4)));
typedef float f32x4 __attribute__((ext_vector_type(4)));
constexpr int NWAVES = 8;
#ifndef MK_PER_PHASE
#define MK_PER_PHASE 0
#endif
constexpr int NPHASE = 11;
constexpr int D = 1024, NB = 32, SEQ = 2048, LTOK = 2064, PADF = 48, LP = 2112, MP = NB * LP;
constexpr int NQKV = 3072, DFF = 2816, NGU = 5632;
constexpr size_t al256(size_t x) { return (x + 255) & ~(size_t)255; }
constexpr size_t WS_WQKV = 0;
constexpr size_t WS_WO   = WS_WQKV + (size_t)NQKV * D * 2;
constexpr size_t WS_WGU0 = WS_WO + (size_t)D * D * 2;
constexpr size_t WS_WD0  = WS_WGU0 + (size_t)NGU * D * 2;
constexpr size_t WS_WIN  = WS_WD0 + (size_t)D * DFF * 2;
constexpr size_t WS_WOUT = WS_WIN + (size_t)NQKV * D * 2;
constexpr size_t WS_WGU1 = WS_WOUT + (size_t)D * D * 2;
constexpr size_t WS_WD1  = WS_WGU1 + (size_t)NGU * D * 2;
constexpr size_t WS_ROPE = WS_WD1 + (size_t)D * DFF * 2;
constexpr size_t WS_SSP  = WS_ROPE + al256((size_t)LTOK * 32 * 2 * 4);
constexpr size_t WS_H    = WS_SSP + (size_t)MP * 16 * 4;
constexpr size_t WS_XB   = WS_H + (size_t)MP * D * 4;
constexpr size_t WS_BIG  = WS_XB + (size_t)MP * D * 2;
constexpr size_t WS_O    = WS_BIG + (size_t)MP * NQKV * 2;
constexpr size_t WS_CTL  = WS_O + (size_t)MP * D * 2;
constexpr size_t CTL_BYTES = 16384;
constexpr size_t WS_END  = WS_CTL + CTL_BYTES;
constexpr int LDS_BYTES = 147456;
static_assert(att::ATT_LDS <= LDS_BYTES && pg8::STAGE_BYTES <= LDS_BYTES, "LDS map");

__device__ __forceinline__ unsigned f2bf(float f) { unsigned u = __builtin_bit_cast(unsigned, f); return (u + 0x7fffu + ((u >> 16) & 1u)) >> 16; }
__device__ __forceinline__ unsigned pk2(float lo, float hi) { return f2bf(lo) | (f2bf(hi) << 16); }
__device__ __forceinline__ float wave_sum(float v) {
#pragma unroll
    for (int o = 1; o < 64; o <<= 1) v += __shfl_xor(v, o);
    return v;
}
__device__ __forceinline__ float wave_max(float v) {
#pragma unroll
    for (int o = 1; o < 64; o <<= 1) v = fmaxf(v, __shfl_xor(v, o));
    return v;
}
__device__ __forceinline__ int col_perm(int mode, int n) {
    if (mode == 1) return (n & ~255) + 128 * ((n >> 5) & 1) + 32 * ((n >> 6) & 3) + (n & 31);
    if (mode == 2) { const int up = n >= DFF ? 1 : 0, j = n - up * DFF; return 256 * (j >> 7) + 128 * up + (j & 127); }
    if (mode == 3) { if (n < 1024) return 2048 + n; const int up = n >= 2048 ? 1 : 0, j = (n - 1024) & 1023; return 256 * (j >> 7) + 128 * up + (j & 127); }
    return n;
}
__device__ __forceinline__ void transpose_item(const float* W, int K, int N, bf16* WT, const float* gain, int mode, LAS float* scr, int item, int lane) {
    const int nblk = N / 32, kb = item / nblk, nb = item % nblk, k0 = 64 * kb, n0 = 32 * nb;
#pragma unroll 8
    for (int i = 0; i < 32; ++i) { const int kk = 2 * i + (lane >> 5); scr[kk * 33 + (lane & 31)] = W[(size_t)(k0 + kk) * N + n0 + (lane & 31)]; }
    asm volatile("s_waitcnt lgkmcnt(0)" ::: "memory");
    const int c = lane & 7;
    float gv[8];
#pragma unroll
    for (int e = 0; e < 8; ++e) gv[e] = gain ? gain[k0 + 8 * c + e] : 1.0f;
#pragma unroll
    for (int j = 0; j < 4; ++j) { const int n = (lane >> 3) + 8 * j; const LAS float* s = scr + (8 * c) * 33 + n;
        v4u o; o.x = pk2(s[0 * 33] * gv[0], s[1 * 33] * gv[1]); o.y = pk2(s[2 * 33] * gv[2], s[3 * 33] * gv[3]); o.z = pk2(s[4 * 33] * gv[4], s[5 * 33] * gv[5]); o.w = pk2(s[6 * 33] * gv[6], s[7 * 33] * gv[7]);
        *(v4u*)(WT + (size_t)col_perm(mode, n0 + n) * K + k0 + 8 * c) = o; }
    asm volatile("s_waitcnt lgkmcnt(0)" ::: "memory");
}
__device__ __forceinline__ void sincos_acc(float angf, float& c, float& s) {
    const double TWO_PI = 6.283185307179586476925286766559;
    double a = (double)angf; const double n = rint(a / TWO_PI); double r = a - n * TWO_PI;
    const double r2 = r * r; double cs = 1.0, sn = r, tc = 1.0, ts = r;
#pragma unroll 1
    for (int k = 1; k <= 14; ++k) { tc = -tc * r2 / (double)((2 * k - 1) * (2 * k)); ts = -ts * r2 / (double)((2 * k) * (2 * k + 1)); cs += tc; sn += ts; }
    c = (float)cs; s = (float)sn;
}

#define XB_TMO      128
#define XB_XCNT(j)  (256  + 64 * (j))
#define XB_XSUB(j)  (1280 + 64 * (j))
#define XB_XGEN(j)  (2304 + 64 * (j))
#define XB_TOP      3328
#define XB_TOPGEN   3392
#define XCD_BAR_WORDS 3456
#define XB_SPIN_CAP (1u << 18)

__device__ __forceinline__ unsigned xb_ld(unsigned* p)              { return __hip_atomic_load(p, __ATOMIC_RELAXED, __HIP_MEMORY_SCOPE_AGENT); }
__device__ __forceinline__ unsigned xb_add(unsigned* p, unsigned v) { return __hip_atomic_fetch_add(p, v, __ATOMIC_RELAXED, __HIP_MEMORY_SCOPE_AGENT); }
__device__ __forceinline__ unsigned xb_xcc_id() { return (unsigned)__builtin_amdgcn_s_getreg((3 << 11) | 20) & 0xFu; }
#define XB_SPIN(cond, bar) do { unsigned _sp = 0; while (cond) { __builtin_amdgcn_s_sleep(1); \
    if ((++_sp & 255u) == 0u) { if (xb_ld(&(bar)[XB_TMO])) break; if (_sp > XB_SPIN_CAP) { atomicAdd(&(bar)[XB_TMO], 1u); break; } } } } while (0)

struct XcdBarrier {
    unsigned* bar; unsigned x;
    volatile LAS unsigned* st;
};

__device__ __forceinline__ XcdBarrier xcd_barrier_post(unsigned* bar, volatile LAS unsigned* st) {
    XcdBarrier b; b.bar = bar; b.x = xb_xcc_id(); b.st = st;
    if (threadIdx.x == 0) (void)xb_add(&bar[XB_XCNT(b.x)], 1u);
    return b;
}
__device__ __forceinline__ void xcd_barrier_complete(unsigned* bar, unsigned x, unsigned& nloc, unsigned& nx) {
    const unsigned G = gridDim.x * gridDim.y * gridDim.z;
    unsigned sum, cnt, mine, sp = 0u;
    for (;;) {
        sum = 0u; cnt = 0u; mine = 0u;
#pragma unroll
        for (unsigned j = 0; j < 16; ++j) { const unsigned c = xb_ld(&bar[XB_XCNT(j)]); sum += c; cnt += (c > 0u) ? 1u : 0u; mine = (j == x) ? c : mine; }
        if (sum == G) break;
        __builtin_amdgcn_s_sleep(1);
        if ((++sp & 255u) == 0u) { if (xb_ld(&bar[XB_TMO])) break; if (sp > XB_SPIN_CAP) { atomicAdd(&bar[XB_TMO], 1u); break; } }
    }
    nloc = mine > 0u ? mine : 1u; nx = cnt > 0u ? cnt : 1u;
}

__device__ __forceinline__ void xcd_barrier(const XcdBarrier& b) {
    asm volatile("s_waitcnt vmcnt(0)" ::: "memory");
    __syncthreads();
    if (threadIdx.x == 0) {
        unsigned* bar = b.bar;
        __builtin_amdgcn_s_waitcnt(0);
        unsigned nloc = b.st[0], nx = b.st[1];
        if (nloc == 0u) { xcd_barrier_complete(bar, b.x, nloc, nx); b.st[0] = nloc; b.st[1] = nx; }
        const unsigned old = xb_add(&bar[XB_XSUB(b.x)], 1u);
        const unsigned gen = old / nloc;
        if (old + 1u == (gen + 1u) * nloc) {
            __builtin_amdgcn_fence(__ATOMIC_RELEASE, "agent");
            asm volatile("s_waitcnt vmcnt(0)" ::: "memory");
            const unsigned og = xb_add(&bar[XB_TOP], 1u);
            const unsigned tg = og / nx;
            if (og + 1u == (tg + 1u) * nx) xb_add(&bar[XB_TOPGEN], 1u);
            else XB_SPIN(xb_ld(&bar[XB_TOPGEN]) == tg, bar);
            __builtin_amdgcn_fence(__ATOMIC_ACQUIRE, "agent");
            xb_add(&bar[XB_XGEN(b.x)], 1u);
            asm volatile("s_waitcnt vmcnt(0)" ::: "memory");
        } else {
            XB_SPIN(xb_ld(&bar[XB_XGEN(b.x)]) == gen, bar);
            __builtin_amdgcn_fence(__ATOMIC_ACQUIRE, "agent");
            asm volatile("s_waitcnt vmcnt(0)" ::: "memory");
        }
    }
    __syncthreads();
}

constexpr int MISC_OFF = LDS_BYTES - 64;
struct Args { const float* in[18]; float* out; unsigned char* ws; int ph_lo, ph_hi; };

__device__ __forceinline__ void prologue(const Args& a, LAS unsigned char* lds, int wave, int lane, int gw, int NGW) {
    unsigned char* ws = a.ws;
    LAS float* scr = (LAS float*)(lds + wave * 16384);
    const float* mix_g = a.in[2]; const float* ffn_g = a.in[3];
    constexpr int I_QKV = (D / 64) * (NQKV / 32), I_O = (D / 64) * (D / 32), I_GU = (D / 64) * (NGU / 32), I_DN = (DFF / 64) * (D / 32);
    constexpr int NITEMS = 2 * I_QKV + 2 * I_O + 2 * I_GU + 2 * I_DN;
    for (int it = gw; it < NITEMS; it += NGW) {
        int r = it;
        if (r < I_QKV) { transpose_item(a.in[4], D, NQKV, (bf16*)(ws + WS_WQKV), mix_g, 1, scr, r, lane); continue; } r -= I_QKV;
        if (r < I_O)   { transpose_item(a.in[12], D, D, (bf16*)(ws + WS_WO), nullptr, 0, scr, r, lane); continue; } r -= I_O;
        if (r < I_GU)  { transpose_item(a.in[16], D, NGU, (bf16*)(ws + WS_WGU0), ffn_g, 2, scr, r, lane); continue; } r -= I_GU;
        if (r < I_DN)  { transpose_item(a.in[17], DFF, D, (bf16*)(ws + WS_WD0), nullptr, 0, scr, r, lane); continue; } r -= I_DN;
        if (r < I_QKV) { transpose_item(a.in[13], D, NQKV, (bf16*)(ws + WS_WIN), mix_g + D, 3, scr, r, lane); continue; } r -= I_QKV;
        if (r < I_O)   { transpose_item(a.in[15], D, D, (bf16*)(ws + WS_WOUT), nullptr, 0, scr, r, lane); continue; } r -= I_O;
        if (r < I_GU)  { transpose_item(a.in[16] + (size_t)D * NGU, D, NGU, (bf16*)(ws + WS_WGU1), ffn_g + D, 2, scr, r, lane); continue; } r -= I_GU;
        transpose_item(a.in[17] + (size_t)DFF * D, DFF, D, (bf16*)(ws + WS_WD1), nullptr, 0, scr, r, lane);
    }
    { float* rope = (float*)(ws + WS_ROPE);
      for (int e = gw * 64 + lane; e < LTOK * 32; e += NGW * 64) { const int pos = e >> 5, i = e & 31;
          const float inv = (float)exp(-9.210340371976184 * (double)(2 * i) / 64.0);
          const float ang = (float)pos * inv; float c, s; sincos_acc(ang, c, s); rope[2 * e] = c; rope[2 * e + 1] = s; } }
    { const float* x = a.in[0]; const float* meta = a.in[1]; float* H = (float*)(ws + WS_H); bf16* XB = (bf16*)(ws + WS_XB); float* ssp = (float*)(ws + WS_SSP);
      for (int m = gw; m < MP; m += NGW) { const int b = m / LP, p = m - b * LP;
          const float* src = p < PADF ? nullptr : (p < 64 ? meta + (size_t)(p - PADF) * D : x + ((size_t)b * SEQ + (p - 64)) * D);
          f32x4 v[4]; float s = 0.f;
#pragma unroll
          for (int j = 0; j < 4; ++j) { v[j] = src ? *((const f32x4*)src + 64 * j + lane) : (f32x4){0.f, 0.f, 0.f, 0.f}; s += (v[j][0] * v[j][0] + v[j][1] * v[j][1]) + (v[j][2] * v[j][2] + v[j][3] * v[j][3]); }
          s = wave_sum(s);
#pragma unroll
          for (int j = 0; j < 4; ++j) { *((f32x4*)(H + (size_t)m * D) + 64 * j + lane) = v[j];
              *((unsigned long long*)(XB + (size_t)m * D) + 64 * j + lane) = (unsigned long long)pk2(v[j][0], v[j][1]) | ((unsigned long long)pk2(v[j][2], v[j][3]) << 32); }
          if (lane < 16) ssp[(size_t)m * 16 + lane] = lane == 0 ? s : 0.f; } }
}
__device__ __forceinline__ void conv_phase(const Args& a, int lane, int gw, int NGW) {
    const bf16* Z = (const bf16*)(a.ws + WS_BIG); const bf16* GB = Z + (size_t)MP * D; bf16* Y = (bf16*)(a.ws + WS_O); const float* cw = a.in[14];
    for (int it = gw; it < (MP / 16) * 2; it += NGW) {
        const int rb = it >> 1, col = (it & 1) * 512 + lane * 8, row0 = rb * 16, p0 = row0 % LP;
        float w0[8], w1[8], w2[8], zm2[8], zm1[8];
#pragma unroll
        for (int e = 0; e < 8; ++e) { w0[e] = cw[col + e]; w1[e] = cw[D + col + e]; w2[e] = cw[2 * D + col + e]; zm2[e] = 0.f; zm1[e] = 0.f; }
        if (p0 != 0) { const v4u a2 = *(const v4u*)(Z + (size_t)(row0 - 2) * D + col), a1 = *(const v4u*)(Z + (size_t)(row0 - 1) * D + col);
#pragma unroll
            for (int e = 0; e < 4; ++e) { zm2[2 * e] = __uint_as_float(a2[e] << 16); zm2[2 * e + 1] = __uint_as_float(a2[e] & 0xffff0000u); zm1[2 * e] = __uint_as_float(a1[e] << 16); zm1[2 * e + 1] = __uint_as_float(a1[e] & 0xffff0000u); } }
#pragma unroll 4
        for (int i = 0; i < 16; ++i) { const size_t off = (size_t)(row0 + i) * D + col; const v4u zz = *(const v4u*)(Z + off), gg = *(const v4u*)(GB + off);
            float z[8], g[8], y[8];
#pragma unroll
            for (int e = 0; e < 4; ++e) { z[2 * e] = __uint_as_float(zz[e] << 16); z[2 * e + 1] = __uint_as_float(zz[e] & 0xffff0000u); g[2 * e] = __uint_as_float(gg[e] << 16); g[2 * e + 1] = __uint_as_float(gg[e] & 0xffff0000u); }
#pragma unroll
            for (int e = 0; e < 8; ++e) { y[e] = g[e] * (w0[e] * zm2[e] + w1[e] * zm1[e] + w2[e] * z[e]); zm2[e] = zm1[e]; zm1[e] = z[e]; }
            v4u o; o.x = pk2(y[0], y[1]); o.y = pk2(y[2], y[3]); o.z = pk2(y[4], y[5]); o.w = pk2(y[6], y[7]);
            *(v4u*)(Y + off) = o; }
    }
}

__global__ void __launch_bounds__(NWAVES * 64, 2) mega_fwd(Args args) {
    extern __shared__ __attribute__((aligned(16))) unsigned char lds_raw[];
    LAS unsigned char* lds = (LAS unsigned char*)lds_raw;
    cg::grid_group grid = cg::this_grid();
    const int wave = __builtin_amdgcn_readfirstlane(threadIdx.x >> 6);
    const int G = gridDim.x, gw = blockIdx.x * NWAVES + wave, NGW = G * NWAVES;
    unsigned char* ws = args.ws;
    float* H = (float*)(ws + WS_H); bf16* XB = (bf16*)(ws + WS_XB); float* SSP = (float*)(ws + WS_SSP); bf16* BIG = (bf16*)(ws + WS_BIG); bf16* OB = (bf16*)(ws + WS_O);
    const int lo = args.ph_lo, hi = args.ph_hi;
    if (threadIdx.x < 16) ((LAS unsigned*)(lds + MISC_OFF))[threadIdx.x] = 0u;
    __syncthreads();
    XcdBarrier bar = xcd_barrier_post((unsigned*)(ws + WS_CTL), (volatile LAS unsigned*)(lds + MISC_OFF));
#ifndef PHASE_MASK
#define PHASE_MASK 0x7ff
#endif
#define IN(k) (((PHASE_MASK >> (k)) & 1) && lo <= (k) && (k) < hi)
#define SEAM(k) do { if (IN(k) && IN((k) + 1)) { if ((k) == 0) grid.sync(); else xcd_barrier(bar); } } while (0)
    if (IN(0)) { prologue(args, lds, wave, pg8::lane_id_v(), gw, NGW); }
    SEAM(0);
    if (IN(1)) {
        pg8::Gemm g{XB, (const bf16*)(ws + WS_WQKV), MP, NQKV, D}; pg8::StaticOrder S; S.init(MP, NQKV, G, (int)blockIdx.x);
        pg8::EpiQKV E{BIG, SSP, (const float*)(ws + WS_ROPE), args.in[5], args.in[6]};
        pg8::gemm_phase<pg8::EpiQKV, pg8::StaticOrder, true, true>(lds, g, S, E, wave);
    }
    SEAM(1);
    if (IN(2)) {
        const int lane = pg8::lane_id_v();
        float s1 = wave_sum(args.in[7][lane] * args.in[8][lane]), s2 = wave_sum(args.in[9][lane] * args.in[10][lane]);
        const float lam = expf(s1) - expf(s2) + 0.2f;
        for (int bh = blockIdx.x; bh < NB * 8; bh += G) { const int b = bh >> 3, h = bh & 7;
#pragma unroll 1
            for (int j = -1; j < 8; ++j) att::attn_unit(lds, BIG, OB, b, h, j < 0 ? 0 : 64 + 256 * j, j < 0 ? 2 : 8, lam, args.in[11], wave); }
    }
    SEAM(2);
    if (IN(3)) {
        pg8::Gemm g{OB, (const bf16*)(ws + WS_WO), MP, D, D}; pg8::StaticOrder S; S.init(MP, D, G, (int)blockIdx.x);
        pg8::EpiRes<false> E{H, XB, SSP, nullptr};
        pg8::gemm_phase<pg8::EpiRes<false>, pg8::StaticOrder, true, true>(lds, g, S, E, wave);
    }
    SEAM(3);
    if (IN(4)) {
        pg8::Gemm g{XB, (const bf16*)(ws + WS_WGU0), MP, NGU, D}; pg8::StaticOrder S; S.init(MP, NGU, G, (int)blockIdx.x);
        pg8::EpiGateUp E{BIG, SSP};
        pg8::gemm_phase<pg8::EpiGateUp, pg8::StaticOrder, true, true>(lds, g, S, E, wave);
    }
    SEAM(4);
    if (IN(5)) {
        pg8::Gemm g{BIG, (const bf16*)(ws + WS_WD0), MP, D, DFF}; pg8::StaticOrder S; S.init(MP, D, G, (int)blockIdx.x);
        pg8::EpiRes<false> E{H, XB, SSP, nullptr};
        pg8::gemm_phase<pg8::EpiRes<false>, pg8::StaticOrder, true, true>(lds, g, S, E, wave);
    }
    SEAM(5);
    if (IN(6)) {
        pg8::Gemm g{XB, (const bf16*)(ws + WS_WIN), MP, NQKV, D}; pg8::StaticOrder S; S.init(MP, NQKV, G, (int)blockIdx.x);
        pg8::EpiWin E{BIG, BIG + (size_t)MP * D, SSP};
        pg8::gemm_phase<pg8::EpiWin, pg8::StaticOrder, true, true>(lds, g, S, E, wave);
    }
    SEAM(6);
    if (IN(7)) { conv_phase(args, pg8::lane_id_v(), gw, NGW); }
    SEAM(7);
    if (IN(8)) {
        pg8::Gemm g{OB, (const bf16*)(ws + WS_WOUT), MP, D, D}; pg8::StaticOrder S; S.init(MP, D, G, (int)blockIdx.x);
        pg8::EpiRes<false> E{H, XB, SSP, nullptr};
        pg8::gemm_phase<pg8::EpiRes<false>, pg8::StaticOrder, true, true>(lds, g, S, E, wave);
    }
    SEAM(8);
    if (IN(9)) {
        pg8::Gemm g{XB, (const bf16*)(ws + WS_WGU1), MP, NGU, D}; pg8::StaticOrder S; S.init(MP, NGU, G, (int)blockIdx.x);
        pg8::EpiGateUp E{BIG, SSP};
        pg8::gemm_phase<pg8::EpiGateUp, pg8::StaticOrder, true, true>(lds, g, S, E, wave);
    }
    SEAM(9);
    if (IN(10)) {
        pg8::Gemm g{BIG, (const bf16*)(ws + WS_WD1), MP, D, DFF}; pg8::StaticOrder S; S.init(MP, D, G, (int)blockIdx.x);
        pg8::EpiRes<true> E{H, nullptr, nullptr, args.out};
        pg8::gemm_phase<pg8::EpiRes<true>, pg8::StaticOrder, true, true>(lds, g, S, E, wave);
    }
#undef IN
#undef SEAM
}

extern "C" void kernel_launch(void* const* d_in, const int* in_sizes, int n_in, void* d_out, int out_size, void* d_ws, size_t ws_size, hipStream_t stream) {
    static int grid = 0;
    if (grid == 0) {
        if (n_in != 18 || ws_size < WS_END) { fprintf(stderr, "kernel_launch: need 18 inputs and %zu bytes of workspace (got %d, %zu)\n", (size_t)WS_END, n_in, ws_size); grid = -1; return; }
        int dev = 0, cus = 0, per_cu = 0;
        hipGetDevice(&dev); hipDeviceGetAttribute(&cus, hipDeviceAttributeMultiprocessorCount, dev);
        if (hipFuncSetAttribute((const void*)mega_fwd, hipFuncAttributeMaxDynamicSharedMemorySize, LDS_BYTES) != hipSuccess) { fprintf(stderr, "kernel_launch: hipFuncSetAttribute failed\n"); grid = -1; return; }
        if (hipOccupancyMaxActiveBlocksPerMultiprocessor(&per_cu, (const void*)mega_fwd, NWAVES * 64, LDS_BYTES) != hipSuccess || per_cu < 1) { fprintf(stderr, "kernel_launch: occupancy query says %d\n", per_cu); per_cu = 1; }
        (void)hipGetLastError();
        grid = cus * per_cu;
    }
    if (grid < 0) return;
    Args a{};
    for (int i = 0; i < 18; ++i) a.in[i] = (const float*)d_in[i];
    a.out = (float*)d_out; a.ws = (unsigned char*)d_ws;
#if MK_PER_PHASE
    for (int p = 0; p < NPHASE; ++p) { a.ph_lo = p; a.ph_hi = p + 1; hipLaunchKernelGGL(mega_fwd, dim3(grid), dim3(NWAVES * 64), LDS_BYTES, stream, a); }
#else
    a.ph_lo = 0; a.ph_hi = NPHASE;
    if (hipMemsetAsync((char*)d_ws + WS_CTL, 0, CTL_BYTES, stream) != hipSuccess) { fprintf(stderr, "kernel_launch: memset failed\n"); return; }
    void* kargs[] = {&a};
    hipError_t e = hipLaunchCooperativeKernel((const void*)mega_fwd, dim3(grid), dim3(NWAVES * 64), kargs, LDS_BYTES, stream);
    if (e != hipSuccess) fprintf(stderr, "kernel_launch: cooperative launch failed: %s (grid %d)\n", hipGetErrorString(e), grid);
#endif
}
```

```cpp
#include <hip/hip_runtime.h>
#include <hip/hip_cooperative_groups.h>
#include <cstdio>
#include <cstdint>
namespace cg = cooperative_groups;
namespace pg8 {
#define PG8_LAS __attribute__((address_space(3)))
typedef unsigned short bf16_t;
typedef short bf16x8 __attribute__((ext_vector_type(8)));
typedef float f32x4 __attribute__((ext_vector_type(4)));
typedef unsigned u32x4 __attribute__((ext_vector_type(4)));
constexpr int BM = 256, BK = 64, HALF = 128, HTB = HALF * BK * 2  , STAGE_BYTES = 8 * HTB, NXCD = 8, WGM = 8;

__host__ __device__ __forceinline__ int lds_byte(int r, int c) { const int st = (r >> 4) * 2 + (c >> 5), rr = r & 15, cc = c & 31, ob = rr * 64 + cc * 2; return st * 1024 + (ob ^ (((ob >> 9) & 1) << 5)); }
__host__ __device__ __forceinline__ void stage_rc(int b, int& R, int& C) { const int st = b / 1024, sb = b % 1024, swz = sb ^ (((sb >> 9) & 1) << 5); R = (st >> 1) * 16 + swz / 64; C = (st & 1) * 32 + (swz % 64) / 2; }
__host__ __device__ __forceinline__ int perm32(int rho) { const int n = rho >> 4, i = rho & 15; return 8 * (i >> 2) + 4 * n + (i & 3); }

struct Unit { int pm, pn; };
struct Gemm { const bf16_t* A; const bf16_t* Bt; int M, N, K; };

struct StaticOrder {
    int nM, nN, nwg, G, c;
    __host__ __device__ void init(int M, int N, int G_, int c_) { nM = M / BM; nN = N / BM; nwg = nM * nN; G = G_; c = c_; }
    __host__ __device__ bool next(int i, Unit& u) const {
        const long L = (long)i * G + c; if (L >= nwg) return false;
        int wgid = (int)L; { const int q = nwg / NXCD, r = nwg % NXCD, xcd = wgid % NXCD, off = wgid / NXCD; wgid = (xcd < r ? xcd * (q + 1) : r * (q + 1) + (xcd - r) * q) + off; }
        const int nig = WGM * nN, gid = wgid / nig, fm = gid * WGM, gsz = (nM - fm) < WGM ? (nM - fm) : WGM;
        u.pm = fm + ((wgid % nig) % gsz); u.pn = (wgid % nig) / gsz; return true;
    }
    __device__ __forceinline__ void a_ready(const Unit&) const {}
    __device__ __forceinline__ void done(const Unit&) const {}
};
__device__ __forceinline__ unsigned cvt_pk_bf16(float lo, float hi) { unsigned r; asm volatile("v_cvt_pk_bf16_f32 %0, %1, %2" : "=v"(r) : "v"(lo), "v"(hi)); return r; }
typedef unsigned u32x2 __attribute__((ext_vector_type(2)));
__device__ __forceinline__ int lane_id_v() { int l; asm volatile("v_mbcnt_lo_u32_b32 %0, -1, 0\n\tv_mbcnt_hi_u32_b32 %0, -1, %0" : "=v"(l)); return l; }
constexpr int LP_ = 2048, NMETA_ = 16;
constexpr float QSCALE_ = 0.125f * 1.4426950408889634f;
__device__ __forceinline__ float row_rstd(const float* ssp, int row) {
    const f32x4* p = (const f32x4*)(ssp + (size_t)row * 16);
    const f32x4 a = p[0], b = p[1], c = p[2], d = p[3];
    const float s = (((a[0] + a[1]) + (a[2] + a[3])) + ((b[0] + b[1]) + (b[2] + b[3]))) + (((c[0] + c[1]) + (c[2] + c[3])) + ((d[0] + d[1]) + (d[2] + d[3])));
    return rsqrtf(s * (1.0f / 1024.0f) + 1e-6f);
}
__device__ __forceinline__ u32x4 pack8(const f32x4 v0, const f32x4 v1) { u32x4 w; w.x = cvt_pk_bf16(v0[0], v0[1]); w.y = cvt_pk_bf16(v0[2], v0[3]); w.z = cvt_pk_bf16(v1[0], v1[1]); w.w = cvt_pk_bf16(v1[2], v1[3]); return w; }

struct EpiQKV {
    static constexpr bool PERM = true, AFTER_DRAIN = false;
    bf16_t* QKV; const float* ssp; const float* rope; const float* qg; const float* kg;
    __device__ __forceinline__ void operator()(const f32x4 (&acc)[2][2][4][2], const Unit& u, int wr, int wc, int fr, int fq) const {
        const int row0 = u.pm * BM + wr * 64 + fr, pn = u.pn;
        const int colbase = pn * 256 + wc * 64 + 8 * fq;
        if (pn < 8) {
            const float* gp = (pn < 4) ? qg : kg; const float osc = (pn < 4) ? QSCALE_ : 1.0f;
            f32x4 g[2][2];
#pragma unroll
            for (int bj = 0; bj < 2; ++bj)
#pragma unroll
                for (int n = 0; n < 2; ++n) g[bj][n] = *(const f32x4*)(gp + 32 * bj + 8 * fq + 4 * n);
#pragma unroll
            for (int ai = 0; ai < 2; ++ai)
#pragma unroll
                for (int m = 0; m < 4; ++m) {
                    const int row = row0 + ai * HALF + m * 16; const float rs = row_rstd(ssp, row);
                    f32x4 v[2][2]; float ss = 0.f;
#pragma unroll
                    for (int bj = 0; bj < 2; ++bj)
#pragma unroll
                        for (int n = 0; n < 2; ++n) { v[bj][n] = acc[ai][bj][m][n] * rs; const f32x4 x = v[bj][n]; ss += (x[0] * x[0] + x[1] * x[1]) + (x[2] * x[2] + x[3] * x[3]); }
                    ss += __shfl_xor(ss, 16); ss += __shfl_xor(ss, 32);
                    const float rn = rsqrtf(ss * (1.0f / 64.0f) + 1e-6f);
#pragma unroll
                    for (int bj = 0; bj < 2; ++bj)
#pragma unroll
                        for (int n = 0; n < 2; ++n) v[bj][n] = v[bj][n] * rn * g[bj][n];
                    const int pos = (row % LP_) + NMETA_;
                    const f32x4* rp = (const f32x4*)(rope + ((size_t)pos * 32 + 8 * fq) * 2);
                    f32x4 o1[2], o2[2];
#pragma unroll
                    for (int n = 0; n < 2; ++n) { const f32x4 ca = rp[2 * n], cb = rp[2 * n + 1];
                        const f32x4 x1 = v[0][n], x2 = v[1][n];
                        o1[n][0] = (x1[0] * ca[0] - x2[0] * ca[1]) * osc; o2[n][0] = (x2[0] * ca[0] + x1[0] * ca[1]) * osc;
                        o1[n][1] = (x1[1] * ca[2] - x2[1] * ca[3]) * osc; o2[n][1] = (x2[1] * ca[2] + x1[1] * ca[3]) * osc;
                        o1[n][2] = (x1[2] * cb[0] - x2[2] * cb[1]) * osc; o2[n][2] = (x2[2] * cb[0] + x1[2] * cb[1]) * osc;
                        o1[n][3] = (x1[3] * cb[2] - x2[3] * cb[3]) * osc; o2[n][3] = (x2[3] * cb[2] + x1[3] * cb[3]) * osc; }
                    bf16_t* rowp = QKV + (size_t)row * 3072 + colbase;
                    *(u32x4*)(rowp) = pack8(o1[0], o1[1]); *(u32x4*)(rowp + 32) = pack8(o2[0], o2[1]);
                }
        } else {
#pragma unroll
            for (int ai = 0; ai < 2; ++ai)
#pragma unroll
                for (int m = 0; m < 4; ++m) {
                    const int row = row0 + ai * HALF + m * 16; const float rs = row_rstd(ssp, row);
                    bf16_t* rowp = QKV + (size_t)row * 3072 + colbase;
#pragma unroll
                    for (int bj = 0; bj < 2; ++bj) *(u32x4*)(rowp + 32 * bj) = pack8(acc[ai][bj][m][0] * rs, acc[ai][bj][m][1] * rs);
                }
        }
    }
};
struct EpiGateUp {
    static constexpr bool PERM = true, AFTER_DRAIN = false;
    bf16_t* HID; const float* ssp;
    __device__ __forceinline__ void operator()(const f32x4 (&acc)[2][2][4][2], const Unit& u, int wr, int wc, int fr, int fq) const {
        const int row0 = u.pm * BM + wr * 64 + fr; const int col = u.pn * 128 + wc * 32 + 8 * fq;
#pragma unroll
        for (int ai = 0; ai < 2; ++ai)
#pragma unroll
            for (int m = 0; m < 4; ++m) {
                const int row = row0 + ai * HALF + m * 16; const float rs = row_rstd(ssp, row);
                f32x4 hv[2];
#pragma unroll
                for (int n = 0; n < 2; ++n) { const f32x4 g = acc[ai][0][m][n] * rs, uu = acc[ai][1][m][n] * rs;
#pragma unroll
                    for (int e = 0; e < 4; ++e) { const float sg = __builtin_amdgcn_rcpf(1.0f + __expf(-g[e])); hv[n][e] = g[e] * sg * uu[e]; } }
                *(u32x4*)(HID + (size_t)row * 2816 + col) = pack8(hv[0], hv[1]);
            }
    }
};
struct EpiWin {
    static constexpr bool PERM = true, AFTER_DRAIN = false;
    bf16_t* Z; bf16_t* GB; const float* ssp;
    __device__ __forceinline__ void operator()(const f32x4 (&acc)[2][2][4][2], const Unit& u, int wr, int wc, int fr, int fq) const {
        const int row0 = u.pm * BM + wr * 64 + fr, pn = u.pn;
#pragma unroll
        for (int ai = 0; ai < 2; ++ai)
#pragma unroll
            for (int m = 0; m < 4; ++m) {
                const int row = row0 + ai * HALF + m * 16; const float rs = row_rstd(ssp, row);
                if (pn < 8) {
                    const float rs2 = rs * rs;
                    *(u32x4*)(Z + (size_t)row * 1024 + pn * 128 + wc * 32 + 8 * fq) = pack8(acc[ai][0][m][0] * acc[ai][1][m][0] * rs2, acc[ai][0][m][1] * acc[ai][1][m][1] * rs2);
                } else {
                    bf16_t* rowp = GB + (size_t)row * 1024 + (pn - 8) * 256 + wc * 32 + 8 * fq;
#pragma unroll
                    for (int bj = 0; bj < 2; ++bj) *(u32x4*)(rowp + 128 * bj) = pack8(acc[ai][bj][m][0] * rs, acc[ai][bj][m][1] * rs);
                }
            }
    }
};
template <bool FINAL> struct EpiRes {
    static constexpr bool PERM = true, AFTER_DRAIN = false;
    const float* base; float* H; bf16_t* XB; float* ssp; float* out;
    __device__ __forceinline__ void operator()(const f32x4 (&acc)[2][2][4][2], const Unit& u, int wr, int wc, int fr, int fq) const {
        const int row0 = u.pm * BM + wr * 64 + fr; const int c0 = u.pn * 256 + wc * 32 + 8 * fq;
#pragma unroll
        for (int ai = 0; ai < 2; ++ai)
#pragma unroll
            for (int m = 0; m < 4; ++m) {
                const int row = row0 + ai * HALF + m * 16; float ss = 0.f;
                const float* hp = base + (size_t)row * 1024 + c0;
                f32x4 nv[2][2];
#pragma unroll
                for (int bj = 0; bj < 2; ++bj) { nv[bj][0] = *(const f32x4*)(hp + 128 * bj) + acc[ai][bj][m][0]; nv[bj][1] = *(const f32x4*)(hp + 128 * bj + 4) + acc[ai][bj][m][1]; }
                if (!FINAL) {
#pragma unroll
                    for (int bj = 0; bj < 2; ++bj) {
                        *(f32x4*)(H + (size_t)row * 1024 + c0 + 128 * bj) = nv[bj][0]; *(f32x4*)(H + (size_t)row * 1024 + c0 + 128 * bj + 4) = nv[bj][1];
                        *(u32x4*)(XB + (size_t)row * 1024 + c0 + 128 * bj) = pack8(nv[bj][0], nv[bj][1]);
#pragma unroll
                        for (int n = 0; n < 2; ++n) { const f32x4 x = nv[bj][n]; ss += (x[0] * x[0] + x[1] * x[1]) + (x[2] * x[2] + x[3] * x[3]); }
                    }
                    ss += __shfl_xor(ss, 16); ss += __shfl_xor(ss, 32);
                    if (fq == 0) ssp[(size_t)row * 16 + 4 * u.pn + wc] = ss;
                } else {
                    float* op = out + (size_t)row * 1024 + c0;
#pragma unroll
                    for (int bj = 0; bj < 2; ++bj) { *(f32x4*)(op + 128 * bj) = nv[bj][0]; *(f32x4*)(op + 128 * bj + 4) = nv[bj][1]; }
                }
            }
    }
};
template <class Epi, class Sched, bool ALIGN_EPI = false, bool SP2 = false>
__device__ __forceinline__ void gemm_phase(PG8_LAS unsigned char* lds, const Gemm g, const Sched& S, const Epi& E, const int wid) {
    const int lane = lane_id_v(), tid = wid * 64 + lane, wr = wid >> 2, wc = wid & 3, fr = lane & 15, fq = lane >> 4;
    const int K = g.K, nt = K / BK;
    unsigned voffA[2], voffB[2];
#pragma unroll
    for (int i = 0; i < 2; ++i) { int R, C; stage_rc(tid * 16 + i * 8192, R, C); const int Rb = Epi::PERM ? ((R & ~31) + perm32(R & 31)) : R;
        voffA[i] = (unsigned)(R * K + C) * 2u; voffB[i] = (unsigned)(Rb * K + C) * 2u; }
    const size_t kstep = (size_t)(BK * 2);
    const size_t hstep = (size_t)HALF * K * 2;
    const size_t tstep = 2 * hstep;
    const unsigned ldsw = (unsigned)wid * 1024u;
    const int aoff = lds_byte(wr * 64 + fr, fq * 8), boff = lds_byte(wc * 32 + fr, fq * 8);
#define PG8_SA(b, h) (((b) * 2 + (h)) * HTB)
#define PG8_SB(b, h) ((4 + (b) * 2 + (h)) * HTB)
#define PG8_STAGE(bufoff, gbase, voff) do { _Pragma("unroll") for (int _i = 0; _i < 2; ++_i) \
        __builtin_amdgcn_global_load_lds((const unsigned*)((const char*)(gbase) + (voff)[_i]), (PG8_LAS unsigned*)(lds + (bufoff) + ldsw + _i * 8192), 16, 0, 0); } while (0)
#define PG8_LDA(dst, b, h) do { _Pragma("unroll") for (int m = 0; m < 4; ++m) _Pragma("unroll") for (int k = 0; k < 2; ++k) dst[m][k] = *(const PG8_LAS bf16x8*)(lds + PG8_SA(b, h) + aoff + m * 2048 + k * 1024); } while (0)
#define PG8_LDB(dst, b, h) do { _Pragma("unroll") for (int n = 0; n < 2; ++n) _Pragma("unroll") for (int k = 0; k < 2; ++k) dst[n][k] = *(const PG8_LAS bf16x8*)(lds + PG8_SB(b, h) + boff + n * 2048 + k * 1024); } while (0)
#define PG8_MMA(ai, bj, At, Bt) do { __builtin_amdgcn_s_setprio(1); _Pragma("unroll") for (int m = 0; m < 4; ++m) _Pragma("unroll") for (int n = 0; n < 2; ++n) _Pragma("unroll") for (int k = 0; k < 2; ++k) \
        acc[ai][bj][m][n] = __builtin_amdgcn_mfma_f32_16x16x32_bf16(Bt[n][k], At[m][k], acc[ai][bj][m][n], 0, 0, 0); __builtin_amdgcn_s_setprio(0); } while (0)
#define PG8_WAIT_V(n) asm volatile("s_waitcnt vmcnt(" #n ")" ::: "memory")
#define PG8_WAIT_L(n) asm volatile("s_waitcnt lgkmcnt(" #n ")" ::: "memory")
#define PG8_BAR __builtin_amdgcn_s_barrier()
#define PG8_SCHED __builtin_amdgcn_sched_barrier(0)
    Unit cur, nxt; int ui = 0;
    if (!S.next(0, cur)) return;
    f32x4 acc[2][2][4][2];
#pragma unroll
    for (int a = 0; a < 2; ++a)
#pragma unroll
        for (int b = 0; b < 2; ++b)
#pragma unroll
            for (int m = 0; m < 4; ++m)
#pragma unroll
                for (int n = 0; n < 2; ++n) acc[a][b][m][n] = (f32x4){0.f, 0.f, 0.f, 0.f};
    bf16x8 At[4][2], B0[2][2], B1[2][2];
    const char* cA = (const char*)g.A + (size_t)cur.pm * tstep; const char* cB = (const char*)g.Bt + (size_t)cur.pn * tstep;
    S.a_ready(cur);
    if constexpr (SP2) {
        PG8_STAGE(PG8_SB(0, 0), cB, voffB); PG8_STAGE(PG8_SB(0, 1), cB + hstep, voffB); PG8_STAGE(PG8_SA(0, 0), cA, voffA); PG8_STAGE(PG8_SA(0, 1), cA + hstep, voffA);
        if (wr == 1) PG8_BAR;
        PG8_WAIT_V(2); PG8_BAR;
        PG8_STAGE(PG8_SB(1, 0), cB + kstep, voffB); PG8_STAGE(PG8_SA(1, 0), cA + kstep, voffA); PG8_STAGE(PG8_SB(1, 1), cB + hstep + kstep, voffB);
        PG8_WAIT_V(6); PG8_BAR;
    } else {
        PG8_STAGE(PG8_SB(0, 0), cB, voffB); PG8_STAGE(PG8_SA(0, 0), cA, voffA); PG8_STAGE(PG8_SB(0, 1), cB + hstep, voffB); PG8_STAGE(PG8_SA(0, 1), cA + hstep, voffA);
        if (wr == 1) PG8_BAR;
        PG8_WAIT_V(4); PG8_BAR;
        PG8_STAGE(PG8_SB(1, 0), cB + kstep, voffB); PG8_STAGE(PG8_SA(1, 0), cA + kstep, voffA); PG8_STAGE(PG8_SB(1, 1), cB + hstep + kstep, voffB);
        PG8_WAIT_V(6); PG8_BAR;
    }
    for (;;) {
        const bool has_next = S.next(ui + 1, nxt);
        const char* nA = has_next ? (const char*)g.A + (size_t)nxt.pm * tstep : cA; const char* nB = has_next ? (const char*)g.Bt + (size_t)nxt.pn * tstep : cB;
        for (int t = 0; t < nt; t += 2) {
            const bool last = (t == nt - 2);
            const char* a1 = cA + (size_t)(t + 1) * kstep;
            const char* a2 = last ? nA : cA + (size_t)(t + 2) * kstep; const char* b2 = last ? nB : cB + (size_t)(t + 2) * kstep;
            const char* a3 = a2 + kstep; const char* b3 = b2 + kstep;
            if (last && has_next) S.a_ready(nxt);
            if constexpr (SP2) {
            PG8_LDB(B0, 0, 0); PG8_LDB(B1, 0, 1); PG8_SCHED; PG8_LDA(At, 0, 0); PG8_STAGE(PG8_SA(1, 1), a1 + hstep, voffA);
            PG8_WAIT_V(8); PG8_WAIT_L(0); PG8_BAR; PG8_MMA(0, 0, At, B0); PG8_MMA(0, 1, At, B1); PG8_BAR; PG8_SCHED;
            PG8_LDA(At, 0, 1); PG8_STAGE(PG8_SB(0, 0), b2, voffB); PG8_STAGE(PG8_SB(0, 1), b2 + hstep, voffB); PG8_STAGE(PG8_SA(0, 0), a2, voffA);
            PG8_WAIT_V(8); PG8_WAIT_L(0); PG8_BAR; PG8_MMA(1, 0, At, B0); PG8_MMA(1, 1, At, B1); PG8_BAR; PG8_SCHED;
            PG8_LDB(B0, 1, 0); PG8_LDB(B1, 1, 1); PG8_SCHED; PG8_LDA(At, 1, 0); PG8_STAGE(PG8_SA(0, 1), a2 + hstep, voffA);
            PG8_WAIT_V(8); PG8_WAIT_L(0); PG8_BAR; PG8_MMA(0, 0, At, B0); PG8_MMA(0, 1, At, B1); PG8_BAR; PG8_SCHED;
            PG8_LDA(At, 1, 1); PG8_STAGE(PG8_SB(1, 0), b3, voffB); PG8_STAGE(PG8_SB(1, 1), b3 + hstep, voffB); PG8_STAGE(PG8_SA(1, 0), a3, voffA);
            PG8_WAIT_V(8); PG8_WAIT_L(0); PG8_BAR; PG8_MMA(1, 0, At, B0); PG8_MMA(1, 1, At, B1); PG8_BAR; PG8_SCHED;
            } else {
            PG8_LDB(B0, 0, 0); PG8_SCHED; PG8_LDA(At, 0, 0); PG8_STAGE(PG8_SA(1, 1), a1 + hstep, voffA);
            PG8_WAIT_L(8); PG8_BAR; PG8_WAIT_L(0); PG8_MMA(0, 0, At, B0); PG8_BAR; PG8_SCHED;
            PG8_LDB(B1, 0, 1); PG8_STAGE(PG8_SB(0, 0), b2, voffB);
            PG8_BAR; PG8_WAIT_L(0); PG8_MMA(0, 1, At, B1); PG8_BAR;
            PG8_LDA(At, 0, 1); PG8_STAGE(PG8_SA(0, 0), a2, voffA);
            PG8_BAR; PG8_WAIT_L(0); PG8_MMA(1, 0, At, B0); PG8_BAR; PG8_SCHED;
            PG8_STAGE(PG8_SB(0, 1), b2 + hstep, voffB);
            PG8_WAIT_V(6); PG8_BAR; PG8_MMA(1, 1, At, B1); PG8_BAR;
            PG8_LDB(B0, 1, 0); PG8_SCHED; PG8_LDA(At, 1, 0); PG8_STAGE(PG8_SA(0, 1), a2 + hstep, voffA);
            PG8_WAIT_L(8); PG8_BAR; PG8_WAIT_L(0); PG8_MMA(0, 0, At, B0); PG8_BAR; PG8_SCHED;
            PG8_LDB(B1, 1, 1); PG8_STAGE(PG8_SB(1, 0), b3, voffB);
            PG8_BAR; PG8_WAIT_L(0); PG8_MMA(0, 1, At, B1); PG8_BAR;
            PG8_LDA(At, 1, 1); PG8_STAGE(PG8_SA(1, 0), a3, voffA);
            PG8_BAR; PG8_WAIT_L(0); PG8_MMA(1, 0, At, B0); PG8_BAR; PG8_SCHED;
            PG8_STAGE(PG8_SB(1, 1), b3 + hstep, voffB);
            PG8_WAIT_V(6); PG8_BAR; PG8_MMA(1, 1, At, B1); PG8_BAR;
            }
        }
        if constexpr (ALIGN_EPI) { if (wr == 0) PG8_BAR; }
        if constexpr (!Epi::AFTER_DRAIN) { E(acc, cur, wr, wc, fr, fq); S.done(cur); }
        if (!has_next) break;
#pragma unroll
        for (int a = 0; a < 2; ++a)
#pragma unroll
            for (int b = 0; b < 2; ++b)
#pragma unroll
                for (int m = 0; m < 4; ++m)
#pragma unroll
                    for (int n = 0; n < 2; ++n) acc[a][b][m][n] = (f32x4){0.f, 0.f, 0.f, 0.f};
        cur = nxt; cA = nA; cB = nB; ++ui;
        if constexpr (ALIGN_EPI) { if (wr == 1) PG8_BAR; }
    }
    PG8_WAIT_V(0);
    if constexpr (!ALIGN_EPI) { if (wr == 0) PG8_BAR; }
    PG8_BAR;
    if constexpr (Epi::AFTER_DRAIN) { E.fused(acc, cur, wr, wc, fr, fq, lds, wid, lane); S.done(cur); }
#undef PG8_SA
#undef PG8_SB
#undef PG8_STAGE
#undef PG8_LDA
#undef PG8_LDB
#undef PG8_MMA
#undef PG8_WAIT_V
#undef PG8_WAIT_L
#undef PG8_BAR
#undef PG8_SCHED
}
}
namespace att {
#define LAS __attribute__((address_space(3)))
typedef unsigned short bf16_t;
typedef short bf16x8 __attribute__((ext_vector_type(8)));
typedef short s16x4 __attribute__((ext_vector_type(4)));
typedef float f32x16 __attribute__((ext_vector_type(16)));
typedef float f32x4 __attribute__((ext_vector_type(4)));
typedef unsigned u32x4 __attribute__((ext_vector_type(4)));
constexpr int LP = 2048, PADF = 48, PITCH = 3072;
constexpr int KV_BUF = 32768, V_OFF = 16384, OST_OFF = 65536, OST_PITCH = 272, OST_WAVE = 32 * OST_PITCH, WSF_OFF = OST_OFF + 8 * OST_WAVE, ATT_LDS = WSF_OFF + 8 * 256;
__device__ __forceinline__ int crow(int r, int hi) { return (r & 3) + 8 * (r >> 2) + 4 * hi; }
__device__ __forceinline__ unsigned cvtpk(float lo, float hi) { unsigned r; asm volatile("v_cvt_pk_bf16_f32 %0, %1, %2" : "=v"(r) : "v"(lo), "v"(hi)); return r; }
__device__ __forceinline__ s16x4 vtr(const LAS unsigned char* p) { return __builtin_bit_cast(s16x4, __builtin_amdgcn_ds_read_tr16_b64_v4i16((LAS s16x4*)p)); }

__device__ __forceinline__ void stage_tile(LAS unsigned char* lds, int bufoff, const bf16_t* QKV, const bf16_t* MQKV, long rowbase, int h, int t, int wid, int lane) {
    const bf16_t* src = (t == 0) ? MQKV : QKV + (size_t)(rowbase + 64 * (t - 1)) * PITCH;
#pragma unroll
    for (int i = 0; i < 2; ++i) {
        const int ci = 2 * wid + i;
        const bf16_t* ks = src + (size_t)lane * PITCH + 1024 + h * 128 + ci * 8;
        __builtin_amdgcn_global_load_lds((const unsigned*)ks, (LAS unsigned*)(lds + bufoff + ci * 1024), 16, 0, 0);
    }
#pragma unroll
    for (int i = 0; i < 2; ++i) {
        const int pi = 2 * wid + i, db = pi >> 2, kg = pi & 3;
        const bf16_t* vs = src + (size_t)(16 * kg + (lane >> 2)) * PITCH + 2048 + h * 128 + db * 32 + (lane & 3) * 8;
        __builtin_amdgcn_global_load_lds((const unsigned*)vs, (LAS unsigned*)(lds + bufoff + V_OFF + pi * 1024), 16, 0, 0);
    }
}

__device__ __forceinline__ void attn_unit(LAS unsigned char* lds, const bf16_t* QKV, const bf16_t* MQKV, bf16_t* O, int b, int h, int q0, int nqw, float lam, const float* subg, const int wid) {
    const int lane = pg8::lane_id_v(), r32 = lane & 31, hi = lane >> 5;
    const long rowbase = (long)b * LP;
    const int NT = (q0 + 32 * nqw) >> 6;
    const bool active = wid < nqw;
    const int qabs = q0 + 32 * wid + r32, qfirst = q0 + 32 * wid, qlast = qfirst + 31;
    LAS unsigned char* qw = lds + OST_OFF + wid * OST_WAVE + lane * 16;
    {
        const bf16_t* qp = QKV + (size_t)(rowbase + (active ? qabs - 64 : 0)) * PITCH + h * 128 + hi * 8;
#pragma unroll
        for (int j = 0; j < 8; ++j) *(LAS bf16x8*)(qw + j * 1024) = *(const bf16x8*)(qp + (j >> 2) * 64 + (j & 3) * 16);
    }
    f32x16 o[2][4];
#pragma unroll
    for (int c = 0; c < 2; ++c)
#pragma unroll
        for (int db = 0; db < 4; ++db)
#pragma unroll
            for (int r = 0; r < 16; ++r) o[c][db][r] = 0.f;
    float lsum[2] = {0.f, 0.f};
    stage_tile(lds, 0, QKV, MQKV, rowbase, h, 0, wid, lane);
    for (int t = 0; t < NT; ++t) {
        __syncthreads();
        const int buf = (t & 1) * KV_BUF;
        if (t + 1 < NT) stage_tile(lds, ((t + 1) & 1) * KV_BUF, QKV, MQKV, rowbase, h, t + 1, wid, lane);
        if (active && 64 * t <= qlast) {
            const bool needmask = (t == 0) || (64 * t + 63 > qfirst);
            const LAS unsigned char* kb = lds + buf + hi * 1024 + r32 * 16;
            const LAS unsigned char* vp = lds + buf + V_OFF + ((lane >> 4) & 1) * 32 + (lane & 3) * 8 + (4 * hi + ((lane & 15) >> 2)) * 64;
            int mhi = qabs - 64 * t - 4 * hi, mlo = PADF - 64 * t - 4 * hi;
            asm volatile("" : "+v"(mhi), "+v"(mlo));
#pragma unroll
            for (int c = 0; c < 2; ++c) {
                f32x16 p0, p1;
#pragma unroll
                for (int r = 0; r < 16; ++r) { p0[r] = 0.f; p1[r] = 0.f; }
#pragma unroll
                for (int d0 = 0; d0 < 4; ++d0) {
                    const bf16x8 k0 = *(const LAS bf16x8*)(kb + (c * 8 + 2 * d0) * 1024);
                    const bf16x8 k1 = *(const LAS bf16x8*)(kb + (c * 8 + 2 * d0) * 1024 + 512);
                    const bf16x8 qv = *(const LAS bf16x8*)(qw + (c * 4 + d0) * 1024);
                    p0 = __builtin_amdgcn_mfma_f32_32x32x16_bf16(k0, qv, p0, 0, 0, 0);
                    p1 = __builtin_amdgcn_mfma_f32_32x32x16_bf16(k1, qv, p1, 0, 0, 0);
                    if (d0 == 1) __builtin_amdgcn_sched_barrier(0);
                }
#pragma unroll
                for (int r = 0; r < 16; ++r) { p0[r] = __builtin_amdgcn_exp2f(p0[r]); p1[r] = __builtin_amdgcn_exp2f(p1[r]); }
                if (needmask) {
#pragma unroll
                    for (int r = 0; r < 16; ++r) { const int cr = (r & 3) + 8 * (r >> 2);
                        if (cr > mhi) p0[r] = 0.f;
                        if (cr + 32 > mhi) p1[r] = 0.f; }
                    if (t == 0) {
#pragma unroll
                        for (int r = 0; r < 16; ++r) { const int cr = (r & 3) + 8 * (r >> 2);
                            if (cr < mlo) p0[r] = 0.f;
                            if (cr + 32 < mlo) p1[r] = 0.f; }
                    }
                }
                float s = 0.f;
#pragma unroll
                for (int r = 0; r < 16; ++r) s += p0[r] + p1[r];
                lsum[c] += s;
                u32x4 pw[4];
                pw[0] = (u32x4){cvtpk(p0[0], p0[1]), cvtpk(p0[2], p0[3]), cvtpk(p0[4], p0[5]), cvtpk(p0[6], p0[7])};
                pw[1] = (u32x4){cvtpk(p0[8], p0[9]), cvtpk(p0[10], p0[11]), cvtpk(p0[12], p0[13]), cvtpk(p0[14], p0[15])};
                pw[2] = (u32x4){cvtpk(p1[0], p1[1]), cvtpk(p1[2], p1[3]), cvtpk(p1[4], p1[5]), cvtpk(p1[6], p1[7])};
                pw[3] = (u32x4){cvtpk(p1[8], p1[9]), cvtpk(p1[10], p1[11]), cvtpk(p1[12], p1[13]), cvtpk(p1[14], p1[15])};
                __builtin_amdgcn_sched_barrier(0);
#pragma unroll
                for (int db = 0; db < 4; ++db) {
#pragma unroll
                    for (int ks = 0; ks < 4; ++ks) {
                        const s16x4 lo = vtr(vp + db * 4096 + ks * 1024), hh = vtr(vp + db * 4096 + ks * 1024 + 512);
                        const bf16x8 vf = (bf16x8){lo[0], lo[1], lo[2], lo[3], hh[0], hh[1], hh[2], hh[3]};
                        o[c][db] = __builtin_amdgcn_mfma_f32_32x32x16_bf16(__builtin_bit_cast(bf16x8, pw[ks]), vf, o[c][db], 0, 0, 0);
                    }
                    __builtin_amdgcn_sched_barrier(0);
                }
            }
        }
    }
    if (active) {
        float l0 = lsum[0], l1 = lsum[1];
        l0 += __shfl_xor(l0, 32); l1 += __shfl_xor(l1, 32);
        LAS float* wsf = (LAS float*)(lds + WSF_OFF) + wid * 64;
        if (hi == 0) { wsf[r32] = l0; wsf[32 + r32] = l1; }
        asm volatile("s_waitcnt lgkmcnt(0)" ::: "memory");
#pragma unroll
        for (int r = 0; r < 16; ++r) { const float a0 = wsf[crow(r, hi)], a1 = wsf[32 + crow(r, hi)];
            const float rl0 = a0 > 0.f ? 1.0f / a0 : 0.f, rl1 = a1 > 0.f ? lam / a1 : 0.f; float s = 0.f;
#pragma unroll
            for (int db = 0; db < 4; ++db) { const float v = o[0][db][r] * rl0 - o[1][db][r] * rl1; o[0][db][r] = v; s += v * v; }
            s += __shfl_xor(s, 1); s += __shfl_xor(s, 2); s += __shfl_xor(s, 4); s += __shfl_xor(s, 8); s += __shfl_xor(s, 16);
            const float rn = rsqrtf(s * (1.0f / 128.0f) + 1e-6f) * 0.8f;
#pragma unroll
            for (int db = 0; db < 4; ++db) o[0][db][r] *= rn; }
        LAS unsigned short* stg = (LAS unsigned short*)(lds + OST_OFF + wid * OST_WAVE);
#pragma unroll
        for (int db = 0; db < 4; ++db) { const float sg = subg[db * 32 + r32];
#pragma unroll
            for (int r = 0; r < 16; ++r) { const unsigned w = cvtpk(o[0][db][r] * sg, 0.f); stg[crow(r, hi) * (OST_PITCH / 2) + db * 32 + r32] = (unsigned short)(w & 0xffffu); } }
        asm volatile("s_waitcnt lgkmcnt(0)" ::: "memory");
        int lsel = lane; asm volatile("" : "+v"(lsel));
        bf16_t* Ow = O + (size_t)(rowbase + qfirst - 64 + (lsel >> 4)) * 1024 + h * 128 + (lsel & 15) * 8;
        const LAS unsigned char* sp = (const LAS unsigned char*)stg + (lsel >> 4) * OST_PITCH + (lsel & 15) * 16;
#pragma unroll
        for (int it = 0; it < 8; ++it) { const u32x4 v = *(const LAS u32x4*)(sp + it * 4 * OST_PITCH); *(u32x4*)Ow = v; Ow += 4 * 1024; asm volatile("" : "+v"(Ow)); }
    }
    __syncthreads();
}
}
typedef unsigned short bf16;
typedef unsigned v4u __attribute__((ext_vector_type(4)));
typedef float f32x4 __attribute__((ext_vector_type(4)));
typedef short bf16x8 __attribute__((ext_vector_type(8)));
constexpr int NWAVES = 8;
#ifndef MK_PER_PHASE
#define MK_PER_PHASE 0
#endif
constexpr int NPHASE = 13;
#ifndef PROBE_DUP
#define PROBE_DUP -1
#endif
#define REPS(k) for (int rep_ = 0; rep_ < ((PROBE_DUP) == (k) ? 2 : 1); ++rep_)
constexpr int D = 1024, NB = 32, SEQ = 2048, LTOK = 2064, NMETA = 16, LP = 2048, MP = NB * LP;
constexpr int NQKV = 3072, DFF = 2816, NGU = 5632;
constexpr size_t al256(size_t x) { return (x + 255) & ~(size_t)255; }
constexpr size_t WS_WQKV = 0;
constexpr size_t WS_WO   = WS_WQKV + (size_t)NQKV * D * 2;
constexpr size_t WS_WGU0 = WS_WO + (size_t)D * D * 2;
constexpr size_t WS_WD0  = WS_WGU0 + (size_t)NGU * D * 2;
constexpr size_t WS_WIN  = WS_WD0 + (size_t)D * DFF * 2;
constexpr size_t WS_WOUT = WS_WIN + (size_t)NQKV * D * 2;
constexpr size_t WS_WGU1 = WS_WOUT + (size_t)D * D * 2;
constexpr size_t WS_WD1  = WS_WGU1 + (size_t)NGU * D * 2;
constexpr size_t WS_ROPE = WS_WD1 + (size_t)D * DFF * 2;
constexpr size_t WS_SSP  = WS_ROPE + al256((size_t)LTOK * 32 * 2 * 4);
constexpr size_t WS_H    = WS_SSP + (size_t)MP * 16 * 4;
constexpr size_t WS_XB   = WS_H + (size_t)MP * D * 4;
constexpr size_t WS_BIG  = WS_XB + (size_t)MP * D * 2;
constexpr size_t WS_O    = WS_BIG + (size_t)MP * NQKV * 2;
constexpr size_t WS_MXB  = WS_O + (size_t)MP * D * 2;
constexpr size_t WS_MRS  = WS_MXB + 16 * 1024 * 2;
constexpr size_t WS_MC1  = WS_MRS + 256;
constexpr size_t WS_MQKV = WS_MC1 + 16 * 3072 * 4;
constexpr size_t WS_MOM  = WS_MQKV + 64 * 3072 * 2;
constexpr size_t WS_MC2  = WS_MOM + 16 * 1024 * 2;
constexpr size_t WS_MC3  = WS_MC2 + 16 * 1024 * 4;
constexpr size_t WS_MH1  = WS_MC3 + 16 * 5632 * 4;
constexpr size_t WS_MHID = WS_MH1 + 16 * 1024 * 4;
constexpr size_t WS_MC4  = WS_MHID + 16 * 2816 * 2;
constexpr size_t WS_MC5  = WS_MC4 + 16 * 1024 * 4;
constexpr size_t WS_MZ   = WS_MC5 + 16 * 2048 * 4;
constexpr size_t WS_CTL  = WS_MZ + 16 * 1024 * 2;
constexpr size_t CTL_BYTES = 16384;
constexpr size_t WS_END  = WS_CTL + CTL_BYTES;
constexpr int LDS_BYTES = 147456;
static_assert(att::ATT_LDS <= LDS_BYTES && pg8::STAGE_BYTES <= LDS_BYTES, "LDS map");

__device__ __forceinline__ unsigned f2bf(float f) { unsigned u = __builtin_bit_cast(unsigned, f); return (u + 0x7fffu + ((u >> 16) & 1u)) >> 16; }
__device__ __forceinline__ unsigned pk2(float lo, float hi) { return f2bf(lo) | (f2bf(hi) << 16); }
__device__ __forceinline__ float wave_sum(float v) {
#pragma unroll
    for (int o = 1; o < 64; o <<= 1) v += __shfl_xor(v, o);
    return v;
}
__device__ __forceinline__ float wave_max(float v) {
#pragma unroll
    for (int o = 1; o < 64; o <<= 1) v = fmaxf(v, __shfl_xor(v, o));
    return v;
}
__device__ __forceinline__ int col_perm(int mode, int n) {
    if (mode == 1) return (n & ~255) + 128 * ((n >> 5) & 1) + 32 * ((n >> 6) & 3) + (n & 31);
    if (mode == 2) { const int up = n >= DFF ? 1 : 0, j = n - up * DFF; return 256 * (j >> 7) + 128 * up + (j & 127); }
    if (mode == 3) { if (n < 1024) return 2048 + n; const int up = n >= 2048 ? 1 : 0, j = (n - 1024) & 1023; return 256 * (j >> 7) + 128 * up + (j & 127); }
    return n;
}
__device__ __forceinline__ void transpose_item(const float* W, int K, int N, bf16* WT, const float* gain, int mode, LAS float* scr, int item, int lane) {
    const int nblk = N / 32, kb = item / nblk, nb = item % nblk, k0 = 64 * kb, n0 = 32 * nb;
#pragma unroll 8
    for (int i = 0; i < 32; ++i) { const int kk = 2 * i + (lane >> 5); scr[kk * 33 + (lane & 31)] = W[(size_t)(k0 + kk) * N + n0 + (lane & 31)]; }
    asm volatile("s_waitcnt lgkmcnt(0)" ::: "memory");
    const int c = lane & 7;
    float gv[8];
#pragma unroll
    for (int e = 0; e < 8; ++e) gv[e] = gain ? gain[k0 + 8 * c + e] : 1.0f;
#pragma unroll
    for (int j = 0; j < 4; ++j) { const int n = (lane >> 3) + 8 * j; const LAS float* s = scr + (8 * c) * 33 + n;
        v4u o; o.x = pk2(s[0 * 33] * gv[0], s[1 * 33] * gv[1]); o.y = pk2(s[2 * 33] * gv[2], s[3 * 33] * gv[3]); o.z = pk2(s[4 * 33] * gv[4], s[5 * 33] * gv[5]); o.w = pk2(s[6 * 33] * gv[6], s[7 * 33] * gv[7]);
        *(v4u*)(WT + (size_t)col_perm(mode, n0 + n) * K + k0 + 8 * c) = o; }
    asm volatile("s_waitcnt lgkmcnt(0)" ::: "memory");
}
__device__ __forceinline__ void sincos_acc(float angf, float& c, float& s) {
    const double TWO_PI = 6.283185307179586476925286766559;
    double a = (double)angf; const double n = rint(a / TWO_PI); double r = a - n * TWO_PI;
    const double r2 = r * r; double cs = 1.0, sn = r, tc = 1.0, ts = r;
#pragma unroll 1
    for (int k = 1; k <= 14; ++k) { tc = -tc * r2 / (double)((2 * k - 1) * (2 * k)); ts = -ts * r2 / (double)((2 * k) * (2 * k + 1)); cs += tc; sn += ts; }
    c = (float)cs; s = (float)sn;
}

#define XB_TMO      128
#define XB_XCNT(j)  (256  + 64 * (j))
#define XB_XSUB(j)  (1280 + 64 * (j))
#define XB_XGEN(j)  (2304 + 64 * (j))
#define XB_TOP      3328
#define XB_TOPGEN   3392
#define XCD_BAR_WORDS 3456
#define XB_SPIN_CAP (1u << 18)

__device__ __forceinline__ unsigned xb_ld(unsigned* p)              { return __hip_atomic_load(p, __ATOMIC_RELAXED, __HIP_MEMORY_SCOPE_AGENT); }
__device__ __forceinline__ unsigned xb_add(unsigned* p, unsigned v) { return __hip_atomic_fetch_add(p, v, __ATOMIC_RELAXED, __HIP_MEMORY_SCOPE_AGENT); }
__device__ __forceinline__ unsigned xb_xcc_id() { return (unsigned)__builtin_amdgcn_s_getreg((3 << 11) | 20) & 0xFu; }
#define XB_SPIN(cond, bar) do { unsigned _sp = 0; while (cond) { __builtin_amdgcn_s_sleep(1); \
    if ((++_sp & 255u) == 0u) { if (xb_ld(&(bar)[XB_TMO])) break; if (_sp > XB_SPIN_CAP) { atomicAdd(&(bar)[XB_TMO], 1u); break; } } } } while (0)

struct XcdBarrier {
    unsigned* bar; unsigned x;
    volatile LAS unsigned* st;
};

__device__ __forceinline__ XcdBarrier xcd_barrier_post(unsigned* bar, volatile LAS unsigned* st) {
    XcdBarrier b; b.bar = bar; b.x = xb_xcc_id(); b.st = st;
    if (threadIdx.x == 0) (void)xb_add(&bar[XB_XCNT(b.x)], 1u);
    return b;
}
__device__ __forceinline__ void xcd_barrier_complete(unsigned* bar, unsigned x, unsigned& nloc, unsigned& nx) {
    const unsigned G = gridDim.x * gridDim.y * gridDim.z;
    unsigned sum, cnt, mine, sp = 0u;
    for (;;) {
        sum = 0u; cnt = 0u; mine = 0u;
#pragma unroll
        for (unsigned j = 0; j < 16; ++j) { const unsigned c = xb_ld(&bar[XB_XCNT(j)]); sum += c; cnt += (c > 0u) ? 1u : 0u; mine = (j == x) ? c : mine; }
        if (sum == G) break;
        __builtin_amdgcn_s_sleep(1);
        if ((++sp & 255u) == 0u) { if (xb_ld(&bar[XB_TMO])) break; if (sp > XB_SPIN_CAP) { atomicAdd(&bar[XB_TMO], 1u); break; } }
    }
    nloc = mine > 0u ? mine : 1u; nx = cnt > 0u ? cnt : 1u;
}

__device__ __forceinline__ void xcd_barrier(const XcdBarrier& b) {
    asm volatile("s_waitcnt vmcnt(0)" ::: "memory");
    __syncthreads();
    if (threadIdx.x == 0) {
        unsigned* bar = b.bar;
        __builtin_amdgcn_s_waitcnt(0);
        unsigned nloc = b.st[0], nx = b.st[1];
        if (nloc == 0u) { xcd_barrier_complete(bar, b.x, nloc, nx); b.st[0] = nloc; b.st[1] = nx; }
        const unsigned old = xb_add(&bar[XB_XSUB(b.x)], 1u);
        const unsigned gen = old / nloc;
        if (old + 1u == (gen + 1u) * nloc) {
            __builtin_amdgcn_fence(__ATOMIC_RELEASE, "agent");
            asm volatile("s_waitcnt vmcnt(0)" ::: "memory");
            const unsigned og = xb_add(&bar[XB_TOP], 1u);
            const unsigned tg = og / nx;
            if (og + 1u == (tg + 1u) * nx) xb_add(&bar[XB_TOPGEN], 1u);
            else XB_SPIN(xb_ld(&bar[XB_TOPGEN]) == tg, bar);
            __builtin_amdgcn_fence(__ATOMIC_ACQUIRE, "agent");
            xb_add(&bar[XB_XGEN(b.x)], 1u);
            asm volatile("s_waitcnt vmcnt(0)" ::: "memory");
        } else {
            XB_SPIN(xb_ld(&bar[XB_XGEN(b.x)]) == gen, bar);
            __builtin_amdgcn_fence(__ATOMIC_ACQUIRE, "agent");
            asm volatile("s_waitcnt vmcnt(0)" ::: "memory");
        }
    }
    __syncthreads();
}

constexpr int MISC_OFF = LDS_BYTES - 64;
struct Args { const float* in[18]; float* out; unsigned char* ws; int ph_lo, ph_hi; };

__device__ __forceinline__ void prologue(const Args& a, LAS unsigned char* lds, int wave, int lane, int gw, int NGW) {
    unsigned char* ws = a.ws;
    LAS float* scr = (LAS float*)(lds + wave * 16384);
    const float* mix_g = a.in[2]; const float* ffn_g = a.in[3];
    constexpr int I_QKV = (D / 64) * (NQKV / 32), I_O = (D / 64) * (D / 32), I_GU = (D / 64) * (NGU / 32), I_DN = (DFF / 64) * (D / 32);
    constexpr int NITEMS = 2 * I_QKV + 2 * I_O + 2 * I_GU + 2 * I_DN;
    for (int it = gw; it < NITEMS; it += NGW) {
        int r = it;
        if (r < I_QKV) { transpose_item(a.in[4], D, NQKV, (bf16*)(ws + WS_WQKV), mix_g, 1, scr, r, lane); continue; } r -= I_QKV;
        if (r < I_O)   { transpose_item(a.in[12], D, D, (bf16*)(ws + WS_WO), nullptr, 0, scr, r, lane); continue; } r -= I_O;
        if (r < I_GU)  { transpose_item(a.in[16], D, NGU, (bf16*)(ws + WS_WGU0), ffn_g, 2, scr, r, lane); continue; } r -= I_GU;
        if (r < I_DN)  { transpose_item(a.in[17], DFF, D, (bf16*)(ws + WS_WD0), nullptr, 0, scr, r, lane); continue; } r -= I_DN;
        if (r < I_QKV) { transpose_item(a.in[13], D, NQKV, (bf16*)(ws + WS_WIN), mix_g + D, 3, scr, r, lane); continue; } r -= I_QKV;
        if (r < I_O)   { transpose_item(a.in[15], D, D, (bf16*)(ws + WS_WOUT), nullptr, 0, scr, r, lane); continue; } r -= I_O;
        if (r < I_GU)  { transpose_item(a.in[16] + (size_t)D * NGU, D, NGU, (bf16*)(ws + WS_WGU1), ffn_g + D, 2, scr, r, lane); continue; } r -= I_GU;
        transpose_item(a.in[17] + (size_t)DFF * D, DFF, D, (bf16*)(ws + WS_WD1), nullptr, 0, scr, r, lane);
    }
    { float* rope = (float*)(ws + WS_ROPE);
      for (int e = gw * 64 + lane; e < LTOK * 32; e += NGW * 64) { const int pos = e >> 5, i = e & 31;
          const float inv = (float)exp(-9.210340371976184 * (double)(2 * i) / 64.0);
          const float ang = (float)pos * inv; float c, s; sincos_acc(ang, c, s); rope[2 * e] = c; rope[2 * e + 1] = s; } }
    { const float* x = a.in[0]; bf16* XB = (bf16*)(ws + WS_XB); float* ssp = (float*)(ws + WS_SSP);
      for (int m = gw; m < MP; m += NGW) {
          const float* src = x + (size_t)m * D;
          f32x4 v[4]; float s = 0.f;
#pragma unroll
          for (int j = 0; j < 4; ++j) { v[j] = *((const f32x4*)src + 64 * j + lane); s += (v[j][0] * v[j][0] + v[j][1] * v[j][1]) + (v[j][2] * v[j][2] + v[j][3] * v[j][3]); }
          s = wave_sum(s);
#pragma unroll
          for (int j = 0; j < 4; ++j) *((unsigned long long*)(XB + (size_t)m * D) + 64 * j + lane) = (unsigned long long)pk2(v[j][0], v[j][1]) | ((unsigned long long)pk2(v[j][2], v[j][3]) << 32);
          if (lane < 16) ssp[(size_t)m * 16 + lane] = lane == 0 ? s : 0.f; } }
    { const float* meta = a.in[1]; bf16* MXB = (bf16*)(ws + WS_MXB); float* mrs = (float*)(ws + WS_MRS);
      if (gw < NMETA) { const int m = gw; const float* src = meta + (size_t)m * D; f32x4 v[4]; float s = 0.f;
#pragma unroll
          for (int j = 0; j < 4; ++j) { v[j] = *((const f32x4*)src + 64 * j + lane); s += (v[j][0] * v[j][0] + v[j][1] * v[j][1]) + (v[j][2] * v[j][2] + v[j][3] * v[j][3]); }
          s = wave_sum(s);
#pragma unroll
          for (int j = 0; j < 4; ++j) *((unsigned long long*)(MXB + (size_t)m * D) + 64 * j + lane) = (unsigned long long)pk2(v[j][0], v[j][1]) | ((unsigned long long)pk2(v[j][2], v[j][3]) << 32);
          if (lane == 0) mrs[m] = s; }
      v4u* mz = (v4u*)(ws + WS_MQKV);
      for (int e = gw * 64 + lane; e < 48 * 3072 * 2 / 16; e += NGW * 64) mz[e] = (v4u){0u, 0u, 0u, 0u}; }
}
template <int AMODE> __device__ __forceinline__ void skinny_gemm(const bf16* A, const float* P, const float* Q, int K, const bf16* Bt, int mode, int n_src0, int ntiles, float* C, int ldc, int gw, int NGW, int lane) {
    const int fr = lane & 15, fq = lane >> 4;
    for (int tile = gw; tile < ntiles; tile += NGW) {
        const bf16* bp = Bt + (size_t)col_perm(mode, n_src0 + tile * 16 + fr) * K + 8 * fq;
        f32x4 acc = {0.f, 0.f, 0.f, 0.f};
#pragma unroll 4
        for (int kk = 0; kk < K; kk += 32) {
            bf16x8 av;
            if (AMODE == 0) av = *(const bf16x8*)(A + (size_t)fr * K + kk + 8 * fq);
            else { const float* pp = P + (size_t)fr * K + kk + 8 * fq; const float* qq = Q + (size_t)fr * K + kk + 8 * fq;
                const f32x4 p0 = *(const f32x4*)pp, p1 = *(const f32x4*)(pp + 4), q0 = *(const f32x4*)qq, q1 = *(const f32x4*)(qq + 4);
                v4u t; t.x = pk2(p0[0] + q0[0], p0[1] + q0[1]); t.y = pk2(p0[2] + q0[2], p0[3] + q0[3]); t.z = pk2(p1[0] + q1[0], p1[1] + q1[1]); t.w = pk2(p1[2] + q1[2], p1[3] + q1[3]);
                av = __builtin_bit_cast(bf16x8, t); }
            const bf16x8 bv = *(const bf16x8*)(bp + kk);
            acc = __builtin_amdgcn_mfma_f32_16x16x32_bf16(av, bv, acc, 0, 0, 0);
        }
#pragma unroll
        for (int j = 0; j < 4; ++j) C[(size_t)(4 * fq + j) * ldc + tile * 16 + fr] = acc[j];
    }
}
__device__ __forceinline__ void meta_e1(const Args& a, LAS unsigned char* lds, int wave, int lane) {
    unsigned char* ws = a.ws;
    const float* C1 = (const float*)(ws + WS_MC1); const float* mrs = (const float*)(ws + WS_MRS); const float* rope = (const float*)(ws + WS_ROPE);
    bf16* MQ = (bf16*)(ws + WS_MQKV); bf16* OM = (bf16*)(ws + WS_MOM);
    const float* qg = a.in[5]; const float* kg = a.in[6]; const float* subg = a.in[11];
    const float lam = expf(wave_sum(a.in[7][lane] * a.in[8][lane])) - expf(wave_sum(a.in[9][lane] * a.in[10][lane])) + 0.2f;
    LAS float* kl = (LAS float*)(lds + wave * 16384);
    LAS float* vl = kl + 2048;
    const int h = wave, i = lane & 31;
#pragma unroll 1
    for (int r = 0; r < 16; ++r) {
        const float rs = rsqrtf(mrs[r] * (1.0f / 1024.0f) + 1e-6f);
        const float cs = rope[(r * 32 + i) * 2], sn = rope[(r * 32 + i) * 2 + 1];
#pragma unroll
        for (int c = 0; c < 2; ++c) {
            float x = C1[(size_t)r * 3072 + 1024 + h * 128 + c * 64 + lane] * rs;
            const float ss = wave_sum(x * x); x = x * rsqrtf(ss * (1.0f / 64.0f) + 1e-6f) * kg[lane];
            const float pr = __shfl_xor(x, 32); const float o = lane < 32 ? x * cs - pr * sn : x * cs + pr * sn;
            kl[(c * 16 + r) * 64 + lane] = o;
            MQ[(size_t)(48 + r) * 3072 + 1024 + h * 128 + c * 64 + lane] = (bf16)f2bf(o);
        }
#pragma unroll
        for (int hf = 0; hf < 2; ++hf) { const float v = C1[(size_t)r * 3072 + 2048 + h * 128 + hf * 64 + lane] * rs; vl[r * 128 + hf * 64 + lane] = v;
            MQ[(size_t)(48 + r) * 3072 + 2048 + h * 128 + hf * 64 + lane] = (bf16)f2bf(v); }
    }
    asm volatile("s_waitcnt lgkmcnt(0)" ::: "memory");
#pragma unroll 1
    for (int r = 0; r < 16; ++r) {
        const float rs = rsqrtf(mrs[r] * (1.0f / 1024.0f) + 1e-6f);
        const float cs = rope[(r * 32 + i) * 2], sn = rope[(r * 32 + i) * 2 + 1];
        float q0, q1;
        { float x = C1[(size_t)r * 3072 + h * 128 + lane] * rs; const float ss = wave_sum(x * x); x = x * rsqrtf(ss * (1.0f / 64.0f) + 1e-6f) * qg[lane];
          const float pr = __shfl_xor(x, 32); q0 = (lane < 32 ? x * cs - pr * sn : x * cs + pr * sn) * pg8::QSCALE_; }
        { float x = C1[(size_t)r * 3072 + h * 128 + 64 + lane] * rs; const float ss = wave_sum(x * x); x = x * rsqrtf(ss * (1.0f / 64.0f) + 1e-6f) * qg[lane];
          const float pr = __shfl_xor(x, 32); q1 = (lane < 32 ? x * cs - pr * sn : x * cs + pr * sn) * pg8::QSCALE_; }
        float l0 = 0.f, l1 = 0.f, o0a = 0.f, o0b = 0.f, o1a = 0.f, o1b = 0.f;
#pragma unroll 1
        for (int rp = 0; rp <= r; ++rp) {
            const float s0 = wave_sum(q0 * kl[rp * 64 + lane]), s1 = wave_sum(q1 * kl[(16 + rp) * 64 + lane]);
            const float p0 = __builtin_amdgcn_exp2f(s0), p1 = __builtin_amdgcn_exp2f(s1); l0 += p0; l1 += p1;
            const float va = vl[rp * 128 + lane], vb = vl[rp * 128 + 64 + lane];
            o0a += p0 * va; o0b += p0 * vb; o1a += p1 * va; o1b += p1 * vb;
        }
        const float oa = o0a / l0 - lam * o1a / l1, ob = o0b / l0 - lam * o1b / l1;
        const float rn = rsqrtf(wave_sum(oa * oa + ob * ob) * (1.0f / 128.0f) + 1e-6f) * 0.8f;
        OM[(size_t)r * 1024 + h * 128 + lane] = (bf16)f2bf(oa * rn * subg[lane]); OM[(size_t)r * 1024 + h * 128 + 64 + lane] = (bf16)f2bf(ob * rn * subg[64 + lane]);
    }
}
__device__ __forceinline__ void meta_e3(const Args& a, LAS unsigned char* lds, int wave, int lane) {
    unsigned char* ws = a.ws; const float* meta = a.in[1]; const float* C2 = (const float*)(ws + WS_MC2); float* H1 = (float*)(ws + WS_MH1);
    const float* C3 = (const float*)(ws + WS_MC3); bf16* HID = (bf16*)(ws + WS_MHID); LAS float* rsl = (LAS float*)lds;
#pragma unroll
    for (int rr = 0; rr < 2; ++rr) { const int r = 2 * wave + rr; float s = 0.f;
#pragma unroll
        for (int j = 0; j < 4; ++j) { const f32x4 v = *((const f32x4*)(meta + (size_t)r * D) + 64 * j + lane) + *((const f32x4*)(C2 + (size_t)r * D) + 64 * j + lane);
            *((f32x4*)(H1 + (size_t)r * D) + 64 * j + lane) = v; s += (v[0] * v[0] + v[1] * v[1]) + (v[2] * v[2] + v[3] * v[3]); }
        s = wave_sum(s); if (lane == 0) rsl[r] = rsqrtf(s * (1.0f / 1024.0f) + 1e-6f); }
    __syncthreads();
    for (int e = wave * 64 + lane; e < 16 * DFF; e += NWAVES * 64) { const int r = e / DFF, j = e - r * DFF; const float rs = rsl[r];
        const float g = C3[(size_t)r * NGU + j] * rs, u = C3[(size_t)r * NGU + DFF + j] * rs;
        HID[e] = (bf16)f2bf(g * __builtin_amdgcn_rcpf(1.0f + __expf(-g)) * u); }
    __syncthreads();
}
__device__ __forceinline__ void meta_e5(const Args& a, LAS unsigned char* lds, int wave, int lane) {
    unsigned char* ws = a.ws; const float* H1 = (const float*)(ws + WS_MH1); const float* C4 = (const float*)(ws + WS_MC4);
    const float* C5 = (const float*)(ws + WS_MC5); bf16* MZ = (bf16*)(ws + WS_MZ); LAS float* rsl = (LAS float*)lds;
#pragma unroll
    for (int rr = 0; rr < 2; ++rr) { const int r = 2 * wave + rr; float s = 0.f;
#pragma unroll
        for (int j = 0; j < 4; ++j) { const f32x4 v = *((const f32x4*)(H1 + (size_t)r * D) + 64 * j + lane) + *((const f32x4*)(C4 + (size_t)r * D) + 64 * j + lane);
            s += (v[0] * v[0] + v[1] * v[1]) + (v[2] * v[2] + v[3] * v[3]); }
        s = wave_sum(s); if (lane == 0) rsl[r] = rsqrtf(s * (1.0f / 1024.0f) + 1e-6f); }
    __syncthreads();
    for (int e = wave * 64 + lane; e < 16 * D; e += NWAVES * 64) { const int r = e >> 10, j = e & 1023; const float rs = rsl[r];
        MZ[e] = (bf16)f2bf((C5[(size_t)r * 2048 + j] * rs) * (C5[(size_t)r * 2048 + 1024 + j] * rs)); }
    __syncthreads();
}
__device__ __forceinline__ void conv_phase(const Args& a, int lane, int gw, int NGW) {
    const bf16* Z = (const bf16*)(a.ws + WS_BIG); const bf16* GB = Z + (size_t)MP * D; bf16* Y = (bf16*)(a.ws + WS_O); const float* cw = a.in[14];
    for (int it = gw; it < (MP / 16) * 2; it += NGW) {
        const int rb = it >> 1, col = (it & 1) * 512 + lane * 8, row0 = rb * 16, p0 = row0 % LP;
        float w0[8], w1[8], w2[8], zm2[8], zm1[8];
#pragma unroll
        for (int e = 0; e < 8; ++e) { w0[e] = cw[col + e]; w1[e] = cw[D + col + e]; w2[e] = cw[2 * D + col + e]; zm2[e] = 0.f; zm1[e] = 0.f; }
        { const bf16* MZ = (const bf16*)(a.ws + WS_MZ);
          const v4u a2 = *(const v4u*)(p0 != 0 ? Z + (size_t)(row0 - 2) * D + col : MZ + 14 * D + col), a1 = *(const v4u*)(p0 != 0 ? Z + (size_t)(row0 - 1) * D + col : MZ + 15 * D + col);
#pragma unroll
            for (int e = 0; e < 4; ++e) { zm2[2 * e] = __uint_as_float(a2[e] << 16); zm2[2 * e + 1] = __uint_as_float(a2[e] & 0xffff0000u); zm1[2 * e] = __uint_as_float(a1[e] << 16); zm1[2 * e + 1] = __uint_as_float(a1[e] & 0xffff0000u); } }
#pragma unroll 4
        for (int i = 0; i < 16; ++i) { const size_t off = (size_t)(row0 + i) * D + col; const v4u zz = *(const v4u*)(Z + off), gg = *(const v4u*)(GB + off);
            float z[8], g[8], y[8];
#pragma unroll
            for (int e = 0; e < 4; ++e) { z[2 * e] = __uint_as_float(zz[e] << 16); z[2 * e + 1] = __uint_as_float(zz[e] & 0xffff0000u); g[2 * e] = __uint_as_float(gg[e] << 16); g[2 * e + 1] = __uint_as_float(gg[e] & 0xffff0000u); }
#pragma unroll
            for (int e = 0; e < 8; ++e) { y[e] = g[e] * (w0[e] * zm2[e] + w1[e] * zm1[e] + w2[e] * z[e]); zm2[e] = zm1[e]; zm1[e] = z[e]; }
            v4u o; o.x = pk2(y[0], y[1]); o.y = pk2(y[2], y[3]); o.z = pk2(y[4], y[5]); o.w = pk2(y[6], y[7]);
            *(v4u*)(Y + off) = o; }
    }
}

__global__ void __launch_bounds__(NWAVES * 64, 2) mega_fwd(Args args) {
    extern __shared__ __attribute__((aligned(16))) unsigned char lds_raw[];
    LAS unsigned char* lds = (LAS unsigned char*)lds_raw;
    cg::grid_group grid = cg::this_grid();
    const int wave = __builtin_amdgcn_readfirstlane(threadIdx.x >> 6);
    const int G = gridDim.x, gw = blockIdx.x * NWAVES + wave, NGW = G * NWAVES;
    unsigned char* ws = args.ws;
    float* H = (float*)(ws + WS_H); bf16* XB = (bf16*)(ws + WS_XB); float* SSP = (float*)(ws + WS_SSP); bf16* BIG = (bf16*)(ws + WS_BIG); bf16* OB = (bf16*)(ws + WS_O);
    const int lo = args.ph_lo, hi = args.ph_hi;
    if (threadIdx.x < 16) ((LAS unsigned*)(lds + MISC_OFF))[threadIdx.x] = 0u;
    __syncthreads();
    XcdBarrier bar = xcd_barrier_post((unsigned*)(ws + WS_CTL), (volatile LAS unsigned*)(lds + MISC_OFF));
#ifndef PHASE_MASK
#define PHASE_MASK 0x1fff
#endif
#define IN(k) (((PHASE_MASK >> (k)) & 1) && lo <= (k) && (k) < hi)
#define SEAM(k) do { if (IN(k) && IN((k) + 1)) { if ((k) == 0) grid.sync(); else xcd_barrier(bar); } } while (0)
    bf16* MXB = (bf16*)(ws + WS_MXB); const bf16* MQKV = (const bf16*)(ws + WS_MQKV);
    if (IN(0)) REPS(0) { prologue(args, lds, wave, pg8::lane_id_v(), gw, NGW); }
    SEAM(0);
    if (IN(1)) {
        skinny_gemm<0>(MXB, nullptr, nullptr, D, (const bf16*)(ws + WS_WQKV), 1, 0, NQKV / 16, (float*)(ws + WS_MC1), NQKV, gw, NGW, pg8::lane_id_v());
    }
    SEAM(1);
    if (IN(2)) {
        if (blockIdx.x == 0) meta_e1(args, lds, wave, pg8::lane_id_v());
    }
    SEAM(2);
    if (IN(3)) REPS(3) {
        skinny_gemm<0>((const bf16*)(ws + WS_MOM), nullptr, nullptr, D, (const bf16*)(ws + WS_WO), 0, 0, D / 16, (float*)(ws + WS_MC2), D, gw, NGW, pg8::lane_id_v());
        pg8::Gemm g{XB, (const bf16*)(ws + WS_WQKV), MP, NQKV, D}; pg8::StaticOrder S; S.init(MP, NQKV, G, (int)blockIdx.x);
        pg8::EpiQKV E{BIG, SSP, (const float*)(ws + WS_ROPE), args.in[5], args.in[6]};
        pg8::gemm_phase<pg8::EpiQKV, pg8::StaticOrder, true, true>(lds, g, S, E, wave);
    }
    SEAM(3);
    if (IN(4)) REPS(4) {
        skinny_gemm<1>(nullptr, args.in[1], (const float*)(ws + WS_MC2), D, (const bf16*)(ws + WS_WGU0), 2, 0, NGU / 16, (float*)(ws + WS_MC3), NGU, gw, NGW, pg8::lane_id_v());
        const int lane = pg8::lane_id_v();
        float s1 = wave_sum(args.in[7][lane] * args.in[8][lane]), s2 = wave_sum(args.in[9][lane] * args.in[10][lane]);
        const float lam = expf(s1) - expf(s2) + 0.2f;
        for (int bh = blockIdx.x; bh < NB * 8; bh += G) { const int b = bh >> 3, h = bh & 7;
#pragma unroll 1
            for (int j = 0; j < 8; ++j) att::attn_unit(lds, BIG, MQKV, OB, b, h, 64 + 256 * j, 8, lam, args.in[11], wave); }
    }
    SEAM(4);
    if (IN(5)) {
        if (blockIdx.x == 0) meta_e3(args, lds, wave, pg8::lane_id_v());
        pg8::Gemm g{OB, (const bf16*)(ws + WS_WO), MP, D, D}; pg8::StaticOrder S; S.init(MP, D, G, (int)blockIdx.x);
        pg8::EpiRes<false> E{args.in[0], H, XB, SSP, nullptr};
        pg8::gemm_phase<pg8::EpiRes<false>, pg8::StaticOrder, true, true>(lds, g, S, E, wave);
    }
    SEAM(5);
    if (IN(6)) REPS(6) {
        skinny_gemm<0>((const bf16*)(ws + WS_MHID), nullptr, nullptr, DFF, (const bf16*)(ws + WS_WD0), 0, 0, D / 16, (float*)(ws + WS_MC4), D, gw, NGW, pg8::lane_id_v());
        pg8::Gemm g{XB, (const bf16*)(ws + WS_WGU0), MP, NGU, D}; pg8::StaticOrder S; S.init(MP, NGU, G, (int)blockIdx.x);
        pg8::EpiGateUp E{BIG, SSP};
        pg8::gemm_phase<pg8::EpiGateUp, pg8::StaticOrder, true, true>(lds, g, S, E, wave);
    }
    SEAM(6);
    if (IN(7)) {
        skinny_gemm<1>(nullptr, (const float*)(ws + WS_MH1), (const float*)(ws + WS_MC4), D, (const bf16*)(ws + WS_WIN), 3, 1024, 2048 / 16, (float*)(ws + WS_MC5), 2048, gw, NGW, pg8::lane_id_v());
        pg8::Gemm g{BIG, (const bf16*)(ws + WS_WD0), MP, D, DFF}; pg8::StaticOrder S; S.init(MP, D, G, (int)blockIdx.x);
        pg8::EpiRes<false> E{H, H, XB, SSP, nullptr};
        pg8::gemm_phase<pg8::EpiRes<false>, pg8::StaticOrder, true, true>(lds, g, S, E, wave);
    }
    SEAM(7);
    if (IN(8)) REPS(8) {
        if (blockIdx.x == 0) meta_e5(args, lds, wave, pg8::lane_id_v());
        pg8::Gemm g{XB, (const bf16*)(ws + WS_WIN), MP, NQKV, D}; pg8::StaticOrder S; S.init(MP, NQKV, G, (int)blockIdx.x);
        pg8::EpiWin E{BIG, BIG + (size_t)MP * D, SSP};
        pg8::gemm_phase<pg8::EpiWin, pg8::StaticOrder, true, true>(lds, g, S, E, wave);
    }
    SEAM(8);
    if (IN(9)) REPS(9) { conv_phase(args, pg8::lane_id_v(), gw, NGW); }
    SEAM(9);
    if (IN(10)) {
        pg8::Gemm g{OB, (const bf16*)(ws + WS_WOUT), MP, D, D}; pg8::StaticOrder S; S.init(MP, D, G, (int)blockIdx.x);
        pg8::EpiRes<false> E{H, H, XB, SSP, nullptr};
        pg8::gemm_phase<pg8::EpiRes<false>, pg8::StaticOrder, true, true>(lds, g, S, E, wave);
    }
    SEAM(10);
    if (IN(11)) REPS(11) {
        pg8::Gemm g{XB, (const bf16*)(ws + WS_WGU1), MP, NGU, D}; pg8::StaticOrder S; S.init(MP, NGU, G, (int)blockIdx.x);
        pg8::EpiGateUp E{BIG, SSP};
        pg8::gemm_phase<pg8::EpiGateUp, pg8::StaticOrder, true, true>(lds, g, S, E, wave);
    }
    SEAM(11);
    if (IN(12)) {
        pg8::Gemm g{BIG, (const bf16*)(ws + WS_WD1), MP, D, DFF}; pg8::StaticOrder S; S.init(MP, D, G, (int)blockIdx.x);
        pg8::EpiRes<true> E{H, nullptr, nullptr, nullptr, args.out};
        pg8::gemm_phase<pg8::EpiRes<true>, pg8::StaticOrder, true, true>(lds, g, S, E, wave);
    }
#undef IN
#undef SEAM
}

extern "C" void kernel_launch(void* const* d_in, const int* in_sizes, int n_in, void* d_out, int out_size, void* d_ws, size_t ws_size, hipStream_t stream) {
    static int grid = 0;
    if (grid == 0) {
        if (n_in != 18 || ws_size < WS_END) { fprintf(stderr, "kernel_launch: need 18 inputs and %zu bytes of workspace (got %d, %zu)\n", (size_t)WS_END, n_in, ws_size); grid = -1; return; }
        int dev = 0, cus = 0, per_cu = 0;
        hipGetDevice(&dev); hipDeviceGetAttribute(&cus, hipDeviceAttributeMultiprocessorCount, dev);
        if (hipFuncSetAttribute((const void*)mega_fwd, hipFuncAttributeMaxDynamicSharedMemorySize, LDS_BYTES) != hipSuccess) { fprintf(stderr, "kernel_launch: hipFuncSetAttribute failed\n"); grid = -1; return; }
        if (hipOccupancyMaxActiveBlocksPerMultiprocessor(&per_cu, (const void*)mega_fwd, NWAVES * 64, LDS_BYTES) != hipSuccess || per_cu < 1) { fprintf(stderr, "kernel_launch: occupancy query says %d\n", per_cu); per_cu = 1; }
        (void)hipGetLastError();
        grid = cus * per_cu;
    }
    if (grid < 0) return;
    Args a{};
    for (int i = 0; i < 18; ++i) a.in[i] = (const float*)d_in[i];
    a.out = (float*)d_out; a.ws = (unsigned char*)d_ws;
#if MK_PER_PHASE
    for (int p = 0; p < NPHASE; ++p) { a.ph_lo = p; a.ph_hi = p + 1; hipLaunchKernelGGL(mega_fwd, dim3(grid), dim3(NWAVES * 64), LDS_BYTES, stream, a); }
#else
    a.ph_lo = 0; a.ph_hi = NPHASE;
    if (hipMemsetAsync((char*)d_ws + WS_CTL, 0, CTL_BYTES, stream) != hipSuccess) { fprintf(stderr, "kernel_launch: memset failed\n"); return; }
    void* kargs[] = {&a};
    hipError_t e = hipLaunchCooperativeKernel((const void*)mega_fwd, dim3(grid), dim3(NWAVES * 64), kargs, LDS_BYTES, stream);
    if (e != hipSuccess) fprintf(stderr, "kernel_launch: cooperative launch failed: %s (grid %d)\n", hipGetErrorString(e), grid);
#endif
}
```

```cpp
#include <hip/hip_runtime.h>
#include <hip/hip_cooperative_groups.h>
#include <cstdio>
#include <cstdint>
namespace cg = cooperative_groups;
namespace pg8 {
#define PG8_LAS __attribute__((address_space(3)))
typedef unsigned short bf16_t;
typedef short bf16x8 __attribute__((ext_vector_type(8)));
typedef float f32x4 __attribute__((ext_vector_type(4)));
typedef unsigned u32x4 __attribute__((ext_vector_type(4)));
constexpr int BM = 256, BK = 64, HALF = 128, HTB = HALF * BK * 2  , STAGE_BYTES = 8 * HTB, NXCD = 8, WGM = 8;

__host__ __device__ __forceinline__ int lds_byte(int r, int c) { const int st = (r >> 4) * 2 + (c >> 5), rr = r & 15, cc = c & 31, ob = rr * 64 + cc * 2; return st * 1024 + (ob ^ (((ob >> 9) & 1) << 5)); }
__host__ __device__ __forceinline__ void stage_rc(int b, int& R, int& C) { const int st = b / 1024, sb = b % 1024, swz = sb ^ (((sb >> 9) & 1) << 5); R = (st >> 1) * 16 + swz / 64; C = (st & 1) * 32 + (swz % 64) / 2; }
__host__ __device__ __forceinline__ int perm32(int rho) { const int n = rho >> 4, i = rho & 15; return 8 * (i >> 2) + 4 * n + (i & 3); }

struct Unit { int pm, pn; };
struct Gemm { const bf16_t* A; const bf16_t* Bt; int M, N, K; };

struct StaticOrder {
    int nM, nN, nwg, G, c;
    __host__ __device__ void init(int M, int N, int G_, int c_) { nM = M / BM; nN = N / BM; nwg = nM * nN; G = G_; c = c_; }
    __host__ __device__ bool next(int i, Unit& u) const {
        const long L = (long)i * G + c; if (L >= nwg) return false;
        int wgid = (int)L; { const int q = nwg / NXCD, r = nwg % NXCD, xcd = wgid % NXCD, off = wgid / NXCD; wgid = (xcd < r ? xcd * (q + 1) : r * (q + 1) + (xcd - r) * q) + off; }
        const int nig = WGM * nN, gid = wgid / nig, fm = gid * WGM, gsz = (nM - fm) < WGM ? (nM - fm) : WGM;
        u.pm = fm + ((wgid % nig) % gsz); u.pn = (wgid % nig) / gsz; return true;
    }
    __device__ __forceinline__ void a_ready(const Unit&) const {}
    __device__ __forceinline__ void done(const Unit&) const {}
};
__device__ __forceinline__ unsigned cvt_pk_bf16(float lo, float hi) { unsigned r; asm volatile("v_cvt_pk_bf16_f32 %0, %1, %2" : "=v"(r) : "v"(lo), "v"(hi)); return r; }
typedef unsigned u32x2 __attribute__((ext_vector_type(2)));
__device__ __forceinline__ int lane_id_v() { int l; asm volatile("v_mbcnt_lo_u32_b32 %0, -1, 0\n\tv_mbcnt_hi_u32_b32 %0, -1, %0" : "=v"(l)); return l; }
constexpr int LP_ = 2048, NMETA_ = 16;
constexpr float QSCALE_ = 0.125f * 1.4426950408889634f;
__device__ __forceinline__ float row_rstd(const float* ssp, int row) {
    const f32x4* p = (const f32x4*)(ssp + (size_t)row * 16);
    const f32x4 a = p[0], b = p[1], c = p[2], d = p[3];
    const float s = (((a[0] + a[1]) + (a[2] + a[3])) + ((b[0] + b[1]) + (b[2] + b[3]))) + (((c[0] + c[1]) + (c[2] + c[3])) + ((d[0] + d[1]) + (d[2] + d[3])));
    return rsqrtf(s * (1.0f / 1024.0f) + 1e-6f);
}
__device__ __forceinline__ u32x4 pack8(const f32x4 v0, const f32x4 v1) { u32x4 w; w.x = cvt_pk_bf16(v0[0], v0[1]); w.y = cvt_pk_bf16(v0[2], v0[3]); w.z = cvt_pk_bf16(v1[0], v1[1]); w.w = cvt_pk_bf16(v1[2], v1[3]); return w; }

struct EpiQKV {
    static constexpr bool PERM = true, AFTER_DRAIN = false;
    bf16_t* QKV; const float* ssp; const float* rope; const float* qg; const float* kg;
    __device__ __forceinline__ void operator()(const f32x4 (&acc)[2][2][4][2], const Unit& u, int wr, int wc, int fr, int fq) const {
        const int row0 = u.pm * BM + wr * 64 + fr, pn = u.pn;
        const int colbase = pn * 256 + wc * 64 + 8 * fq;
        if (pn < 8) {
            const float* gp = (pn < 4) ? qg : kg; const float osc = (pn < 4) ? QSCALE_ : 1.0f;
            f32x4 g[2][2];
#pragma unroll
            for (int bj = 0; bj < 2; ++bj)
#pragma unroll
                for (int n = 0; n < 2; ++n) g[bj][n] = *(const f32x4*)(gp + 32 * bj + 8 * fq + 4 * n);
#pragma unroll
            for (int ai = 0; ai < 2; ++ai)
#pragma unroll
                for (int m = 0; m < 4; ++m) {
                    const int row = row0 + ai * HALF + m * 16; const float rs = row_rstd(ssp, row);
                    f32x4 v[2][2]; float ss = 0.f;
#pragma unroll
                    for (int bj = 0; bj < 2; ++bj)
#pragma unroll
                        for (int n = 0; n < 2; ++n) { v[bj][n] = acc[ai][bj][m][n] * rs; const f32x4 x = v[bj][n]; ss += (x[0] * x[0] + x[1] * x[1]) + (x[2] * x[2] + x[3] * x[3]); }
                    ss += __shfl_xor(ss, 16); ss += __shfl_xor(ss, 32);
                    const float rn = rsqrtf(ss * (1.0f / 64.0f) + 1e-6f);
#pragma unroll
                    for (int bj = 0; bj < 2; ++bj)
#pragma unroll
                        for (int n = 0; n < 2; ++n) v[bj][n] = v[bj][n] * rn * g[bj][n];
                    const int pos = (row % LP_) + NMETA_;
                    const f32x4* rp = (const f32x4*)(rope + ((size_t)pos * 32 + 8 * fq) * 2);
                    f32x4 o1[2], o2[2];
#pragma unroll
                    for (int n = 0; n < 2; ++n) { const f32x4 ca = rp[2 * n], cb = rp[2 * n + 1];
                        const f32x4 x1 = v[0][n], x2 = v[1][n];
                        o1[n][0] = (x1[0] * ca[0] - x2[0] * ca[1]) * osc; o2[n][0] = (x2[0] * ca[0] + x1[0] * ca[1]) * osc;
                        o1[n][1] = (x1[1] * ca[2] - x2[1] * ca[3]) * osc; o2[n][1] = (x2[1] * ca[2] + x1[1] * ca[3]) * osc;
                        o1[n][2] = (x1[2] * cb[0] - x2[2] * cb[1]) * osc; o2[n][2] = (x2[2] * cb[0] + x1[2] * cb[1]) * osc;
                        o1[n][3] = (x1[3] * cb[2] - x2[3] * cb[3]) * osc; o2[n][3] = (x2[3] * cb[2] + x1[3] * cb[3]) * osc; }
                    bf16_t* rowp = QKV + (size_t)row * 3072 + colbase;
                    *(u32x4*)(rowp) = pack8(o1[0], o1[1]); *(u32x4*)(rowp + 32) = pack8(o2[0], o2[1]);
                }
        } else {
#pragma unroll
            for (int ai = 0; ai < 2; ++ai)
#pragma unroll
                for (int m = 0; m < 4; ++m) {
                    const int row = row0 + ai * HALF + m * 16; const float rs = row_rstd(ssp, row);
                    bf16_t* rowp = QKV + (size_t)row * 3072 + colbase;
#pragma unroll
                    for (int bj = 0; bj < 2; ++bj) *(u32x4*)(rowp + 32 * bj) = pack8(acc[ai][bj][m][0] * rs, acc[ai][bj][m][1] * rs);
                }
        }
    }
};
struct EpiGateUp {
    static constexpr bool PERM = true, AFTER_DRAIN = false;
    bf16_t* HID; const float* ssp;
    __device__ __forceinline__ void operator()(const f32x4 (&acc)[2][2][4][2], const Unit& u, int wr, int wc, int fr, int fq) const {
        const int row0 = u.pm * BM + wr * 64 + fr; const int col = u.pn * 128 + wc * 32 + 8 * fq;
#pragma unroll
        for (int ai = 0; ai < 2; ++ai)
#pragma unroll
            for (int m = 0; m < 4; ++m) {
                const int row = row0 + ai * HALF + m * 16; const float rs = row_rstd(ssp, row);
                f32x4 hv[2];
#pragma unroll
                for (int n = 0; n < 2; ++n) { const f32x4 g = acc[ai][0][m][n] * rs, uu = acc[ai][1][m][n] * rs;
#pragma unroll
                    for (int e = 0; e < 4; ++e) { const float sg = __builtin_amdgcn_rcpf(1.0f + __expf(-g[e])); hv[n][e] = g[e] * sg * uu[e]; } }
                *(u32x4*)(HID + (size_t)row * 2816 + col) = pack8(hv[0], hv[1]);
            }
    }
};
struct EpiWin {
    static constexpr bool PERM = true, AFTER_DRAIN = false;
    bf16_t* Z; bf16_t* GB; const float* ssp;
    __device__ __forceinline__ void operator()(const f32x4 (&acc)[2][2][4][2], const Unit& u, int wr, int wc, int fr, int fq) const {
        const int row0 = u.pm * BM + wr * 64 + fr, pn = u.pn;
#pragma unroll
        for (int ai = 0; ai < 2; ++ai)
#pragma unroll
            for (int m = 0; m < 4; ++m) {
                const int row = row0 + ai * HALF + m * 16; const float rs = row_rstd(ssp, row);
                if (pn < 8) {
                    const float rs2 = rs * rs;
                    *(u32x4*)(Z + (size_t)row * 1024 + pn * 128 + wc * 32 + 8 * fq) = pack8(acc[ai][0][m][0] * acc[ai][1][m][0] * rs2, acc[ai][0][m][1] * acc[ai][1][m][1] * rs2);
                } else {
                    bf16_t* rowp = GB + (size_t)row * 1024 + (pn - 8) * 256 + wc * 32 + 8 * fq;
#pragma unroll
                    for (int bj = 0; bj < 2; ++bj) *(u32x4*)(rowp + 128 * bj) = pack8(acc[ai][bj][m][0] * rs, acc[ai][bj][m][1] * rs);
                }
            }
    }
};
__device__ __forceinline__ f32x4 bf_lo4(const u32x4 w) { f32x4 r; r[0] = __uint_as_float(w.x << 16); r[1] = __uint_as_float(w.x & 0xffff0000u); r[2] = __uint_as_float(w.y << 16); r[3] = __uint_as_float(w.y & 0xffff0000u); return r; }
__device__ __forceinline__ f32x4 bf_hi4(const u32x4 w) { f32x4 r; r[0] = __uint_as_float(w.z << 16); r[1] = __uint_as_float(w.z & 0xffff0000u); r[2] = __uint_as_float(w.w << 16); r[3] = __uint_as_float(w.w & 0xffff0000u); return r; }
template <int MODE> struct EpiRes {
    static constexpr bool PERM = true, AFTER_DRAIN = false;
    const float* x; bf16_t* XB; float* ssp; float* out;
    __device__ __forceinline__ void operator()(const f32x4 (&acc)[2][2][4][2], const Unit& u, int wr, int wc, int fr, int fq) const {
        const int row0 = u.pm * BM + wr * 64 + fr; const int c0 = u.pn * 256 + wc * 32 + 8 * fq;
#pragma unroll
        for (int ai = 0; ai < 2; ++ai)
#pragma unroll
            for (int m = 0; m < 4; ++m) {
                const int row = row0 + ai * HALF + m * 16; float ss = 0.f;
                f32x4 nv[2][2];
#pragma unroll
                for (int bj = 0; bj < 2; ++bj) {
                    if (MODE == 0) { const float* hp = x + (size_t)row * 1024 + c0 + 128 * bj; nv[bj][0] = *(const f32x4*)hp + acc[ai][bj][m][0]; nv[bj][1] = *(const f32x4*)(hp + 4) + acc[ai][bj][m][1]; }
                    else { const u32x4 hw = *(const u32x4*)(XB + (size_t)row * 1024 + c0 + 128 * bj); nv[bj][0] = bf_lo4(hw) + acc[ai][bj][m][0]; nv[bj][1] = bf_hi4(hw) + acc[ai][bj][m][1]; }
                }
                if (MODE != 2) {
#pragma unroll
                    for (int bj = 0; bj < 2; ++bj) {
                        *(u32x4*)(XB + (size_t)row * 1024 + c0 + 128 * bj) = pack8(nv[bj][0], nv[bj][1]);
#pragma unroll
                        for (int n = 0; n < 2; ++n) { const f32x4 v = nv[bj][n]; ss += (v[0] * v[0] + v[1] * v[1]) + (v[2] * v[2] + v[3] * v[3]); }
                    }
                    ss += __shfl_xor(ss, 16); ss += __shfl_xor(ss, 32);
                    if (fq == 0) ssp[(size_t)row * 16 + 4 * u.pn + wc] = ss;
                } else {
                    float* op = out + (size_t)row * 1024 + c0;
#pragma unroll
                    for (int bj = 0; bj < 2; ++bj) { *(f32x4*)(op + 128 * bj) = nv[bj][0]; *(f32x4*)(op + 128 * bj + 4) = nv[bj][1]; }
                }
            }
    }
};
template <class Epi, class Sched, bool ALIGN_EPI = false, bool SP2 = false>
__device__ __forceinline__ void gemm_phase(PG8_LAS unsigned char* lds, const Gemm g, const Sched& S, const Epi& E, const int wid) {
    const int lane = lane_id_v(), tid = wid * 64 + lane, wr = wid >> 2, wc = wid & 3, fr = lane & 15, fq = lane >> 4;
    const int K = g.K, nt = K / BK;
    unsigned voffA[2], voffB[2];
#pragma unroll
    for (int i = 0; i < 2; ++i) { int R, C; stage_rc(tid * 16 + i * 8192, R, C); const int Rb = Epi::PERM ? ((R & ~31) + perm32(R & 31)) : R;
        voffA[i] = (unsigned)(R * K + C) * 2u; voffB[i] = (unsigned)(Rb * K + C) * 2u; }
    const size_t kstep = (size_t)(BK * 2);
    const size_t hstep = (size_t)HALF * K * 2;
    const size_t tstep = 2 * hstep;
    const unsigned ldsw = (unsigned)wid * 1024u;
    const int aoff = lds_byte(wr * 64 + fr, fq * 8), boff = lds_byte(wc * 32 + fr, fq * 8);
#define PG8_SA(b, h) (((b) * 2 + (h)) * HTB)
#define PG8_SB(b, h) ((4 + (b) * 2 + (h)) * HTB)
#define PG8_STAGE(bufoff, gbase, voff) do { _Pragma("unroll") for (int _i = 0; _i < 2; ++_i) \
        __builtin_amdgcn_global_load_lds((const unsigned*)((const char*)(gbase) + (voff)[_i]), (PG8_LAS unsigned*)(lds + (bufoff) + ldsw + _i * 8192), 16, 0, 0); } while (0)
#define PG8_LDA(dst, b, h) do { _Pragma("unroll") for (int m = 0; m < 4; ++m) _Pragma("unroll") for (int k = 0; k < 2; ++k) dst[m][k] = *(const PG8_LAS bf16x8*)(lds + PG8_SA(b, h) + aoff + m * 2048 + k * 1024); } while (0)
#define PG8_LDB(dst, b, h) do { _Pragma("unroll") for (int n = 0; n < 2; ++n) _Pragma("unroll") for (int k = 0; k < 2; ++k) dst[n][k] = *(const PG8_LAS bf16x8*)(lds + PG8_SB(b, h) + boff + n * 2048 + k * 1024); } while (0)
#define PG8_MMA(ai, bj, At, Bt) do { __builtin_amdgcn_s_setprio(1); _Pragma("unroll") for (int m = 0; m < 4; ++m) _Pragma("unroll") for (int n = 0; n < 2; ++n) _Pragma("unroll") for (int k = 0; k < 2; ++k) \
        acc[ai][bj][m][n] = __builtin_amdgcn_mfma_f32_16x16x32_bf16(Bt[n][k], At[m][k], acc[ai][bj][m][n], 0, 0, 0); __builtin_amdgcn_s_setprio(0); } while (0)
#define PG8_WAIT_V(n) asm volatile("s_waitcnt vmcnt(" #n ")" ::: "memory")
#define PG8_WAIT_L(n) asm volatile("s_waitcnt lgkmcnt(" #n ")" ::: "memory")
#define PG8_BAR __builtin_amdgcn_s_barrier()
#define PG8_SCHED __builtin_amdgcn_sched_barrier(0)
    Unit cur, nxt; int ui = 0;
    if (!S.next(0, cur)) return;
    f32x4 acc[2][2][4][2];
#pragma unroll
    for (int a = 0; a < 2; ++a)
#pragma unroll
        for (int b = 0; b < 2; ++b)
#pragma unroll
            for (int m = 0; m < 4; ++m)
#pragma unroll
                for (int n = 0; n < 2; ++n) acc[a][b][m][n] = (f32x4){0.f, 0.f, 0.f, 0.f};
    bf16x8 At[4][2], B0[2][2], B1[2][2];
    const char* cA = (const char*)g.A + (size_t)cur.pm * tstep; const char* cB = (const char*)g.Bt + (size_t)cur.pn * tstep;
    S.a_ready(cur);
    if constexpr (SP2) {
        PG8_STAGE(PG8_SB(0, 0), cB, voffB); PG8_STAGE(PG8_SB(0, 1), cB + hstep, voffB); PG8_STAGE(PG8_SA(0, 0), cA, voffA); PG8_STAGE(PG8_SA(0, 1), cA + hstep, voffA);
        if (wr == 1) PG8_BAR;
        PG8_WAIT_V(2); PG8_BAR;
        PG8_STAGE(PG8_SB(1, 0), cB + kstep, voffB); PG8_STAGE(PG8_SA(1, 0), cA + kstep, voffA); PG8_STAGE(PG8_SB(1, 1), cB + hstep + kstep, voffB);
        PG8_WAIT_V(6); PG8_BAR;
    } else {
        PG8_STAGE(PG8_SB(0, 0), cB, voffB); PG8_STAGE(PG8_SA(0, 0), cA, voffA); PG8_STAGE(PG8_SB(0, 1), cB + hstep, voffB); PG8_STAGE(PG8_SA(0, 1), cA + hstep, voffA);
        if (wr == 1) PG8_BAR;
        PG8_WAIT_V(4); PG8_BAR;
        PG8_STAGE(PG8_SB(1, 0), cB + kstep, voffB); PG8_STAGE(PG8_SA(1, 0), cA + kstep, voffA); PG8_STAGE(PG8_SB(1, 1), cB + hstep + kstep, voffB);
        PG8_WAIT_V(6); PG8_BAR;
    }
    for (;;) {
        const bool has_next = S.next(ui + 1, nxt);
        const char* nA = has_next ? (const char*)g.A + (size_t)nxt.pm * tstep : cA; const char* nB = has_next ? (const char*)g.Bt + (size_t)nxt.pn * tstep : cB;
        for (int t = 0; t < nt; t += 2) {
            const bool last = (t == nt - 2);
            const char* a1 = cA + (size_t)(t + 1) * kstep;
            const char* a2 = last ? nA : cA + (size_t)(t + 2) * kstep; const char* b2 = last ? nB : cB + (size_t)(t + 2) * kstep;
            const char* a3 = a2 + kstep; const char* b3 = b2 + kstep;
            if (last && has_next) S.a_ready(nxt);
            if constexpr (SP2) {
            PG8_LDB(B0, 0, 0); PG8_LDB(B1, 0, 1); PG8_SCHED; PG8_LDA(At, 0, 0); PG8_STAGE(PG8_SA(1, 1), a1 + hstep, voffA);
            PG8_WAIT_V(8); PG8_WAIT_L(0); PG8_BAR; PG8_MMA(0, 0, At, B0); PG8_MMA(0, 1, At, B1); PG8_BAR; PG8_SCHED;
            PG8_LDA(At, 0, 1); PG8_STAGE(PG8_SB(0, 0), b2, voffB); PG8_STAGE(PG8_SB(0, 1), b2 + hstep, voffB); PG8_STAGE(PG8_SA(0, 0), a2, voffA);
            PG8_WAIT_V(8); PG8_WAIT_L(0); PG8_BAR; PG8_MMA(1, 0, At, B0); PG8_MMA(1, 1, At, B1); PG8_BAR; PG8_SCHED;
            PG8_LDB(B0, 1, 0); PG8_LDB(B1, 1, 1); PG8_SCHED; PG8_LDA(At, 1, 0); PG8_STAGE(PG8_SA(0, 1), a2 + hstep, voffA);
            PG8_WAIT_V(8); PG8_WAIT_L(0); PG8_BAR; PG8_MMA(0, 0, At, B0); PG8_MMA(0, 1, At, B1); PG8_BAR; PG8_SCHED;
            PG8_LDA(At, 1, 1); PG8_STAGE(PG8_SB(1, 0), b3, voffB); PG8_STAGE(PG8_SB(1, 1), b3 + hstep, voffB); PG8_STAGE(PG8_SA(1, 0), a3, voffA);
            PG8_WAIT_V(8); PG8_WAIT_L(0); PG8_BAR; PG8_MMA(1, 0, At, B0); PG8_MMA(1, 1, At, B1); PG8_BAR; PG8_SCHED;
            } else {
            PG8_LDB(B0, 0, 0); PG8_SCHED; PG8_LDA(At, 0, 0); PG8_STAGE(PG8_SA(1, 1), a1 + hstep, voffA);
            PG8_WAIT_L(8); PG8_BAR; PG8_WAIT_L(0); PG8_MMA(0, 0, At, B0); PG8_BAR; PG8_SCHED;
            PG8_LDB(B1, 0, 1); PG8_STAGE(PG8_SB(0, 0), b2, voffB);
            PG8_BAR; PG8_WAIT_L(0); PG8_MMA(0, 1, At, B1); PG8_BAR;
            PG8_LDA(At, 0, 1); PG8_STAGE(PG8_SA(0, 0), a2, voffA);
            PG8_BAR; PG8_WAIT_L(0); PG8_MMA(1, 0, At, B0); PG8_BAR; PG8_SCHED;
            PG8_STAGE(PG8_SB(0, 1), b2 + hstep, voffB);
            PG8_WAIT_V(6); PG8_BAR; PG8_MMA(1, 1, At, B1); PG8_BAR;
            PG8_LDB(B0, 1, 0); PG8_SCHED; PG8_LDA(At, 1, 0); PG8_STAGE(PG8_SA(0, 1), a2 + hstep, voffA);
            PG8_WAIT_L(8); PG8_BAR; PG8_WAIT_L(0); PG8_MMA(0, 0, At, B0); PG8_BAR; PG8_SCHED;
            PG8_LDB(B1, 1, 1); PG8_STAGE(PG8_SB(1, 0), b3, voffB);
            PG8_BAR; PG8_WAIT_L(0); PG8_MMA(0, 1, At, B1); PG8_BAR;
            PG8_LDA(At, 1, 1); PG8_STAGE(PG8_SA(1, 0), a3, voffA);
            PG8_BAR; PG8_WAIT_L(0); PG8_MMA(1, 0, At, B0); PG8_BAR; PG8_SCHED;
            PG8_STAGE(PG8_SB(1, 1), b3 + hstep, voffB);
            PG8_WAIT_V(6); PG8_BAR; PG8_MMA(1, 1, At, B1); PG8_BAR;
            }
        }
        if constexpr (ALIGN_EPI) { if (wr == 0) PG8_BAR; }
        if constexpr (!Epi::AFTER_DRAIN) { E(acc, cur, wr, wc, fr, fq); S.done(cur); }
        if (!has_next) break;
#pragma unroll
        for (int a = 0; a < 2; ++a)
#pragma unroll
            for (int b = 0; b < 2; ++b)
#pragma unroll
                for (int m = 0; m < 4; ++m)
#pragma unroll
                    for (int n = 0; n < 2; ++n) acc[a][b][m][n] = (f32x4){0.f, 0.f, 0.f, 0.f};
        cur = nxt; cA = nA; cB = nB; ++ui;
        if constexpr (ALIGN_EPI) { if (wr == 1) PG8_BAR; }
    }
    PG8_WAIT_V(0);
    if constexpr (!ALIGN_EPI) { if (wr == 0) PG8_BAR; }
    PG8_BAR;
    if constexpr (Epi::AFTER_DRAIN) { E.fused(acc, cur, wr, wc, fr, fq, lds, wid, lane); S.done(cur); }
#undef PG8_SA
#undef PG8_SB
#undef PG8_STAGE
#undef PG8_LDA
#undef PG8_LDB
#undef PG8_MMA
#undef PG8_WAIT_V
#undef PG8_WAIT_L
#undef PG8_BAR
#undef PG8_SCHED
}
}
namespace att {
#define LAS __attribute__((address_space(3)))
typedef unsigned short bf16_t;
typedef short bf16x8 __attribute__((ext_vector_type(8)));
typedef short s16x4 __attribute__((ext_vector_type(4)));
typedef float f32x16 __attribute__((ext_vector_type(16)));
typedef float f32x4 __attribute__((ext_vector_type(4)));
typedef unsigned u32x4 __attribute__((ext_vector_type(4)));
constexpr int LP = 2048, PADF = 48, PITCH = 3072;
constexpr int KV_BUF = 32768, V_OFF = 16384, OST_OFF = 65536, OST_PITCH = 272, OST_WAVE = 32 * OST_PITCH, WSF_OFF = OST_OFF + 8 * OST_WAVE, ATT_LDS = WSF_OFF + 8 * 256;
__device__ __forceinline__ int crow(int r, int hi) { return (r & 3) + 8 * (r >> 2) + 4 * hi; }
__device__ __forceinline__ unsigned cvtpk(float lo, float hi) { unsigned r; asm volatile("v_cvt_pk_bf16_f32 %0, %1, %2" : "=v"(r) : "v"(lo), "v"(hi)); return r; }
__device__ __forceinline__ s16x4 vtr(const LAS unsigned char* p) { return __builtin_bit_cast(s16x4, __builtin_amdgcn_ds_read_tr16_b64_v4i16((LAS s16x4*)p)); }

__device__ __forceinline__ void stage_tile(LAS unsigned char* lds, int bufoff, const bf16_t* QKV, const bf16_t* MQKV, long rowbase, int h, int t, int wid, int lane) {
    const bf16_t* src = (t == 0) ? MQKV : QKV + (size_t)(rowbase + 64 * (t - 1)) * PITCH;
#pragma unroll
    for (int i = 0; i < 2; ++i) {
        const int ci = 2 * wid + i;
        const bf16_t* ks = src + (size_t)lane * PITCH + 1024 + h * 128 + ci * 8;
        __builtin_amdgcn_global_load_lds((const unsigned*)ks, (LAS unsigned*)(lds + bufoff + ci * 1024), 16, 0, 0);
    }
#pragma unroll
    for (int i = 0; i < 2; ++i) {
        const int pi = 2 * wid + i, db = pi >> 2, kg = pi & 3;
        const bf16_t* vs = src + (size_t)(16 * kg + (lane >> 2)) * PITCH + 2048 + h * 128 + db * 32 + (lane & 3) * 8;
        __builtin_amdgcn_global_load_lds((const unsigned*)vs, (LAS unsigned*)(lds + bufoff + V_OFF + pi * 1024), 16, 0, 0);
    }
}

__device__ __forceinline__ void attn_unit(LAS unsigned char* lds, const bf16_t* QKV, const bf16_t* MQKV, bf16_t* O, int b, int h, int q0, int nqw, float lam, const float* subg, const int wid) {
    const int lane = pg8::lane_id_v(), r32 = lane & 31, hi = lane >> 5;
    const long rowbase = (long)b * LP;
    const int NT = (q0 + 32 * nqw) >> 6;
    const bool active = wid < nqw;
    const int qabs = q0 + 32 * wid + r32, qfirst = q0 + 32 * wid, qlast = qfirst + 31;
    LAS unsigned char* qw = lds + OST_OFF + wid * OST_WAVE + lane * 16;
    {
        const bf16_t* qp = QKV + (size_t)(rowbase + (active ? qabs - 64 : 0)) * PITCH + h * 128 + hi * 8;
#pragma unroll
        for (int j = 0; j < 8; ++j) *(LAS bf16x8*)(qw + j * 1024) = *(const bf16x8*)(qp + (j >> 2) * 64 + (j & 3) * 16);
    }
    f32x16 o[2][4];
#pragma unroll
    for (int c = 0; c < 2; ++c)
#pragma unroll
        for (int db = 0; db < 4; ++db)
#pragma unroll
            for (int r = 0; r < 16; ++r) o[c][db][r] = 0.f;
    float lsum[2] = {0.f, 0.f};
    stage_tile(lds, 0, QKV, MQKV, rowbase, h, 0, wid, lane);
    for (int t = 0; t < NT; ++t) {
        __syncthreads();
        const int buf = (t & 1) * KV_BUF;
        if (t + 1 < NT) stage_tile(lds, ((t + 1) & 1) * KV_BUF, QKV, MQKV, rowbase, h, t + 1, wid, lane);
        if (active && 64 * t <= qlast) {
            const bool needmask = (t == 0) || (64 * t + 63 > qfirst);
            const LAS unsigned char* kb = lds + buf + hi * 1024 + r32 * 16;
            const LAS unsigned char* vp = lds + buf + V_OFF + ((lane >> 4) & 1) * 32 + (lane & 3) * 8 + (4 * hi + ((lane & 15) >> 2)) * 64;
            int mhi = qabs - 64 * t - 4 * hi, mlo = PADF - 64 * t - 4 * hi;
            asm volatile("" : "+v"(mhi), "+v"(mlo));
#pragma unroll
            for (int c = 0; c < 2; ++c) {
                f32x16 p0, p1;
#pragma unroll
                for (int r = 0; r < 16; ++r) { p0[r] = 0.f; p1[r] = 0.f; }
#pragma unroll
                for (int d0 = 0; d0 < 4; ++d0) {
                    const bf16x8 k0 = *(const LAS bf16x8*)(kb + (c * 8 + 2 * d0) * 1024);
                    const bf16x8 k1 = *(const LAS bf16x8*)(kb + (c * 8 + 2 * d0) * 1024 + 512);
                    const bf16x8 qv = *(const LAS bf16x8*)(qw + (c * 4 + d0) * 1024);
                    p0 = __builtin_amdgcn_mfma_f32_32x32x16_bf16(k0, qv, p0, 0, 0, 0);
                    p1 = __builtin_amdgcn_mfma_f32_32x32x16_bf16(k1, qv, p1, 0, 0, 0);
                    if (d0 == 1) __builtin_amdgcn_sched_barrier(0);
                }
#pragma unroll
                for (int r = 0; r < 16; ++r) { p0[r] = __builtin_amdgcn_exp2f(p0[r]); p1[r] = __builtin_amdgcn_exp2f(p1[r]); }
                if (needmask) {
#pragma unroll
                    for (int r = 0; r < 16; ++r) { const int cr = (r & 3) + 8 * (r >> 2);
                        if (cr > mhi) p0[r] = 0.f;
                        if (cr + 32 > mhi) p1[r] = 0.f; }
                    if (t == 0) {
#pragma unroll
                        for (int r = 0; r < 16; ++r) { const int cr = (r & 3) + 8 * (r >> 2);
                            if (cr < mlo) p0[r] = 0.f;
                            if (cr + 32 < mlo) p1[r] = 0.f; }
                    }
                }
                float s = 0.f;
#pragma unroll
                for (int r = 0; r < 16; ++r) s += p0[r] + p1[r];
                lsum[c] += s;
                u32x4 pw[4];
                pw[0] = (u32x4){cvtpk(p0[0], p0[1]), cvtpk(p0[2], p0[3]), cvtpk(p0[4], p0[5]), cvtpk(p0[6], p0[7])};
                pw[1] = (u32x4){cvtpk(p0[8], p0[9]), cvtpk(p0[10], p0[11]), cvtpk(p0[12], p0[13]), cvtpk(p0[14], p0[15])};
                pw[2] = (u32x4){cvtpk(p1[0], p1[1]), cvtpk(p1[2], p1[3]), cvtpk(p1[4], p1[5]), cvtpk(p1[6], p1[7])};
                pw[3] = (u32x4){cvtpk(p1[8], p1[9]), cvtpk(p1[10], p1[11]), cvtpk(p1[12], p1[13]), cvtpk(p1[14], p1[15])};
                __builtin_amdgcn_sched_barrier(0);
#pragma unroll
                for (int db = 0; db < 4; ++db) {
#pragma unroll
                    for (int ks = 0; ks < 4; ++ks) {
                        const s16x4 lo = vtr(vp + db * 4096 + ks * 1024), hh = vtr(vp + db * 4096 + ks * 1024 + 512);
                        const bf16x8 vf = (bf16x8){lo[0], lo[1], lo[2], lo[3], hh[0], hh[1], hh[2], hh[3]};
                        o[c][db] = __builtin_amdgcn_mfma_f32_32x32x16_bf16(__builtin_bit_cast(bf16x8, pw[ks]), vf, o[c][db], 0, 0, 0);
                    }
                    __builtin_amdgcn_sched_barrier(0);
                }
            }
        }
    }
    if (active) {
        float l0 = lsum[0], l1 = lsum[1];
        l0 += __shfl_xor(l0, 32); l1 += __shfl_xor(l1, 32);
        LAS float* wsf = (LAS float*)(lds + WSF_OFF) + wid * 64;
        if (hi == 0) { wsf[r32] = l0; wsf[32 + r32] = l1; }
        asm volatile("s_waitcnt lgkmcnt(0)" ::: "memory");
#pragma unroll
        for (int r = 0; r < 16; ++r) { const float a0 = wsf[crow(r, hi)], a1 = wsf[32 + crow(r, hi)];
            const float rl0 = a0 > 0.f ? 1.0f / a0 : 0.f, rl1 = a1 > 0.f ? lam / a1 : 0.f; float s = 0.f;
#pragma unroll
            for (int db = 0; db < 4; ++db) { const float v = o[0][db][r] * rl0 - o[1][db][r] * rl1; o[0][db][r] = v; s += v * v; }
            s += __shfl_xor(s, 1); s += __shfl_xor(s, 2); s += __shfl_xor(s, 4); s += __shfl_xor(s, 8); s += __shfl_xor(s, 16);
            const float rn = rsqrtf(s * (1.0f / 128.0f) + 1e-6f) * 0.8f;
#pragma unroll
            for (int db = 0; db < 4; ++db) o[0][db][r] *= rn; }
        LAS unsigned short* stg = (LAS unsigned short*)(lds + OST_OFF + wid * OST_WAVE);
#pragma unroll
        for (int db = 0; db < 4; ++db) { const float sg = subg[db * 32 + r32];
#pragma unroll
            for (int r = 0; r < 16; ++r) { const unsigned w = cvtpk(o[0][db][r] * sg, 0.f); stg[crow(r, hi) * (OST_PITCH / 2) + db * 32 + r32] = (unsigned short)(w & 0xffffu); } }
        asm volatile("s_waitcnt lgkmcnt(0)" ::: "memory");
        int lsel = lane; asm volatile("" : "+v"(lsel));
        bf16_t* Ow = O + (size_t)(rowbase + qfirst - 64 + (lsel >> 4)) * 1024 + h * 128 + (lsel & 15) * 8;
        const LAS unsigned char* sp = (const LAS unsigned char*)stg + (lsel >> 4) * OST_PITCH + (lsel & 15) * 16;
#pragma unroll
        for (int it = 0; it < 8; ++it) { const u32x4 v = *(const LAS u32x4*)(sp + it * 4 * OST_PITCH); *(u32x4*)Ow = v; Ow += 4 * 1024; asm volatile("" : "+v"(Ow)); }
    }
    __syncthreads();
}
}
typedef unsigned short bf16;
typedef unsigned v4u __attribute__((ext_vector_type(4)));
typedef float f32x4 __attribute__((ext_vector_type(4)));
typedef short bf16x8 __attribute__((ext_vector_type(8)));
constexpr int NWAVES = 8;
#ifndef MK_PER_PHASE
#define MK_PER_PHASE 0
#endif
constexpr int NPHASE = 13;
#ifndef PROBE_DUP
#define PROBE_DUP -1
#endif
#define REPS(k) for (int rep_ = 0; rep_ < ((PROBE_DUP) == (k) ? 2 : 1); ++rep_)
constexpr int D = 1024, NB = 32, SEQ = 2048, LTOK = 2064, NMETA = 16, LP = 2048, MP = NB * LP;
constexpr int NQKV = 3072, DFF = 2816, NGU = 5632;
constexpr size_t al256(size_t x) { return (x + 255) & ~(size_t)255; }
constexpr size_t WS_WQKV = 0;
constexpr size_t WS_WO   = WS_WQKV + (size_t)NQKV * D * 2;
constexpr size_t WS_WGU0 = WS_WO + (size_t)D * D * 2;
constexpr size_t WS_WD0  = WS_WGU0 + (size_t)NGU * D * 2;
constexpr size_t WS_WIN  = WS_WD0 + (size_t)D * DFF * 2;
constexpr size_t WS_WOUT = WS_WIN + (size_t)NQKV * D * 2;
constexpr size_t WS_WGU1 = WS_WOUT + (size_t)D * D * 2;
constexpr size_t WS_WD1  = WS_WGU1 + (size_t)NGU * D * 2;
constexpr size_t WS_ROPE = WS_WD1 + (size_t)D * DFF * 2;
constexpr size_t WS_SSP  = WS_ROPE + al256((size_t)LTOK * 32 * 2 * 4);
constexpr size_t WS_H    = WS_SSP + (size_t)MP * 16 * 4;
constexpr size_t WS_XB   = WS_H;
constexpr size_t WS_BIG  = WS_XB + (size_t)MP * D * 2;
constexpr size_t WS_O    = WS_BIG + (size_t)MP * NQKV * 2;
constexpr size_t WS_MXB  = WS_O + (size_t)MP * D * 2;
constexpr size_t WS_MRS  = WS_MXB + 16 * 1024 * 2;
constexpr size_t WS_MC1  = WS_MRS + 256;
constexpr size_t WS_MQKV = WS_MC1 + 16 * 3072 * 4;
constexpr size_t WS_MOM  = WS_MQKV + 64 * 3072 * 2;
constexpr size_t WS_MC2  = WS_MOM + 16 * 1024 * 2;
constexpr size_t WS_MC3  = WS_MC2 + 16 * 1024 * 4;
constexpr size_t WS_MH1  = WS_MC3 + 16 * 5632 * 4;
constexpr size_t WS_MHID = WS_MH1 + 16 * 1024 * 4;
constexpr size_t WS_MC4  = WS_MHID + 16 * 2816 * 2;
constexpr size_t WS_MC5  = WS_MC4 + 16 * 1024 * 4;
constexpr size_t WS_MZ   = WS_MC5 + 16 * 2048 * 4;
constexpr size_t WS_CTL  = WS_MZ + 16 * 1024 * 2;
constexpr size_t CTL_BYTES = 16384;
constexpr size_t WS_END  = WS_CTL + CTL_BYTES;
constexpr int LDS_BYTES = 147456;
static_assert(att::ATT_LDS <= LDS_BYTES && pg8::STAGE_BYTES <= LDS_BYTES, "LDS map");

__device__ __forceinline__ unsigned f2bf(float f) { unsigned u = __builtin_bit_cast(unsigned, f); return (u + 0x7fffu + ((u >> 16) & 1u)) >> 16; }
__device__ __forceinline__ unsigned pk2(float lo, float hi) { return f2bf(lo) | (f2bf(hi) << 16); }
__device__ __forceinline__ float wave_sum(float v) {
#pragma unroll
    for (int o = 1; o < 64; o <<= 1) v += __shfl_xor(v, o);
    return v;
}
__device__ __forceinline__ float wave_max(float v) {
#pragma unroll
    for (int o = 1; o < 64; o <<= 1) v = fmaxf(v, __shfl_xor(v, o));
    return v;
}
__device__ __forceinline__ int col_perm(int mode, int n) {
    if (mode == 1) return (n & ~255) + 128 * ((n >> 5) & 1) + 32 * ((n >> 6) & 3) + (n & 31);
    if (mode == 2) { const int up = n >= DFF ? 1 : 0, j = n - up * DFF; return 256 * (j >> 7) + 128 * up + (j & 127); }
    if (mode == 3) { if (n < 1024) return 2048 + n; const int up = n >= 2048 ? 1 : 0, j = (n - 1024) & 1023; return 256 * (j >> 7) + 128 * up + (j & 127); }
    return n;
}
__device__ __forceinline__ void transpose_item(const float* W, int K, int N, bf16* WT, const float* gain, int mode, LAS float* scr, int item, int lane) {
    const int nblk = N / 32, kb = item / nblk, nb = item % nblk, k0 = 64 * kb, n0 = 32 * nb;
#pragma unroll 8
    for (int i = 0; i < 32; ++i) { const int kk = 2 * i + (lane >> 5); scr[kk * 33 + (lane & 31)] = W[(size_t)(k0 + kk) * N + n0 + (lane & 31)]; }
    asm volatile("s_waitcnt lgkmcnt(0)" ::: "memory");
    const int c = lane & 7;
    float gv[8];
#pragma unroll
    for (int e = 0; e < 8; ++e) gv[e] = gain ? gain[k0 + 8 * c + e] : 1.0f;
#pragma unroll
    for (int j = 0; j < 4; ++j) { const int n = (lane >> 3) + 8 * j; const LAS float* s = scr + (8 * c) * 33 + n;
        v4u o; o.x = pk2(s[0 * 33] * gv[0], s[1 * 33] * gv[1]); o.y = pk2(s[2 * 33] * gv[2], s[3 * 33] * gv[3]); o.z = pk2(s[4 * 33] * gv[4], s[5 * 33] * gv[5]); o.w = pk2(s[6 * 33] * gv[6], s[7 * 33] * gv[7]);
        *(v4u*)(WT + (size_t)col_perm(mode, n0 + n) * K + k0 + 8 * c) = o; }
    asm volatile("s_waitcnt lgkmcnt(0)" ::: "memory");
}
__device__ __forceinline__ void sincos_acc(float angf, float& c, float& s) {
    const double TWO_PI = 6.283185307179586476925286766559;
    double a = (double)angf; const double n = rint(a / TWO_PI); double r = a - n * TWO_PI;
    const double r2 = r * r; double cs = 1.0, sn = r, tc = 1.0, ts = r;
#pragma unroll 1
    for (int k = 1; k <= 14; ++k) { tc = -tc * r2 / (double)((2 * k - 1) * (2 * k)); ts = -ts * r2 / (double)((2 * k) * (2 * k + 1)); cs += tc; sn += ts; }
    c = (float)cs; s = (float)sn;
}

#define XB_TMO      128
#define XB_XCNT(j)  (256  + 64 * (j))
#define XB_XSUB(j)  (1280 + 64 * (j))
#define XB_XGEN(j)  (2304 + 64 * (j))
#define XB_TOP      3328
#define XB_TOPGEN   3392
#define XCD_BAR_WORDS 3456
#define XB_SPIN_CAP (1u << 18)

__device__ __forceinline__ unsigned xb_ld(unsigned* p)              { return __hip_atomic_load(p, __ATOMIC_RELAXED, __HIP_MEMORY_SCOPE_AGENT); }
__device__ __forceinline__ unsigned xb_add(unsigned* p, unsigned v) { return __hip_atomic_fetch_add(p, v, __ATOMIC_RELAXED, __HIP_MEMORY_SCOPE_AGENT); }
__device__ __forceinline__ unsigned xb_xcc_id() { return (unsigned)__builtin_amdgcn_s_getreg((3 << 11) | 20) & 0xFu; }
#define XB_SPIN(cond, bar) do { unsigned _sp = 0; while (cond) { __builtin_amdgcn_s_sleep(1); \
    if ((++_sp & 255u) == 0u) { if (xb_ld(&(bar)[XB_TMO])) break; if (_sp > XB_SPIN_CAP) { atomicAdd(&(bar)[XB_TMO], 1u); break; } } } } while (0)

struct XcdBarrier {
    unsigned* bar; unsigned x;
    volatile LAS unsigned* st;
};

__device__ __forceinline__ XcdBarrier xcd_barrier_post(unsigned* bar, volatile LAS unsigned* st) {
    XcdBarrier b; b.bar = bar; b.x = xb_xcc_id(); b.st = st;
    if (threadIdx.x == 0) (void)xb_add(&bar[XB_XCNT(b.x)], 1u);
    return b;
}
__device__ __forceinline__ void xcd_barrier_complete(unsigned* bar, unsigned x, unsigned& nloc, unsigned& nx) {
    const unsigned G = gridDim.x * gridDim.y * gridDim.z;
    unsigned sum, cnt, mine, sp = 0u;
    for (;;) {
        sum = 0u; cnt = 0u; mine = 0u;
#pragma unroll
        for (unsigned j = 0; j < 16; ++j) { const unsigned c = xb_ld(&bar[XB_XCNT(j)]); sum += c; cnt += (c > 0u) ? 1u : 0u; mine = (j == x) ? c : mine; }
        if (sum == G) break;
        __builtin_amdgcn_s_sleep(1);
        if ((++sp & 255u) == 0u) { if (xb_ld(&bar[XB_TMO])) break; if (sp > XB_SPIN_CAP) { atomicAdd(&bar[XB_TMO], 1u); break; } }
    }
    nloc = mine > 0u ? mine : 1u; nx = cnt > 0u ? cnt : 1u;
}

__device__ __forceinline__ void xcd_barrier(const XcdBarrier& b) {
    asm volatile("s_waitcnt vmcnt(0)" ::: "memory");
    __syncthreads();
    if (threadIdx.x == 0) {
        unsigned* bar = b.bar;
        __builtin_amdgcn_s_waitcnt(0);
        unsigned nloc = b.st[0], nx = b.st[1];
        if (nloc == 0u) { xcd_barrier_complete(bar, b.x, nloc, nx); b.st[0] = nloc; b.st[1] = nx; }
        const unsigned old = xb_add(&bar[XB_XSUB(b.x)], 1u);
        const unsigned gen = old / nloc;
        if (old + 1u == (gen + 1u) * nloc) {
            __builtin_amdgcn_fence(__ATOMIC_RELEASE, "agent");
            asm volatile("s_waitcnt vmcnt(0)" ::: "memory");
            const unsigned og = xb_add(&bar[XB_TOP], 1u);
            const unsigned tg = og / nx;
            if (og + 1u == (tg + 1u) * nx) xb_add(&bar[XB_TOPGEN], 1u);
            else XB_SPIN(xb_ld(&bar[XB_TOPGEN]) == tg, bar);
            __builtin_amdgcn_fence(__ATOMIC_ACQUIRE, "agent");
            xb_add(&bar[XB_XGEN(b.x)], 1u);
            asm volatile("s_waitcnt vmcnt(0)" ::: "memory");
        } else {
            XB_SPIN(xb_ld(&bar[XB_XGEN(b.x)]) == gen, bar);
            __builtin_amdgcn_fence(__ATOMIC_ACQUIRE, "agent");
            asm volatile("s_waitcnt vmcnt(0)" ::: "memory");
        }
    }
    __syncthreads();
}

constexpr int MISC_OFF = LDS_BYTES - 64;
struct Args { const float* in[18]; float* out; unsigned char* ws; int ph_lo, ph_hi; };

__device__ __forceinline__ void prologue(const Args& a, LAS unsigned char* lds, int wave, int lane, int gw, int NGW) {
    unsigned char* ws = a.ws;
    LAS float* scr = (LAS float*)(lds + wave * 16384);
    const float* mix_g = a.in[2]; const float* ffn_g = a.in[3];
    constexpr int I_QKV = (D / 64) * (NQKV / 32), I_O = (D / 64) * (D / 32), I_GU = (D / 64) * (NGU / 32), I_DN = (DFF / 64) * (D / 32);
    constexpr int NITEMS = 2 * I_QKV + 2 * I_O + 2 * I_GU + 2 * I_DN;
    for (int it = gw; it < NITEMS; it += NGW) {
        int r = it;
        if (r < I_QKV) { transpose_item(a.in[4], D, NQKV, (bf16*)(ws + WS_WQKV), mix_g, 1, scr, r, lane); continue; } r -= I_QKV;
        if (r < I_O)   { transpose_item(a.in[12], D, D, (bf16*)(ws + WS_WO), nullptr, 0, scr, r, lane); continue; } r -= I_O;
        if (r < I_GU)  { transpose_item(a.in[16], D, NGU, (bf16*)(ws + WS_WGU0), ffn_g, 2, scr, r, lane); continue; } r -= I_GU;
        if (r < I_DN)  { transpose_item(a.in[17], DFF, D, (bf16*)(ws + WS_WD0), nullptr, 0, scr, r, lane); continue; } r -= I_DN;
        if (r < I_QKV) { transpose_item(a.in[13], D, NQKV, (bf16*)(ws + WS_WIN), mix_g + D, 3, scr, r, lane); continue; } r -= I_QKV;
        if (r < I_O)   { transpose_item(a.in[15], D, D, (bf16*)(ws + WS_WOUT), nullptr, 0, scr, r, lane); continue; } r -= I_O;
        if (r < I_GU)  { transpose_item(a.in[16] + (size_t)D * NGU, D, NGU, (bf16*)(ws + WS_WGU1), ffn_g + D, 2, scr, r, lane); continue; } r -= I_GU;
        transpose_item(a.in[17] + (size_t)DFF * D, DFF, D, (bf16*)(ws + WS_WD1), nullptr, 0, scr, r, lane);
    }
    { float* rope = (float*)(ws + WS_ROPE);
      for (int e = gw * 64 + lane; e < LTOK * 32; e += NGW * 64) { const int pos = e >> 5, i = e & 31;
          const float inv = (float)exp(-9.210340371976184 * (double)(2 * i) / 64.0);
          const float ang = (float)pos * inv; float c, s; sincos_acc(ang, c, s); rope[2 * e] = c; rope[2 * e + 1] = s; } }
    { const float* x = a.in[0]; bf16* XB = (bf16*)(ws + WS_XB); float* ssp = (float*)(ws + WS_SSP);
      for (int m = gw; m < MP; m += NGW) {
          const float* src = x + (size_t)m * D;
          f32x4 v[4]; float s = 0.f;
#pragma unroll
          for (int j = 0; j < 4; ++j) { v[j] = *((const f32x4*)src + 64 * j + lane); s += (v[j][0] * v[j][0] + v[j][1] * v[j][1]) + (v[j][2] * v[j][2] + v[j][3] * v[j][3]); }
          s = wave_sum(s);
#pragma unroll
          for (int j = 0; j < 4; ++j) *((unsigned long long*)(XB + (size_t)m * D) + 64 * j + lane) = (unsigned long long)pk2(v[j][0], v[j][1]) | ((unsigned long long)pk2(v[j][2], v[j][3]) << 32);
          if (lane < 16) ssp[(size_t)m * 16 + lane] = lane == 0 ? s : 0.f; } }
    { const float* meta = a.in[1]; bf16* MXB = (bf16*)(ws + WS_MXB); float* mrs = (float*)(ws + WS_MRS);
      if (gw < NMETA) { const int m = gw; const float* src = meta + (size_t)m * D; f32x4 v[4]; float s = 0.f;
#pragma unroll
          for (int j = 0; j < 4; ++j) { v[j] = *((const f32x4*)src + 64 * j + lane); s += (v[j][0] * v[j][0] + v[j][1] * v[j][1]) + (v[j][2] * v[j][2] + v[j][3] * v[j][3]); }
          s = wave_sum(s);
#pragma unroll
          for (int j = 0; j < 4; ++j) *((unsigned long long*)(MXB + (size_t)m * D) + 64 * j + lane) = (unsigned long long)pk2(v[j][0], v[j][1]) | ((unsigned long long)pk2(v[j][2], v[j][3]) << 32);
          if (lane == 0) mrs[m] = s; }
      v4u* mz = (v4u*)(ws + WS_MQKV);
      for (int e = gw * 64 + lane; e < 48 * 3072 * 2 / 16; e += NGW * 64) mz[e] = (v4u){0u, 0u, 0u, 0u}; }
}
template <int AMODE> __device__ __forceinline__ void skinny_gemm(const bf16* A, const float* P, const float* Q, int K, const bf16* Bt, int mode, int n_src0, int ntiles, float* C, int ldc, int gw, int NGW, int lane) {
    const int fr = lane & 15, fq = lane >> 4;
    for (int tile = gw; tile < ntiles; tile += NGW) {
        const bf16* bp = Bt + (size_t)col_perm(mode, n_src0 + tile * 16 + fr) * K + 8 * fq;
        f32x4 acc = {0.f, 0.f, 0.f, 0.f};
#pragma unroll 4
        for (int kk = 0; kk < K; kk += 32) {
            bf16x8 av;
            if (AMODE == 0) av = *(const bf16x8*)(A + (size_t)fr * K + kk + 8 * fq);
            else { const float* pp = P + (size_t)fr * K + kk + 8 * fq; const float* qq = Q + (size_t)fr * K + kk + 8 * fq;
                const f32x4 p0 = *(const f32x4*)pp, p1 = *(const f32x4*)(pp + 4), q0 = *(const f32x4*)qq, q1 = *(const f32x4*)(qq + 4);
                v4u t; t.x = pk2(p0[0] + q0[0], p0[1] + q0[1]); t.y = pk2(p0[2] + q0[2], p0[3] + q0[3]); t.z = pk2(p1[0] + q1[0], p1[1] + q1[1]); t.w = pk2(p1[2] + q1[2], p1[3] + q1[3]);
                av = __builtin_bit_cast(bf16x8, t); }
            const bf16x8 bv = *(const bf16x8*)(bp + kk);
            acc = __builtin_amdgcn_mfma_f32_16x16x32_bf16(av, bv, acc, 0, 0, 0);
        }
#pragma unroll
        for (int j = 0; j < 4; ++j) C[(size_t)(4 * fq + j) * ldc + tile * 16 + fr] = acc[j];
    }
}
__device__ __forceinline__ void meta_e1(const Args& a, LAS unsigned char* lds, int wave, int lane) {
    unsigned char* ws = a.ws;
    const float* C1 = (const float*)(ws + WS_MC1); const float* mrs = (const float*)(ws + WS_MRS); const float* rope = (const float*)(ws + WS_ROPE);
    bf16* MQ = (bf16*)(ws + WS_MQKV); bf16* OM = (bf16*)(ws + WS_MOM);
    const float* qg = a.in[5]; const float* kg = a.in[6]; const float* subg = a.in[11];
    const float lam = expf(wave_sum(a.in[7][lane] * a.in[8][lane])) - expf(wave_sum(a.in[9][lane] * a.in[10][lane])) + 0.2f;
    LAS float* kl = (LAS float*)(lds + wave * 16384);
    LAS float* vl = kl + 2048;
    const int h = wave, i = lane & 31;
#pragma unroll 1
    for (int r = 0; r < 16; ++r) {
        const float rs = rsqrtf(mrs[r] * (1.0f / 1024.0f) + 1e-6f);
        const float cs = rope[(r * 32 + i) * 2], sn = rope[(r * 32 + i) * 2 + 1];
#pragma unroll
        for (int c = 0; c < 2; ++c) {
            float x = C1[(size_t)r * 3072 + 1024 + h * 128 + c * 64 + lane] * rs;
            const float ss = wave_sum(x * x); x = x * rsqrtf(ss * (1.0f / 64.0f) + 1e-6f) * kg[lane];
            const float pr = __shfl_xor(x, 32); const float o = lane < 32 ? x * cs - pr * sn : x * cs + pr * sn;
            kl[(c * 16 + r) * 64 + lane] = o;
            MQ[(size_t)(48 + r) * 3072 + 1024 + h * 128 + c * 64 + lane] = (bf16)f2bf(o);
        }
#pragma unroll
        for (int hf = 0; hf < 2; ++hf) { const float v = C1[(size_t)r * 3072 + 2048 + h * 128 + hf * 64 + lane] * rs; vl[r * 128 + hf * 64 + lane] = v;
            MQ[(size_t)(48 + r) * 3072 + 2048 + h * 128 + hf * 64 + lane] = (bf16)f2bf(v); }
    }
    asm volatile("s_waitcnt lgkmcnt(0)" ::: "memory");
#pragma unroll 1
    for (int r = 0; r < 16; ++r) {
        const float rs = rsqrtf(mrs[r] * (1.0f / 1024.0f) + 1e-6f);
        const float cs = rope[(r * 32 + i) * 2], sn = rope[(r * 32 + i) * 2 + 1];
        float q0, q1;
        { float x = C1[(size_t)r * 3072 + h * 128 + lane] * rs; const float ss = wave_sum(x * x); x = x * rsqrtf(ss * (1.0f / 64.0f) + 1e-6f) * qg[lane];
          const float pr = __shfl_xor(x, 32); q0 = (lane < 32 ? x * cs - pr * sn : x * cs + pr * sn) * pg8::QSCALE_; }
        { float x = C1[(size_t)r * 3072 + h * 128 + 64 + lane] * rs; const float ss = wave_sum(x * x); x = x * rsqrtf(ss * (1.0f / 64.0f) + 1e-6f) * qg[lane];
          const float pr = __shfl_xor(x, 32); q1 = (lane < 32 ? x * cs - pr * sn : x * cs + pr * sn) * pg8::QSCALE_; }
        float l0 = 0.f, l1 = 0.f, o0a = 0.f, o0b = 0.f, o1a = 0.f, o1b = 0.f;
#pragma unroll 1
        for (int rp = 0; rp <= r; ++rp) {
            const float s0 = wave_sum(q0 * kl[rp * 64 + lane]), s1 = wave_sum(q1 * kl[(16 + rp) * 64 + lane]);
            const float p0 = __builtin_amdgcn_exp2f(s0), p1 = __builtin_amdgcn_exp2f(s1); l0 += p0; l1 += p1;
            const float va = vl[rp * 128 + lane], vb = vl[rp * 128 + 64 + lane];
            o0a += p0 * va; o0b += p0 * vb; o1a += p1 * va; o1b += p1 * vb;
        }
        const float oa = o0a / l0 - lam * o1a / l1, ob = o0b / l0 - lam * o1b / l1;
        const float rn = rsqrtf(wave_sum(oa * oa + ob * ob) * (1.0f / 128.0f) + 1e-6f) * 0.8f;
        OM[(size_t)r * 1024 + h * 128 + lane] = (bf16)f2bf(oa * rn * subg[lane]); OM[(size_t)r * 1024 + h * 128 + 64 + lane] = (bf16)f2bf(ob * rn * subg[64 + lane]);
    }
}
__device__ __forceinline__ void meta_e3(const Args& a, LAS unsigned char* lds, int wave, int lane) {
    unsigned char* ws = a.ws; const float* meta = a.in[1]; const float* C2 = (const float*)(ws + WS_MC2); float* H1 = (float*)(ws + WS_MH1);
    const float* C3 = (const float*)(ws + WS_MC3); bf16* HID = (bf16*)(ws + WS_MHID); LAS float* rsl = (LAS float*)lds;
#pragma unroll
    for (int rr = 0; rr < 2; ++rr) { const int r = 2 * wave + rr; float s = 0.f;
#pragma unroll
        for (int j = 0; j < 4; ++j) { const f32x4 v = *((const f32x4*)(meta + (size_t)r * D) + 64 * j + lane) + *((const f32x4*)(C2 + (size_t)r * D) + 64 * j + lane);
            *((f32x4*)(H1 + (size_t)r * D) + 64 * j + lane) = v; s += (v[0] * v[0] + v[1] * v[1]) + (v[2] * v[2] + v[3] * v[3]); }
        s = wave_sum(s); if (lane == 0) rsl[r] = rsqrtf(s * (1.0f / 1024.0f) + 1e-6f); }
    __syncthreads();
    for (int e = wave * 64 + lane; e < 16 * DFF; e += NWAVES * 64) { const int r = e / DFF, j = e - r * DFF; const float rs = rsl[r];
        const float g = C3[(size_t)r * NGU + j] * rs, u = C3[(size_t)r * NGU + DFF + j] * rs;
        HID[e] = (bf16)f2bf(g * __builtin_amdgcn_rcpf(1.0f + __expf(-g)) * u); }
    __syncthreads();
}
__device__ __forceinline__ void meta_e5(const Args& a, LAS unsigned char* lds, int wave, int lane) {
    unsigned char* ws = a.ws; const float* H1 = (const float*)(ws + WS_MH1); const float* C4 = (const float*)(ws + WS_MC4);
    const float* C5 = (const float*)(ws + WS_MC5); bf16* MZ = (bf16*)(ws + WS_MZ); LAS float* rsl = (LAS float*)lds;
#pragma unroll
    for (int rr = 0; rr < 2; ++rr) { const int r = 2 * wave + rr; float s = 0.f;
#pragma unroll
        for (int j = 0; j < 4; ++j) { const f32x4 v = *((const f32x4*)(H1 + (size_t)r * D) + 64 * j + lane) + *((const f32x4*)(C4 + (size_t)r * D) + 64 * j + lane);
            s += (v[0] * v[0] + v[1] * v[1]) + (v[2] * v[2] + v[3] * v[3]); }
        s = wave_sum(s); if (lane == 0) rsl[r] = rsqrtf(s * (1.0f / 1024.0f) + 1e-6f); }
    __syncthreads();
    for (int e = wave * 64 + lane; e < 16 * D; e += NWAVES * 64) { const int r = e >> 10, j = e & 1023; const float rs = rsl[r];
        MZ[e] = (bf16)f2bf((C5[(size_t)r * 2048 + j] * rs) * (C5[(size_t)r * 2048 + 1024 + j] * rs)); }
    __syncthreads();
}
__device__ __forceinline__ void conv_phase(const Args& a, int lane, int gw, int NGW) {
    const bf16* Z = (const bf16*)(a.ws + WS_BIG); const bf16* GB = Z + (size_t)MP * D; bf16* Y = (bf16*)(a.ws + WS_O); const float* cw = a.in[14];
    for (int it = gw; it < (MP / 16) * 2; it += NGW) {
        const int rb = it >> 1, col = (it & 1) * 512 + lane * 8, row0 = rb * 16, p0 = row0 % LP;
        float w0[8], w1[8], w2[8], zm2[8], zm1[8];
#pragma unroll
        for (int e = 0; e < 8; ++e) { w0[e] = cw[col + e]; w1[e] = cw[D + col + e]; w2[e] = cw[2 * D + col + e]; zm2[e] = 0.f; zm1[e] = 0.f; }
        { const bf16* MZ = (const bf16*)(a.ws + WS_MZ);
          const v4u a2 = *(const v4u*)(p0 != 0 ? Z + (size_t)(row0 - 2) * D + col : MZ + 14 * D + col), a1 = *(const v4u*)(p0 != 0 ? Z + (size_t)(row0 - 1) * D + col : MZ + 15 * D + col);
#pragma unroll
            for (int e = 0; e < 4; ++e) { zm2[2 * e] = __uint_as_float(a2[e] << 16); zm2[2 * e + 1] = __uint_as_float(a2[e] & 0xffff0000u); zm1[2 * e] = __uint_as_float(a1[e] << 16); zm1[2 * e + 1] = __uint_as_float(a1[e] & 0xffff0000u); } }
#pragma unroll 4
        for (int i = 0; i < 16; ++i) { const size_t off = (size_t)(row0 + i) * D + col; const v4u zz = *(const v4u*)(Z + off), gg = *(const v4u*)(GB + off);
            float z[8], g[8], y[8];
#pragma unroll
            for (int e = 0; e < 4; ++e) { z[2 * e] = __uint_as_float(zz[e] << 16); z[2 * e + 1] = __uint_as_float(zz[e] & 0xffff0000u); g[2 * e] = __uint_as_float(gg[e] << 16); g[2 * e + 1] = __uint_as_float(gg[e] & 0xffff0000u); }
#pragma unroll
            for (int e = 0; e < 8; ++e) { y[e] = g[e] * (w0[e] * zm2[e] + w1[e] * zm1[e] + w2[e] * z[e]); zm2[e] = zm1[e]; zm1[e] = z[e]; }
            v4u o; o.x = pk2(y[0], y[1]); o.y = pk2(y[2], y[3]); o.z = pk2(y[4], y[5]); o.w = pk2(y[6], y[7]);
            *(v4u*)(Y + off) = o; }
    }
}

__global__ void __launch_bounds__(NWAVES * 64, 2) mega_fwd(Args args) {
    extern __shared__ __attribute__((aligned(16))) unsigned char lds_raw[];
    LAS unsigned char* lds = (LAS unsigned char*)lds_raw;
    cg::grid_group grid = cg::this_grid();
    const int wave = __builtin_amdgcn_readfirstlane(threadIdx.x >> 6);
    const int G = gridDim.x, gw = blockIdx.x * NWAVES + wave, NGW = G * NWAVES;
    unsigned char* ws = args.ws;
    bf16* XB = (bf16*)(ws + WS_XB); float* SSP = (float*)(ws + WS_SSP); bf16* BIG = (bf16*)(ws + WS_BIG); bf16* OB = (bf16*)(ws + WS_O);
    const int lo = args.ph_lo, hi = args.ph_hi;
    if (threadIdx.x < 16) ((LAS unsigned*)(lds + MISC_OFF))[threadIdx.x] = 0u;
    __syncthreads();
    XcdBarrier bar = xcd_barrier_post((unsigned*)(ws + WS_CTL), (volatile LAS unsigned*)(lds + MISC_OFF));
#ifndef PHASE_MASK
#define PHASE_MASK 0x1fff
#endif
#define IN(k) (((PHASE_MASK >> (k)) & 1) && lo <= (k) && (k) < hi)
#define SEAM(k) do { if (IN(k) && IN((k) + 1)) { if ((k) == 0) grid.sync(); else xcd_barrier(bar); } } while (0)
    bf16* MXB = (bf16*)(ws + WS_MXB); const bf16* MQKV = (const bf16*)(ws + WS_MQKV);
    if (IN(0)) REPS(0) { prologue(args, lds, wave, pg8::lane_id_v(), gw, NGW); }
    SEAM(0);
    if (IN(1)) {
        skinny_gemm<0>(MXB, nullptr, nullptr, D, (const bf16*)(ws + WS_WQKV), 1, 0, NQKV / 16, (float*)(ws + WS_MC1), NQKV, gw, NGW, pg8::lane_id_v());
    }
    SEAM(1);
    if (IN(2)) {
        if (blockIdx.x == 0) meta_e1(args, lds, wave, pg8::lane_id_v());
    }
    SEAM(2);
    if (IN(3)) REPS(3) {
        skinny_gemm<0>((const bf16*)(ws + WS_MOM), nullptr, nullptr, D, (const bf16*)(ws + WS_WO), 0, 0, D / 16, (float*)(ws + WS_MC2), D, gw, NGW, pg8::lane_id_v());
        pg8::Gemm g{XB, (const bf16*)(ws + WS_WQKV), MP, NQKV, D}; pg8::StaticOrder S; S.init(MP, NQKV, G, (int)blockIdx.x);
        pg8::EpiQKV E{BIG, SSP, (const float*)(ws + WS_ROPE), args.in[5], args.in[6]};
        pg8::gemm_phase<pg8::EpiQKV, pg8::StaticOrder, true, true>(lds, g, S, E, wave);
    }
    SEAM(3);
    if (IN(4)) REPS(4) {
        skinny_gemm<1>(nullptr, args.in[1], (const float*)(ws + WS_MC2), D, (const bf16*)(ws + WS_WGU0), 2, 0, NGU / 16, (float*)(ws + WS_MC3), NGU, gw, NGW, pg8::lane_id_v());
        const int lane = pg8::lane_id_v();
        float s1 = wave_sum(args.in[7][lane] * args.in[8][lane]), s2 = wave_sum(args.in[9][lane] * args.in[10][lane]);
        const float lam = expf(s1) - expf(s2) + 0.2f;
        for (int bh = blockIdx.x; bh < NB * 8; bh += G) { const int b = bh >> 3, h = bh & 7;
#pragma unroll 1
            for (int j = 0; j < 8; ++j) att::attn_unit(lds, BIG, MQKV, OB, b, h, 64 + 256 * j, 8, lam, args.in[11], wave); }
    }
    SEAM(4);
    if (IN(5)) {
        if (blockIdx.x == 0) meta_e3(args, lds, wave, pg8::lane_id_v());
        pg8::Gemm g{OB, (const bf16*)(ws + WS_WO), MP, D, D}; pg8::StaticOrder S; S.init(MP, D, G, (int)blockIdx.x);
        pg8::EpiRes<0> E{args.in[0], XB, SSP, nullptr};
        pg8::gemm_phase<pg8::EpiRes<0>, pg8::StaticOrder, true, true>(lds, g, S, E, wave);
    }
    SEAM(5);
    if (IN(6)) REPS(6) {
        skinny_gemm<0>((const bf16*)(ws + WS_MHID), nullptr, nullptr, DFF, (const bf16*)(ws + WS_WD0), 0, 0, D / 16, (float*)(ws + WS_MC4), D, gw, NGW, pg8::lane_id_v());
        pg8::Gemm g{XB, (const bf16*)(ws + WS_WGU0), MP, NGU, D}; pg8::StaticOrder S; S.init(MP, NGU, G, (int)blockIdx.x);
        pg8::EpiGateUp E{BIG, SSP};
        pg8::gemm_phase<pg8::EpiGateUp, pg8::StaticOrder, true, true>(lds, g, S, E, wave);
    }
    SEAM(6);
    if (IN(7)) {
        skinny_gemm<1>(nullptr, (const float*)(ws + WS_MH1), (const float*)(ws + WS_MC4), D, (const bf16*)(ws + WS_WIN), 3, 1024, 2048 / 16, (float*)(ws + WS_MC5), 2048, gw, NGW, pg8::lane_id_v());
        pg8::Gemm g{BIG, (const bf16*)(ws + WS_WD0), MP, D, DFF}; pg8::StaticOrder S; S.init(MP, D, G, (int)blockIdx.x);
        pg8::EpiRes<1> E{nullptr, XB, SSP, nullptr};
        pg8::gemm_phase<pg8::EpiRes<1>, pg8::StaticOrder, true, true>(lds, g, S, E, wave);
    }
    SEAM(7);
    if (IN(8)) REPS(8) {
        if (blockIdx.x == 0) meta_e5(args, lds, wave, pg8::lane_id_v());
        pg8::Gemm g{XB, (const bf16*)(ws + WS_WIN), MP, NQKV, D}; pg8::StaticOrder S; S.init(MP, NQKV, G, (int)blockIdx.x);
        pg8::EpiWin E{BIG, BIG + (size_t)MP * D, SSP};
        pg8::gemm_phase<pg8::EpiWin, pg8::StaticOrder, true, true>(lds, g, S, E, wave);
    }
    SEAM(8);
    if (IN(9)) REPS(9) { conv_phase(args, pg8::lane_id_v(), gw, NGW); }
    SEAM(9);
    if (IN(10)) {
        pg8::Gemm g{OB, (const bf16*)(ws + WS_WOUT), MP, D, D}; pg8::StaticOrder S; S.init(MP, D, G, (int)blockIdx.x);
        pg8::EpiRes<1> E{nullptr, XB, SSP, nullptr};
        pg8::gemm_phase<pg8::EpiRes<1>, pg8::StaticOrder, true, true>(lds, g, S, E, wave);
    }
    SEAM(10);
    if (IN(11)) REPS(11) {
        pg8::Gemm g{XB, (const bf16*)(ws + WS_WGU1), MP, NGU, D}; pg8::StaticOrder S; S.init(MP, NGU, G, (int)blockIdx.x);
        pg8::EpiGateUp E{BIG, SSP};
        pg8::gemm_phase<pg8::EpiGateUp, pg8::StaticOrder, true, true>(lds, g, S, E, wave);
    }
    SEAM(11);
    if (IN(12)) {
        pg8::Gemm g{BIG, (const bf16*)(ws + WS_WD1), MP, D, DFF}; pg8::StaticOrder S; S.init(MP, D, G, (int)blockIdx.x);
        pg8::EpiRes<2> E{nullptr, XB, nullptr, args.out};
        pg8::gemm_phase<pg8::EpiRes<2>, pg8::StaticOrder, true, true>(lds, g, S, E, wave);
    }
#undef IN
#undef SEAM
}

extern "C" void kernel_launch(void* const* d_in, const int* in_sizes, int n_in, void* d_out, int out_size, void* d_ws, size_t ws_size, hipStream_t stream) {
    static int grid = 0;
    if (grid == 0) {
        if (n_in != 18 || ws_size < WS_END) { fprintf(stderr, "kernel_launch: need 18 inputs and %zu bytes of workspace (got %d, %zu)\n", (size_t)WS_END, n_in, ws_size); grid = -1; return; }
        int dev = 0, cus = 0, per_cu = 0;
        hipGetDevice(&dev); hipDeviceGetAttribute(&cus, hipDeviceAttributeMultiprocessorCount, dev);
        if (hipFuncSetAttribute((const void*)mega_fwd, hipFuncAttributeMaxDynamicSharedMemorySize, LDS_BYTES) != hipSuccess) { fprintf(stderr, "kernel_launch: hipFuncSetAttribute failed\n"); grid = -1; return; }
        if (hipOccupancyMaxActiveBlocksPerMultiprocessor(&per_cu, (const void*)mega_fwd, NWAVES * 64, LDS_BYTES) != hipSuccess || per_cu < 1) { fprintf(stderr, "kernel_launch: occupancy query says %d\n", per_cu); per_cu = 1; }
        (void)hipGetLastError();
        grid = cus * per_cu;
    }
    if (grid < 0) return;
    Args a{};
    for (int i = 0; i < 18; ++i) a.in[i] = (const float*)d_in[i];
    a.out = (float*)d_out; a.ws = (unsigned char*)d_ws;
#if MK_PER_PHASE
    for (int p = 0; p < NPHASE; ++p) { a.ph_lo = p; a.ph_hi = p + 1; hipLaunchKernelGGL(mega_fwd, dim3(grid), dim3(NWAVES * 64), LDS_BYTES, stream, a); }
#else
    a.ph_lo = 0; a.ph_hi = NPHASE;
    if (hipMemsetAsync((char*)d_ws + WS_CTL, 0, CTL_BYTES, stream) != hipSuccess) { fprintf(stderr, "kernel_launch: memset failed\n"); return; }
    void* kargs[] = {&a};
    hipError_t e = hipLaunchCooperativeKernel((const void*)mega_fwd, dim3(grid), dim3(NWAVES * 64), kargs, LDS_BYTES, stream);
    if (e != hipSuccess) fprintf(stderr, "kernel_launch: cooperative launch failed: %s (grid %d)\n", hipGetErrorString(e), grid);
#endif
}
```

```cpp
#include <hip/hip_runtime.h>
#include <hip/hip_cooperative_groups.h>
#include <cstdio>
#include <cstdint>
namespace cg = cooperative_groups;
namespace pg8 {
#define PG8_LAS __attribute__((address_space(3)))
typedef unsigned short bf16_t;
typedef short bf16x8 __attribute__((ext_vector_type(8)));
typedef float f32x4 __attribute__((ext_vector_type(4)));
typedef unsigned u32x4 __attribute__((ext_vector_type(4)));
constexpr int BM = 256, BK = 64, HALF = 128, HTB = HALF * BK * 2  , STAGE_BYTES = 8 * HTB, NXCD = 8, WGM = 8;

__host__ __device__ __forceinline__ int lds_byte(int r, int c) { const int st = (r >> 4) * 2 + (c >> 5), rr = r & 15, cc = c & 31, ob = rr * 64 + cc * 2; return st * 1024 + (ob ^ (((ob >> 9) & 1) << 5)); }
__host__ __device__ __forceinline__ void stage_rc(int b, int& R, int& C) { const int st = b / 1024, sb = b % 1024, swz = sb ^ (((sb >> 9) & 1) << 5); R = (st >> 1) * 16 + swz / 64; C = (st & 1) * 32 + (swz % 64) / 2; }
__host__ __device__ __forceinline__ int perm32(int rho) { const int n = rho >> 4, i = rho & 15; return 8 * (i >> 2) + 4 * n + (i & 3); }

struct Unit { int pm, pn; };
struct Gemm { const bf16_t* A; const bf16_t* Bt; int M, N, K; };

struct StaticOrder {
    int nM, nN, nwg, G, c, rev;
    __host__ __device__ void init(int M, int N, int G_, int c_, int rev_ = 0) { nM = M / BM; nN = N / BM; nwg = nM * nN; G = G_; c = c_; rev = rev_; }
    __host__ __device__ bool next(int i, Unit& u) const {
        const long L = (long)i * G + c; if (L >= nwg) return false;
        int wgid = (int)L; { const int q = nwg / NXCD, r = nwg % NXCD, xcd = wgid % NXCD, off = wgid / NXCD; wgid = (xcd < r ? xcd * (q + 1) : r * (q + 1) + (xcd - r) * q) + off; }
        const int nig = WGM * nN, gid = wgid / nig, fm = gid * WGM, gsz = (nM - fm) < WGM ? (nM - fm) : WGM;
        u.pm = fm + ((wgid % nig) % gsz); u.pn = (wgid % nig) / gsz; if (rev) u.pm = nM - 1 - u.pm; return true;
    }
    __device__ __forceinline__ void a_ready(const Unit&) const {}
    __device__ __forceinline__ void done(const Unit&) const {}
};
__device__ __forceinline__ unsigned cvt_pk_bf16(float lo, float hi) { unsigned r; asm volatile("v_cvt_pk_bf16_f32 %0, %1, %2" : "=v"(r) : "v"(lo), "v"(hi)); return r; }
typedef unsigned u32x2 __attribute__((ext_vector_type(2)));
__device__ __forceinline__ int lane_id_v() { int l; asm volatile("v_mbcnt_lo_u32_b32 %0, -1, 0\n\tv_mbcnt_hi_u32_b32 %0, -1, %0" : "=v"(l)); return l; }
constexpr int LP_ = 2048, NMETA_ = 16;
constexpr float QSCALE_ = 0.125f * 1.4426950408889634f;
__device__ __forceinline__ float row_rstd(const float* ssp, int row) {
    const f32x4* p = (const f32x4*)(ssp + (size_t)row * 16);
    const f32x4 a = p[0], b = p[1], c = p[2], d = p[3];
    const float s = (((a[0] + a[1]) + (a[2] + a[3])) + ((b[0] + b[1]) + (b[2] + b[3]))) + (((c[0] + c[1]) + (c[2] + c[3])) + ((d[0] + d[1]) + (d[2] + d[3])));
    return rsqrtf(s * (1.0f / 1024.0f) + 1e-6f);
}
__device__ __forceinline__ float row_rstd_lds(const PG8_LAS unsigned char* sspl, int rl) {
    const PG8_LAS f32x4* p = (const PG8_LAS f32x4*)(sspl + rl * 64);
    const f32x4 a = p[0], b = p[1], c = p[2], d = p[3];
    const float s = (((a[0] + a[1]) + (a[2] + a[3])) + ((b[0] + b[1]) + (b[2] + b[3]))) + (((c[0] + c[1]) + (c[2] + c[3])) + ((d[0] + d[1]) + (d[2] + d[3])));
    return rsqrtf(s * (1.0f / 1024.0f) + 1e-6f);
}
constexpr int SSPL_OFF = 131072;
constexpr int QRS_OFF = SSPL_OFF, QROPEB_OFF = SSPL_OFF + 2048, QROPEO_OFF = SSPL_OFF + 2048 + 8192;
__device__ __forceinline__ u32x4 pack8(const f32x4 v0, const f32x4 v1) { u32x4 w; w.x = cvt_pk_bf16(v0[0], v0[1]); w.y = cvt_pk_bf16(v0[2], v0[3]); w.z = cvt_pk_bf16(v1[0], v1[1]); w.w = cvt_pk_bf16(v1[2], v1[3]); return w; }

struct EpiQKV {
    static constexpr bool PERM = true, AFTER_DRAIN = false, USES_SSP = false; static constexpr int NST = 16;
    bf16_t* QKV; const float* rs0; const float* rope; const float* qg; const float* kg; const PG8_LAS unsigned char* sspl;
    __device__ __forceinline__ void prefetch_next(PG8_LAS unsigned char* lds, int pm, int wid, int lane, int par) const {
        if (wid < 4) { const int p0 = ((pm * BM) % LP_) + NMETA_;
            __builtin_amdgcn_global_load_lds((const unsigned*)((const char*)rope + (size_t)(p0 + 64 * wid) * 256 + (unsigned)((lane >> 4) * 4096 + (lane & 15) * 16)), (PG8_LAS unsigned*)(lds + QROPEB_OFF + par * 4096 + wid * 1024), 16, 0, 0); }
        else if (wid == 4) __builtin_amdgcn_global_load_lds((const unsigned*)((const char*)rs0 + (size_t)pm * (BM * 4) + (unsigned)(lane * 16)), (PG8_LAS unsigned*)(lds + QRS_OFF + par * 1024), 16, 0, 0);
    }
    __device__ __forceinline__ void prefetch_phase(PG8_LAS unsigned char* lds, int pm, int wid, int lane) const {
        if (wid >= 4) __builtin_amdgcn_global_load_lds((const unsigned*)((const char*)rope + (size_t)((wid - 4) * 1024) + (unsigned)(lane * 16)), (PG8_LAS unsigned*)(lds + QROPEO_OFF + (wid - 4) * 1024), 16, 0, 0);
        prefetch_next(lds, pm, wid, lane, 0);
    }
    __device__ __forceinline__ void operator()(const f32x4 (&acc)[2][2][4][2], const Unit& u, int wr, int wc, int fr, int fq, int par) const {
        const int row0 = u.pm * BM + wr * 64 + fr, pn = u.pn;
        const int colbase = pn * 256 + wc * 64 + 8 * fq;
        if (pn < 8) {
            const float* gp = (pn < 4) ? qg : kg; const float osc = (pn < 4) ? QSCALE_ : 1.0f;
            f32x4 g[2][2];
#pragma unroll
            for (int bj = 0; bj < 2; ++bj)
#pragma unroll
                for (int n = 0; n < 2; ++n) g[bj][n] = *(const f32x4*)(gp + 32 * bj + 8 * fq + 4 * n);
            const PG8_LAS f32x4* rop = (const PG8_LAS f32x4*)(sspl + (QROPEO_OFF - SSPL_OFF) + fr * 256 + fq * 64);
#pragma unroll
            for (int ai = 0; ai < 2; ++ai)
#pragma unroll
                for (int m = 0; m < 4; ++m) {
                    const int row = row0 + ai * HALF + m * 16; const float rs = rsqrtf(*(const PG8_LAS float*)(sspl + (QRS_OFF - SSPL_OFF) + par * 1024 + (row - u.pm * BM) * 4) * (1.0f / 1024.0f) + 1e-6f);
                    f32x4 v[2][2]; float ss = 0.f;
#pragma unroll
                    for (int bj = 0; bj < 2; ++bj)
#pragma unroll
                        for (int n = 0; n < 2; ++n) { v[bj][n] = acc[ai][bj][m][n] * rs; const f32x4 x = v[bj][n]; ss += (x[0] * x[0] + x[1] * x[1]) + (x[2] * x[2] + x[3] * x[3]); }
                    ss += __shfl_xor(ss, 16); ss += __shfl_xor(ss, 32);
                    const float rn = rsqrtf(ss * (1.0f / 64.0f) + 1e-6f);
#pragma unroll
                    for (int bj = 0; bj < 2; ++bj)
#pragma unroll
                        for (int n = 0; n < 2; ++n) v[bj][n] = v[bj][n] * rn * g[bj][n];
                    const PG8_LAS f32x4* bp = (const PG8_LAS f32x4*)(sspl + (QROPEB_OFF - SSPL_OFF) + par * 4096 + ((row - u.pm * BM) >> 4) * 256 + fq * 64);
                    f32x4 rp[4];
#pragma unroll
                    for (int qq = 0; qq < 4; ++qq) { const f32x4 bb = bp[qq], oo = rop[qq];
                        rp[qq][0] = bb[0] * oo[0] - bb[1] * oo[1]; rp[qq][1] = bb[1] * oo[0] + bb[0] * oo[1];
                        rp[qq][2] = bb[2] * oo[2] - bb[3] * oo[3]; rp[qq][3] = bb[3] * oo[2] + bb[2] * oo[3]; }
                    f32x4 o1[2], o2[2];
#pragma unroll
                    for (int n = 0; n < 2; ++n) { const f32x4 ca = rp[2 * n], cb = rp[2 * n + 1];
                        const f32x4 x1 = v[0][n], x2 = v[1][n];
                        o1[n][0] = (x1[0] * ca[0] - x2[0] * ca[1]) * osc; o2[n][0] = (x2[0] * ca[0] + x1[0] * ca[1]) * osc;
                        o1[n][1] = (x1[1] * ca[2] - x2[1] * ca[3]) * osc; o2[n][1] = (x2[1] * ca[2] + x1[1] * ca[3]) * osc;
                        o1[n][2] = (x1[2] * cb[0] - x2[2] * cb[1]) * osc; o2[n][2] = (x2[2] * cb[0] + x1[2] * cb[1]) * osc;
                        o1[n][3] = (x1[3] * cb[2] - x2[3] * cb[3]) * osc; o2[n][3] = (x2[3] * cb[2] + x1[3] * cb[3]) * osc; }
                    bf16_t* rowp = QKV + (size_t)row * 3072 + colbase;
                    *(u32x4*)(rowp) = pack8(o1[0], o1[1]); *(u32x4*)(rowp + 32) = pack8(o2[0], o2[1]);
                }
        } else {
#pragma unroll
            for (int ai = 0; ai < 2; ++ai)
#pragma unroll
                for (int m = 0; m < 4; ++m) {
                    const int row = row0 + ai * HALF + m * 16; const float rs = rsqrtf(*(const PG8_LAS float*)(sspl + (QRS_OFF - SSPL_OFF) + par * 1024 + (row - u.pm * BM) * 4) * (1.0f / 1024.0f) + 1e-6f);
                    bf16_t* rowp = QKV + (size_t)row * 3072 + colbase;
#pragma unroll
                    for (int bj = 0; bj < 2; ++bj) *(u32x4*)(rowp + 32 * bj) = pack8(acc[ai][bj][m][0] * rs, acc[ai][bj][m][1] * rs);
                }
        }
    }
};
struct EpiGateUp {
    static constexpr bool PERM = true, AFTER_DRAIN = false, USES_SSP = true; static constexpr int NST = 8;
    bf16_t* HID; const float* ssp; const PG8_LAS unsigned char* sspl;
    __device__ __forceinline__ void prefetch_phase(PG8_LAS unsigned char*, int, int, int) const {}
    __device__ __forceinline__ void prefetch_next(PG8_LAS unsigned char*, int, int, int, int) const {}
    __device__ __forceinline__ void operator()(const f32x4 (&acc)[2][2][4][2], const Unit& u, int wr, int wc, int fr, int fq, int par) const {
        const int row0 = u.pm * BM + wr * 64 + fr; const int col = u.pn * 128 + wc * 32 + 8 * fq;
#pragma unroll
        for (int ai = 0; ai < 2; ++ai)
#pragma unroll
            for (int m = 0; m < 4; ++m) {
                const int row = row0 + ai * HALF + m * 16; const float rs = row_rstd_lds(sspl, row - u.pm * BM);
                f32x4 hv[2];
                const float kx = -1.4426950408889634f * rs, rs2 = rs * rs;
#pragma unroll
                for (int n = 0; n < 2; ++n) { const f32x4 a0 = acc[ai][0][m][n], a1 = acc[ai][1][m][n];
#pragma unroll
                    for (int e = 0; e < 4; ++e) { const float r = __builtin_amdgcn_rcpf(1.0f + __builtin_amdgcn_exp2f(a0[e] * kx)); hv[n][e] = (a0[e] * a1[e]) * (rs2 * r); } }
                *(u32x4*)(HID + (size_t)row * 2816 + col) = pack8(hv[0], hv[1]);
            }
    }
};
struct EpiWin {
    static constexpr bool PERM = true, AFTER_DRAIN = false, USES_SSP = true; static constexpr int NST = 8;
    bf16_t* Z; bf16_t* GB; const float* ssp; const PG8_LAS unsigned char* sspl;
    __device__ __forceinline__ void prefetch_phase(PG8_LAS unsigned char*, int, int, int) const {}
    __device__ __forceinline__ void prefetch_next(PG8_LAS unsigned char*, int, int, int, int) const {}
    __device__ __forceinline__ void operator()(const f32x4 (&acc)[2][2][4][2], const Unit& u, int wr, int wc, int fr, int fq, int par) const {
        const int row0 = u.pm * BM + wr * 64 + fr, pn = u.pn;
#pragma unroll
        for (int ai = 0; ai < 2; ++ai)
#pragma unroll
            for (int m = 0; m < 4; ++m) {
                const int row = row0 + ai * HALF + m * 16; const float rs = row_rstd_lds(sspl, row - u.pm * BM);
                if (pn < 8) {
                    const float rs2 = rs * rs;
                    *(u32x4*)(Z + (size_t)row * 1024 + pn * 128 + wc * 32 + 8 * fq) = pack8(acc[ai][0][m][0] * acc[ai][1][m][0] * rs2, acc[ai][0][m][1] * acc[ai][1][m][1] * rs2);
                } else {
                    bf16_t* rowp = GB + (size_t)row * 1024 + (pn - 8) * 256 + wc * 32 + 8 * fq;
#pragma unroll
                    for (int bj = 0; bj < 2; ++bj) *(u32x4*)(rowp + 128 * bj) = pack8(acc[ai][bj][m][0] * rs, acc[ai][bj][m][1] * rs);
                }
            }
    }
};
__device__ __forceinline__ f32x4 bf_lo4(const u32x4 w) { f32x4 r; r[0] = __uint_as_float(w.x << 16); r[1] = __uint_as_float(w.x & 0xffff0000u); r[2] = __uint_as_float(w.y << 16); r[3] = __uint_as_float(w.y & 0xffff0000u); return r; }
__device__ __forceinline__ f32x4 bf_hi4(const u32x4 w) { f32x4 r; r[0] = __uint_as_float(w.z << 16); r[1] = __uint_as_float(w.z & 0xffff0000u); r[2] = __uint_as_float(w.w << 16); r[3] = __uint_as_float(w.w & 0xffff0000u); return r; }
template <int MODE> struct EpiRes {
    static constexpr bool PERM = true, AFTER_DRAIN = false, USES_SSP = false; static constexpr int NST = (MODE == 2) ? 32 : 8;
    const float* x; bf16_t* XB; float* ssp; float* out;
    __device__ __forceinline__ void prefetch_phase(PG8_LAS unsigned char*, int, int, int) const {}
    __device__ __forceinline__ void prefetch_next(PG8_LAS unsigned char*, int, int, int, int) const {}
    __device__ __forceinline__ void operator()(const f32x4 (&acc)[2][2][4][2], const Unit& u, int wr, int wc, int fr, int fq, int par) const {
        const int row0 = u.pm * BM + wr * 64 + fr; const int c0 = u.pn * 256 + wc * 32 + 8 * fq;
#pragma unroll
        for (int ai = 0; ai < 2; ++ai)
#pragma unroll
            for (int m = 0; m < 4; ++m) {
                const int row = row0 + ai * HALF + m * 16; float ss = 0.f;
                f32x4 nv[2][2];
#pragma unroll
                for (int bj = 0; bj < 2; ++bj) {
                    if (MODE == 0) { const float* hp = x + (size_t)row * 1024 + c0 + 128 * bj; nv[bj][0] = *(const f32x4*)hp + acc[ai][bj][m][0]; nv[bj][1] = *(const f32x4*)(hp + 4) + acc[ai][bj][m][1]; }
                    else { const u32x4 hw = *(const u32x4*)(XB + (size_t)row * 1024 + c0 + 128 * bj); nv[bj][0] = bf_lo4(hw) + acc[ai][bj][m][0]; nv[bj][1] = bf_hi4(hw) + acc[ai][bj][m][1]; }
                }
                if (MODE != 2) {
#pragma unroll
                    for (int bj = 0; bj < 2; ++bj) {
                        *(u32x4*)(XB + (size_t)row * 1024 + c0 + 128 * bj) = pack8(nv[bj][0], nv[bj][1]);
#pragma unroll
                        for (int n = 0; n < 2; ++n) { const f32x4 v = nv[bj][n]; ss += (v[0] * v[0] + v[1] * v[1]) + (v[2] * v[2] + v[3] * v[3]); }
                    }
                    ss += __shfl_xor(ss, 16); ss += __shfl_xor(ss, 32);
                    if (fq == 0) ssp[(size_t)row * 16 + 4 * u.pn + wc] = ss;
                } else {
                    float* op = out + (size_t)row * 1024 + c0;
#pragma unroll
                    for (int bj = 0; bj < 2; ++bj) { *(f32x4*)(op + 128 * bj) = nv[bj][0]; *(f32x4*)(op + 128 * bj + 4) = nv[bj][1]; }
                }
            }
    }
};
template <class Epi, class Sched, bool ALIGN_EPI = false, bool SP2 = false>
__device__ __forceinline__ void gemm_phase(PG8_LAS unsigned char* lds, const Gemm g, const Sched& S, const Epi& E, const int wid) {
    const int lane = lane_id_v(), tid = wid * 64 + lane, wr = wid >> 2, wc = wid & 3, fr = lane & 15, fq = lane >> 4;
    const int K = g.K, nt = K / BK;
    unsigned voffA[2], voffB[2];
#pragma unroll
    for (int i = 0; i < 2; ++i) { int R, C; stage_rc(tid * 16 + i * 8192, R, C); const int Rb = Epi::PERM ? ((R & ~31) + perm32(R & 31)) : R;
        voffA[i] = (unsigned)(R * K + C) * 2u; voffB[i] = (unsigned)(Rb * K + C) * 2u; }
    const size_t kstep = (size_t)(BK * 2);
    const size_t hstep = (size_t)HALF * K * 2;
    const size_t tstep = 2 * hstep;
    const unsigned ldsw = (unsigned)wid * 1024u;
    const int aoff = lds_byte(wr * 64 + fr, fq * 8), boff = lds_byte(wc * 32 + fr, fq * 8);
#define PG8_SA(b, h) (((b) * 2 + (h)) * HTB)
#define PG8_SB(b, h) ((4 + (b) * 2 + (h)) * HTB)
#define PG8_STAGE(bufoff, gbase, voff) do { _Pragma("unroll") for (int _i = 0; _i < 2; ++_i) \
        __builtin_amdgcn_global_load_lds((const unsigned*)((const char*)(gbase) + (voff)[_i]), (PG8_LAS unsigned*)(lds + (bufoff) + ldsw + _i * 8192), 16, 0, 0); } while (0)
#define PG8_SSP_DMA(pm_) do { if constexpr (Epi::USES_SSP) { _Pragma("unroll") for (int _i = 0; _i < 2; ++_i) \
        __builtin_amdgcn_global_load_lds((const unsigned*)((const char*)E.ssp + (size_t)(pm_) * (BM * 64) + (size_t)((2 * wid + _i) * 1024) + (unsigned)(lane * 16)), (PG8_LAS unsigned*)(lds + SSPL_OFF + (2 * wid + _i) * 1024), 16, 0, 0); } } while (0)
#define PG8_LDA(dst, b, h) do { _Pragma("unroll") for (int m = 0; m < 4; ++m) _Pragma("unroll") for (int k = 0; k < 2; ++k) dst[m][k] = *(const PG8_LAS bf16x8*)(lds + PG8_SA(b, h) + aoff + m * 2048 + k * 1024); } while (0)
#define PG8_LDB(dst, b, h) do { _Pragma("unroll") for (int n = 0; n < 2; ++n) _Pragma("unroll") for (int k = 0; k < 2; ++k) dst[n][k] = *(const PG8_LAS bf16x8*)(lds + PG8_SB(b, h) + boff + n * 2048 + k * 1024); } while (0)
#define PG8_MMA(ai, bj, At, Bt) do { __builtin_amdgcn_s_setprio(1); _Pragma("unroll") for (int m = 0; m < 4; ++m) _Pragma("unroll") for (int n = 0; n < 2; ++n) _Pragma("unroll") for (int k = 0; k < 2; ++k) \
        acc[ai][bj][m][n] = __builtin_amdgcn_mfma_f32_16x16x32_bf16(Bt[n][k], At[m][k], acc[ai][bj][m][n], 0, 0, 0); __builtin_amdgcn_s_setprio(0); } while (0)
#define PG8_WAIT_V(n) asm volatile("s_waitcnt vmcnt(" #n ")" ::: "memory")
#define PG8_WAIT_L(n) asm volatile("s_waitcnt lgkmcnt(" #n ")" ::: "memory")
#define PG8_BAR __builtin_amdgcn_s_barrier()
#define PG8_SCHED __builtin_amdgcn_sched_barrier(0)
    Unit cur, nxt; int ui = 0;
    if (!S.next(0, cur)) return;
    f32x4 acc[2][2][4][2];
#pragma unroll
    for (int a = 0; a < 2; ++a)
#pragma unroll
        for (int b = 0; b < 2; ++b)
#pragma unroll
            for (int m = 0; m < 4; ++m)
#pragma unroll
                for (int n = 0; n < 2; ++n) acc[a][b][m][n] = (f32x4){0.f, 0.f, 0.f, 0.f};
    bf16x8 At[4][2], B0[2][2], B1[2][2];
    const char* cA = (const char*)g.A + (size_t)cur.pm * tstep; const char* cB = (const char*)g.Bt + (size_t)cur.pn * tstep;
    S.a_ready(cur);
    PG8_SSP_DMA(cur.pm);
    E.prefetch_phase(lds, cur.pm, wid, lane);
    if constexpr (SP2) {
        PG8_STAGE(PG8_SB(0, 0), cB, voffB); PG8_STAGE(PG8_SB(0, 1), cB + hstep, voffB); PG8_STAGE(PG8_SA(0, 0), cA, voffA); PG8_STAGE(PG8_SA(0, 1), cA + hstep, voffA);
        if (wr == 1) PG8_BAR;
        PG8_WAIT_V(2); PG8_BAR;
        PG8_STAGE(PG8_SB(1, 0), cB + kstep, voffB); PG8_STAGE(PG8_SA(1, 0), cA + kstep, voffA); PG8_STAGE(PG8_SB(1, 1), cB + hstep + kstep, voffB);
        PG8_WAIT_V(6); PG8_BAR;
    } else {
        PG8_STAGE(PG8_SB(0, 0), cB, voffB); PG8_STAGE(PG8_SA(0, 0), cA, voffA); PG8_STAGE(PG8_SB(0, 1), cB + hstep, voffB); PG8_STAGE(PG8_SA(0, 1), cA + hstep, voffA);
        if (wr == 1) PG8_BAR;
        PG8_WAIT_V(4); PG8_BAR;
        PG8_STAGE(PG8_SB(1, 0), cB + kstep, voffB); PG8_STAGE(PG8_SA(1, 0), cA + kstep, voffA); PG8_STAGE(PG8_SB(1, 1), cB + hstep + kstep, voffB);
        PG8_WAIT_V(6); PG8_BAR;
    }
    static_assert(SP2, "this build keeps only the two-super-phase loop");
#define PG8_ITER(WV) do { \
            PG8_LDB(B0, 0, 0); PG8_LDB(B1, 0, 1); PG8_SCHED; PG8_LDA(At, 0, 0); PG8_STAGE(PG8_SA(1, 1), a1 + hstep, voffA); \
            WV; PG8_WAIT_L(0); PG8_BAR; PG8_MMA(0, 0, At, B0); PG8_MMA(0, 1, At, B1); PG8_BAR; PG8_SCHED; \
            PG8_LDA(At, 0, 1); PG8_STAGE(PG8_SB(0, 0), b2, voffB); PG8_STAGE(PG8_SB(0, 1), b2 + hstep, voffB); PG8_STAGE(PG8_SA(0, 0), a2, voffA); \
            WV; PG8_WAIT_L(0); PG8_BAR; PG8_MMA(1, 0, At, B0); PG8_MMA(1, 1, At, B1); PG8_BAR; PG8_SCHED; \
            PG8_LDB(B0, 1, 0); PG8_LDB(B1, 1, 1); PG8_SCHED; PG8_LDA(At, 1, 0); PG8_STAGE(PG8_SA(0, 1), a2 + hstep, voffA); \
            PG8_WAIT_V(8); PG8_WAIT_L(0); PG8_BAR; PG8_MMA(0, 0, At, B0); PG8_MMA(0, 1, At, B1); PG8_BAR; PG8_SCHED; \
            PG8_LDA(At, 1, 1); PG8_STAGE(PG8_SB(1, 0), b3, voffB); PG8_STAGE(PG8_SB(1, 1), b3 + hstep, voffB); PG8_STAGE(PG8_SA(1, 0), a3, voffA); \
            PG8_WAIT_V(8); PG8_WAIT_L(0); PG8_BAR; PG8_MMA(1, 0, At, B0); PG8_MMA(1, 1, At, B1); PG8_BAR; PG8_SCHED; } while (0)
#define PG8_WAIT_R asm volatile("s_waitcnt vmcnt(%0)" :: "n"(8 + Epi::NST) : "memory")
#define PG8_ITER_R() do { \
            PG8_LDB(B0, 0, 0); PG8_LDB(B1, 0, 1); PG8_SCHED; PG8_LDA(At, 0, 0); \
            PG8_WAIT_R; PG8_WAIT_L(0); PG8_BAR; PG8_MMA(0, 0, At, B0); PG8_MMA(0, 1, At, B1); PG8_BAR; PG8_SCHED; \
            PG8_SSP_DMA(cur.pm); PG8_SCHED;     \
            PG8_LDA(At, 0, 1); PG8_STAGE(PG8_SB(0, 0), b2, voffB); PG8_STAGE(PG8_SB(0, 1), b2 + hstep, voffB); PG8_STAGE(PG8_SA(0, 0), a2, voffA); \
            PG8_WAIT_R; PG8_WAIT_L(0); PG8_BAR; PG8_MMA(1, 0, At, B0); PG8_MMA(1, 1, At, B1); PG8_BAR; PG8_SCHED; \
            PG8_LDB(B0, 1, 0); PG8_LDB(B1, 1, 1); PG8_SCHED; PG8_LDA(At, 1, 0); PG8_STAGE(PG8_SA(0, 1), a2 + hstep, voffA); \
            PG8_WAIT_R; PG8_WAIT_L(0); PG8_BAR; PG8_MMA(0, 0, At, B0); PG8_MMA(0, 1, At, B1); PG8_BAR; PG8_SCHED; \
            PG8_LDA(At, 1, 1); PG8_STAGE(PG8_SB(1, 0), b3, voffB); PG8_STAGE(PG8_SB(1, 1), b3 + hstep, voffB); PG8_STAGE(PG8_SA(1, 0), a3, voffA); \
            PG8_WAIT_V(8); PG8_WAIT_L(0); PG8_BAR; PG8_MMA(1, 0, At, B0); PG8_MMA(1, 1, At, B1); PG8_BAR; PG8_SCHED; } while (0)
    int t0 = 0;
    for (;;) {
        const bool has_next = S.next(ui + 1, nxt);
        const char* nA = has_next ? (const char*)g.A + (size_t)nxt.pm * tstep : cA; const char* nB = has_next ? (const char*)g.Bt + (size_t)nxt.pn * tstep : cB;
        for (int t = t0; t < nt; t += 2) {
            const bool last = (t == nt - 2);
            const char* a1 = cA + (size_t)(t + 1) * kstep;
            const char* a2 = last ? nA : cA + (size_t)(t + 2) * kstep; const char* b2 = last ? nB : cB + (size_t)(t + 2) * kstep;
            const char* a3 = a2 + kstep; const char* b3 = b2 + kstep;
            if (last && has_next) S.a_ready(nxt);
            PG8_ITER(PG8_WAIT_V(8));
        }
        if constexpr (ALIGN_EPI) { if (wr == 0) PG8_BAR; }
        if (has_next) PG8_STAGE(PG8_SA(1, 1), nA + kstep + hstep, voffA);
        PG8_SCHED;
        if constexpr (!Epi::AFTER_DRAIN) { const int le = lane_id_v(); E(acc, cur, wr, wc, le & 15, le >> 4, ui & 1); if (has_next) E.prefetch_next(lds, nxt.pm, wid, le, (ui + 1) & 1); S.done(cur); }
        PG8_SCHED;
        if (!has_next) break;
#pragma unroll
        for (int a = 0; a < 2; ++a)
#pragma unroll
            for (int b = 0; b < 2; ++b)
#pragma unroll
                for (int m = 0; m < 4; ++m)
#pragma unroll
                    for (int n = 0; n < 2; ++n) acc[a][b][m][n] = (f32x4){0.f, 0.f, 0.f, 0.f};
        cur = nxt; cA = nA; cB = nB; ++ui; t0 = 2;
        if constexpr (ALIGN_EPI) { if (wr == 1) PG8_BAR; }
        PG8_SCHED;
        {
            const char* a1 = cA + kstep; const char* a2 = cA + 2 * kstep; const char* b2 = cB + 2 * kstep; const char* a3 = a2 + kstep; const char* b3 = b2 + kstep;
            (void)a1; PG8_ITER_R();
        }
    }
#undef PG8_ITER
#undef PG8_ITER_R
#undef PG8_WAIT_R
    PG8_WAIT_V(0);
    if constexpr (!ALIGN_EPI) { if (wr == 0) PG8_BAR; }
    PG8_BAR;
    if constexpr (Epi::AFTER_DRAIN) { E.fused(acc, cur, wr, wc, fr, fq, lds, wid, lane); S.done(cur); }
#undef PG8_SA
#undef PG8_SB
#undef PG8_STAGE
#undef PG8_SSP_DMA
#undef PG8_LDA
#undef PG8_LDB
#undef PG8_MMA
#undef PG8_WAIT_V
#undef PG8_WAIT_L
#undef PG8_BAR
#undef PG8_SCHED
}
}
namespace att {
#define LAS __attribute__((address_space(3)))
typedef unsigned short bf16_t;
typedef short bf16x8 __attribute__((ext_vector_type(8)));
typedef short s16x4 __attribute__((ext_vector_type(4)));
typedef float f32x16 __attribute__((ext_vector_type(16)));
typedef float f32x4 __attribute__((ext_vector_type(4)));
typedef unsigned u32x4 __attribute__((ext_vector_type(4)));
constexpr int LP = 2048, PADF = 48, PITCH = 3072;
constexpr int KV_BUF = 32768, V_OFF = 16384, OST_OFF = 65536, OST_PITCH = 272, OST_WAVE = 32 * OST_PITCH, WSF_OFF = OST_OFF + 8 * OST_WAVE, ATT_LDS = WSF_OFF + 8 * 256;
__device__ __forceinline__ int crow(int r, int hi) { return (r & 3) + 8 * (r >> 2) + 4 * hi; }
__device__ __forceinline__ unsigned cvtpk(float lo, float hi) { unsigned r; asm volatile("v_cvt_pk_bf16_f32 %0, %1, %2" : "=v"(r) : "v"(lo), "v"(hi)); return r; }
template <int K> __device__ __forceinline__ float swz_xor(float v) { return __builtin_bit_cast(float, __builtin_amdgcn_ds_swizzle(__builtin_bit_cast(int, v), (K << 10) | 0x1f)); }
__device__ __forceinline__ float xor32(float v) { const int ln = pg8::lane_id_v(); return __builtin_bit_cast(float, __builtin_amdgcn_ds_bpermute((ln ^ 32) << 2, __builtin_bit_cast(int, v))); }
__device__ __forceinline__ s16x4 vtr(const LAS unsigned char* p) { return __builtin_bit_cast(s16x4, __builtin_amdgcn_ds_read_tr16_b64_v4i16((LAS s16x4*)p)); }

__device__ __forceinline__ void stage_tile(LAS unsigned char* lds, int bufoff, const bf16_t* QKV, const bf16_t* MQKV, long rowbase, int h, int t, int wid, int lane) {
    const char* src = (t == 0) ? (const char*)MQKV : (const char*)(QKV + (size_t)(rowbase + 64 * (t - 1)) * PITCH);
    const unsigned voffK = (unsigned)lane * (PITCH * 2), voffV = (unsigned)(lane >> 2) * (PITCH * 2) + (unsigned)(lane & 3) * 16;
#pragma unroll
    for (int i = 0; i < 2; ++i) {
        const int ci = 2 * wid + i;
        const char* ks = src + (size_t)((1024 + h * 128 + ci * 8) * 2);
        __builtin_amdgcn_global_load_lds((const unsigned*)(ks + voffK), (LAS unsigned*)(lds + bufoff + ci * 1024), 16, 0, 0);
    }
#pragma unroll
    for (int i = 0; i < 2; ++i) {
        const int pi = 2 * wid + i, db = pi >> 2, kg = pi & 3;
        const char* vs = src + (size_t)(16 * kg) * (PITCH * 2) + (size_t)((2048 + h * 128 + db * 32) * 2);
        __builtin_amdgcn_global_load_lds((const unsigned*)(vs + voffV), (LAS unsigned*)(lds + bufoff + V_OFF + pi * 1024), 16, 0, 0);
    }
}

template <size_t OFF_QKV, size_t OFF_MQKV, size_t OFF_O> __device__ __forceinline__ void attn_unit(LAS unsigned char* lds, unsigned char* ws, int b, int h, int q0, int nqw, float lam, const float* subg, const int wid) {
    const bf16_t* QKV = (const bf16_t*)(ws + OFF_QKV); const bf16_t* MQKV = (const bf16_t*)(ws + OFF_MQKV); bf16_t* O = (bf16_t*)(ws + OFF_O);
    const int lane = pg8::lane_id_v(), r32 = lane & 31, hi = lane >> 5;
    const long rowbase = (long)b * LP;
    const int NT = (q0 + 32 * nqw) >> 6;
    const bool active = wid < nqw;
    const int qabs = q0 + 32 * wid + r32, qfirst = q0 + 32 * wid, qlast = qfirst + 31;
    LAS unsigned char* qw = lds + OST_OFF + wid * OST_WAVE + lane * 16;
    {
        const char* qb = (const char*)(QKV + (size_t)(rowbase + (active ? qfirst - 64 : 0)) * PITCH + h * 128);
        const bf16_t* qp = (const bf16_t*)(qb + ((unsigned)r32 * (PITCH * 2) + (unsigned)hi * 16));
#pragma unroll
        for (int j = 0; j < 8; ++j) *(LAS bf16x8*)(qw + j * 1024) = *(const bf16x8*)(qp + (j >> 2) * 64 + (j & 3) * 16);
    }
    f32x16 o[2][4];
#pragma unroll
    for (int c = 0; c < 2; ++c)
#pragma unroll
        for (int db = 0; db < 4; ++db)
#pragma unroll
            for (int r = 0; r < 16; ++r) o[c][db][r] = 0.f;
    float lsum[2] = {0.f, 0.f};
    stage_tile(lds, 0, QKV, MQKV, rowbase, h, 0, wid, lane);
    for (int t = 0; t < NT; ++t) {
        __syncthreads();
        const int buf = (t & 1) * KV_BUF;
        if (t + 1 < NT) stage_tile(lds, ((t + 1) & 1) * KV_BUF, QKV, MQKV, rowbase, h, t + 1, wid, lane);
        if (active && 64 * t <= qlast) {
            const bool needmask = (t == 0) || (64 * t + 63 > qfirst);
            const LAS unsigned char* kb = lds + buf + hi * 1024 + r32 * 16;
            const LAS unsigned char* vp = lds + buf + V_OFF + ((lane >> 4) & 1) * 32 + (lane & 3) * 8 + (4 * hi + ((lane & 15) >> 2)) * 64;
            f32x16 sA0, sA1, sB0, sB1;
#pragma unroll
            for (int r = 0; r < 16; ++r) { sA0[r] = 0.f; sA1[r] = 0.f; sB0[r] = 0.f; sB1[r] = 0.f; }
            {
                bf16x8 fk0[3], fk1[3], fq_[3];
#define QK_LOAD(s_) do { fk0[(s_) % 3] = *(const LAS bf16x8*)(kb + (8 * ((s_) >> 2) + 2 * ((s_) & 3)) * 1024); fk1[(s_) % 3] = *(const LAS bf16x8*)(kb + (8 * ((s_) >> 2) + 2 * ((s_) & 3)) * 1024 + 512); \
                                 fq_[(s_) % 3] = *(const LAS bf16x8*)(qw + (s_) * 1024); } while (0)
                QK_LOAD(0); QK_LOAD(1);
                __builtin_amdgcn_sched_barrier(0);
#pragma unroll
                for (int s_ = 0; s_ < 8; ++s_) {
                    if (s_ + 2 < 8) QK_LOAD(s_ + 2);
                    if (s_ < 4) { sA0 = __builtin_amdgcn_mfma_f32_32x32x16_bf16(fk0[s_ % 3], fq_[s_ % 3], sA0, 0, 0, 0); sA1 = __builtin_amdgcn_mfma_f32_32x32x16_bf16(fk1[s_ % 3], fq_[s_ % 3], sA1, 0, 0, 0); }
                    else        { sB0 = __builtin_amdgcn_mfma_f32_32x32x16_bf16(fk0[s_ % 3], fq_[s_ % 3], sB0, 0, 0, 0); sB1 = __builtin_amdgcn_mfma_f32_32x32x16_bf16(fk1[s_ % 3], fq_[s_ % 3], sB1, 0, 0, 0); }
                    __builtin_amdgcn_sched_barrier(0);
                }
#undef QK_LOAD
            }
#define MASK1(P, R, LIM, OP, ADD) asm volatile("s_nop 0\n\t" OP " vcc, %2, %1\n\tv_cndmask_b32_e32 %0, 0, %0, vcc" : "+v"(P[R]) : "v"(LIM), "n"(((R) & 3) + 8 * ((R) >> 2) + (ADD)) : "vcc")
#define MASK16(P0, P1, LIM, OP) do { \
    MASK1(P0, 0, LIM, OP, 0); MASK1(P0, 1, LIM, OP, 0); MASK1(P0, 2, LIM, OP, 0); MASK1(P0, 3, LIM, OP, 0); MASK1(P0, 4, LIM, OP, 0); MASK1(P0, 5, LIM, OP, 0); MASK1(P0, 6, LIM, OP, 0); MASK1(P0, 7, LIM, OP, 0); \
    MASK1(P0, 8, LIM, OP, 0); MASK1(P0, 9, LIM, OP, 0); MASK1(P0, 10, LIM, OP, 0); MASK1(P0, 11, LIM, OP, 0); MASK1(P0, 12, LIM, OP, 0); MASK1(P0, 13, LIM, OP, 0); MASK1(P0, 14, LIM, OP, 0); MASK1(P0, 15, LIM, OP, 0); \
    MASK1(P1, 0, LIM, OP, 32); MASK1(P1, 1, LIM, OP, 32); MASK1(P1, 2, LIM, OP, 32); MASK1(P1, 3, LIM, OP, 32); MASK1(P1, 4, LIM, OP, 32); MASK1(P1, 5, LIM, OP, 32); MASK1(P1, 6, LIM, OP, 32); MASK1(P1, 7, LIM, OP, 32); \
    MASK1(P1, 8, LIM, OP, 32); MASK1(P1, 9, LIM, OP, 32); MASK1(P1, 10, LIM, OP, 32); MASK1(P1, 11, LIM, OP, 32); MASK1(P1, 12, LIM, OP, 32); MASK1(P1, 13, LIM, OP, 32); MASK1(P1, 14, LIM, OP, 32); MASK1(P1, 15, LIM, OP, 32); } while (0)
#define ATT_SOFTMAX(P0, P1, C, PW) do { \
                _Pragma("unroll") for (int r = 0; r < 16; ++r) { P0[r] = __builtin_amdgcn_exp2f(P0[r]); P1[r] = __builtin_amdgcn_exp2f(P1[r]); } \
                if (needmask) {        \
                    int mhi = qabs - 64 * t - 4 * hi; asm volatile("" : "+v"(mhi)); \
                    MASK16(P0, P1, mhi, "v_cmp_le_i32_e32"); \
                    if (t == 0) { int mlo = PADF - 4 * (pg8::lane_id_v() >> 5); MASK16(P0, P1, mlo, "v_cmp_ge_i32_e32"); } \
                } \
                float s_ = 0.f; \
                _Pragma("unroll") for (int r = 0; r < 16; ++r) s_ += P0[r] + P1[r]; \
                lsum[C] += s_; \
                PW[0] = (u32x4){cvtpk(P0[0], P0[1]), cvtpk(P0[2], P0[3]), cvtpk(P0[4], P0[5]), cvtpk(P0[6], P0[7])}; \
                PW[1] = (u32x4){cvtpk(P0[8], P0[9]), cvtpk(P0[10], P0[11]), cvtpk(P0[12], P0[13]), cvtpk(P0[14], P0[15])}; \
                PW[2] = (u32x4){cvtpk(P1[0], P1[1]), cvtpk(P1[2], P1[3]), cvtpk(P1[4], P1[5]), cvtpk(P1[6], P1[7])}; \
                PW[3] = (u32x4){cvtpk(P1[8], P1[9]), cvtpk(P1[10], P1[11]), cvtpk(P1[12], P1[13]), cvtpk(P1[14], P1[15])}; } while (0)
            u32x4 pwA[4], pwB[4];
            ATT_SOFTMAX(sA0, sA1, 0, pwA);
            __builtin_amdgcn_sched_barrier(0);
            ATT_SOFTMAX(sB0, sB1, 1, pwB);
            __builtin_amdgcn_sched_barrier(0);
            {
                bf16x8 vr[4];
#define V_LOAD(i_) do { const s16x4 lo_ = vtr(vp + ((i_) & 3) * 4096 + ((i_) >> 2) * 1024), hh_ = vtr(vp + ((i_) & 3) * 4096 + ((i_) >> 2) * 1024 + 512); \
                                vr[(i_) & 3] = (bf16x8){lo_[0], lo_[1], lo_[2], lo_[3], hh_[0], hh_[1], hh_[2], hh_[3]}; } while (0)
                V_LOAD(0); V_LOAD(1); V_LOAD(2);
                __builtin_amdgcn_sched_barrier(0);
#pragma unroll
                for (int i_ = 0; i_ < 16; ++i_) {
                    if (i_ + 3 < 16) V_LOAD(i_ + 3);
                    o[0][i_ & 3] = __builtin_amdgcn_mfma_f32_32x32x16_bf16(__builtin_bit_cast(bf16x8, pwA[i_ >> 2]), vr[i_ & 3], o[0][i_ & 3], 0, 0, 0);
                    o[1][i_ & 3] = __builtin_amdgcn_mfma_f32_32x32x16_bf16(__builtin_bit_cast(bf16x8, pwB[i_ >> 2]), vr[i_ & 3], o[1][i_ & 3], 0, 0, 0);
                    __builtin_amdgcn_sched_barrier(0);
                }
#undef V_LOAD
            }
#undef ATT_SOFTMAX
#undef MASK1
#undef MASK16
        }
    }
    if (active) {
        const int lane_e = pg8::lane_id_v(), r32 = lane_e & 31, hi = lane_e >> 5;
        float l0 = lsum[0], l1 = lsum[1];
        l0 += xor32(l0); l1 += xor32(l1);
        LAS float* wsf = (LAS float*)(lds + WSF_OFF) + wid * 64;
        if (hi == 0) { wsf[r32] = l0; wsf[32 + r32] = l1; }
        asm volatile("s_waitcnt lgkmcnt(0)" ::: "memory");
#pragma unroll
        for (int r = 0; r < 16; ++r) { const float a0 = wsf[crow(r, hi)], a1 = wsf[32 + crow(r, hi)];
            const float rl0 = a0 > 0.f ? __builtin_amdgcn_rcpf(a0) : 0.f, rl1 = a1 > 0.f ? lam * __builtin_amdgcn_rcpf(a1) : 0.f; float s = 0.f;
#pragma unroll
            for (int db = 0; db < 4; ++db) { const float v = o[0][db][r] * rl0 - o[1][db][r] * rl1; o[0][db][r] = v; s += v * v; }
            s += swz_xor<1>(s); s += swz_xor<2>(s); s += swz_xor<4>(s); s += swz_xor<8>(s); s += swz_xor<16>(s);
            const float rn = rsqrtf(s * (1.0f / 128.0f) + 1e-6f) * 0.8f;
#pragma unroll
            for (int db = 0; db < 4; ++db) o[0][db][r] *= rn; }
        LAS unsigned short* stg = (LAS unsigned short*)(lds + OST_OFF + wid * OST_WAVE);
#pragma unroll
        for (int db = 0; db < 4; ++db) { const float sg = subg[db * 32 + r32];
#pragma unroll
            for (int r = 0; r < 16; ++r) { const unsigned w = cvtpk(o[0][db][r] * sg, 0.f); stg[crow(r, hi) * (OST_PITCH / 2) + db * 32 + r32] = (unsigned short)(w & 0xffffu); } }
        asm volatile("s_waitcnt lgkmcnt(0)" ::: "memory");
        int lsel = lane_e;
        bf16_t* Ow = O + (size_t)(rowbase + qfirst - 64 + (lsel >> 4)) * 1024 + h * 128 + (lsel & 15) * 8;
        const LAS unsigned char* sp = (const LAS unsigned char*)stg + (lsel >> 4) * OST_PITCH + (lsel & 15) * 16;
#pragma unroll
        for (int it = 0; it < 8; ++it) { const u32x4 v = *(const LAS u32x4*)(sp + it * 4 * OST_PITCH); *(u32x4*)Ow = v; Ow += 4 * 1024; asm volatile("" : "+v"(Ow)); }
    }
    __syncthreads();
}
}
typedef unsigned short bf16;
typedef unsigned v4u __attribute__((ext_vector_type(4)));
typedef float f32x4 __attribute__((ext_vector_type(4)));
typedef short bf16x8 __attribute__((ext_vector_type(8)));
constexpr int NWAVES = 8;
#ifndef MK_PER_PHASE
#define MK_PER_PHASE 0
#endif
constexpr int NPHASE = 13;
#ifndef PROBE_DUP
#define PROBE_DUP -1
#endif
#define REPS(k) for (int rep_ = 0; rep_ < ((PROBE_DUP) == (k) ? 2 : 1); ++rep_)
constexpr int D = 1024, NB = 32, SEQ = 2048, LTOK = 2064, NMETA = 16, LP = 2048, MP = NB * LP;
constexpr int NQKV = 3072, DFF = 2816, NGU = 5632;
constexpr size_t al256(size_t x) { return (x + 255) & ~(size_t)255; }
constexpr size_t WS_WQKV = 0;
constexpr size_t WS_WO   = WS_WQKV + (size_t)NQKV * D * 2;
constexpr size_t WS_WGU0 = WS_WO + (size_t)D * D * 2;
constexpr size_t WS_WD0  = WS_WGU0 + (size_t)NGU * D * 2;
constexpr size_t WS_WIN  = WS_WD0 + (size_t)D * DFF * 2;
constexpr size_t WS_WOUT = WS_WIN + (size_t)NQKV * D * 2;
constexpr size_t WS_WGU1 = WS_WOUT + (size_t)D * D * 2;
constexpr size_t WS_WD1  = WS_WGU1 + (size_t)NGU * D * 2;
constexpr size_t WS_ROPE = WS_WD1 + (size_t)D * DFF * 2;
constexpr size_t WS_SSP  = WS_ROPE + al256((size_t)LTOK * 32 * 2 * 4);
constexpr size_t WS_H    = WS_SSP + (size_t)MP * 16 * 4;
constexpr size_t WS_XB   = WS_H;
constexpr size_t WS_BIG  = WS_XB + (size_t)MP * D * 2;
constexpr size_t WS_O    = WS_BIG + (size_t)MP * NQKV * 2;
constexpr size_t WS_MXB  = WS_O + (size_t)MP * D * 2;
constexpr size_t WS_MRS  = WS_MXB + 16 * 1024 * 2;
constexpr size_t WS_MC1  = WS_MRS + 256;
constexpr size_t WS_MQKV = WS_MC1 + 16 * 3072 * 4;
constexpr size_t WS_MOM  = WS_MQKV + 64 * 3072 * 2;
constexpr size_t WS_MC2  = WS_MOM + 16 * 1024 * 2;
constexpr size_t WS_MC3  = WS_MC2 + 16 * 1024 * 4;
constexpr size_t WS_MH1  = WS_MC3 + 16 * 5632 * 4;
constexpr size_t WS_MHID = WS_MH1 + 16 * 1024 * 4;
constexpr size_t WS_MC4  = WS_MHID + 16 * 2816 * 2;
constexpr size_t WS_MC5  = WS_MC4 + 16 * 1024 * 4;
constexpr size_t WS_MZ   = WS_MC5 + 16 * 2048 * 4;
constexpr size_t WS_RS0  = WS_MZ + 16 * 1024 * 2;
constexpr size_t WS_CTL  = WS_RS0 + (size_t)MP * 4;
constexpr size_t CTL_BYTES = 16384;
constexpr size_t WS_END  = WS_CTL + CTL_BYTES;
constexpr int LDS_BYTES = 149504;
static_assert(att::ATT_LDS <= LDS_BYTES && pg8::STAGE_BYTES <= LDS_BYTES, "LDS map");

__device__ __forceinline__ unsigned f2bf(float f) { unsigned u = __builtin_bit_cast(unsigned, f); return (u + 0x7fffu + ((u >> 16) & 1u)) >> 16; }
__device__ __forceinline__ unsigned pk2(float lo, float hi) { return f2bf(lo) | (f2bf(hi) << 16); }
__device__ __forceinline__ float wave_sum(float v) {
#pragma unroll
    for (int o = 1; o < 64; o <<= 1) v += __shfl_xor(v, o);
    return v;
}
__device__ __forceinline__ float wave_max(float v) {
#pragma unroll
    for (int o = 1; o < 64; o <<= 1) v = fmaxf(v, __shfl_xor(v, o));
    return v;
}
__device__ __forceinline__ int col_perm(int mode, int n) {
    if (mode == 1) return (n & ~255) + 128 * ((n >> 5) & 1) + 32 * ((n >> 6) & 3) + (n & 31);
    if (mode == 2) { const int up = n >= DFF ? 1 : 0, j = n - up * DFF; return 256 * (j >> 7) + 128 * up + (j & 127); }
    if (mode == 3) { if (n < 1024) return 2048 + n; const int up = n >= 2048 ? 1 : 0, j = (n - 1024) & 1023; return 256 * (j >> 7) + 128 * up + (j & 127); }
    return n;
}
__device__ __forceinline__ void transpose_item(const float* W, int K, int N, bf16* WT, const float* gain, int mode, LAS float* scr, int item, int lane) {
    const int nblk = N / 32, kb = item / nblk, nb = item % nblk, k0 = 64 * kb, n0 = 32 * nb;
#pragma unroll 8
    for (int i = 0; i < 32; ++i) { const int kk = 2 * i + (lane >> 5); scr[kk * 33 + (lane & 31)] = W[(size_t)(k0 + kk) * N + n0 + (lane & 31)]; }
    asm volatile("s_waitcnt lgkmcnt(0)" ::: "memory");
    const int c = lane & 7;
    float gv[8];
#pragma unroll
    for (int e = 0; e < 8; ++e) gv[e] = gain ? gain[k0 + 8 * c + e] : 1.0f;
#pragma unroll
    for (int j = 0; j < 4; ++j) { const int n = (lane >> 3) + 8 * j; const LAS float* s = scr + (8 * c) * 33 + n;
        v4u o; o.x = pk2(s[0 * 33] * gv[0], s[1 * 33] * gv[1]); o.y = pk2(s[2 * 33] * gv[2], s[3 * 33] * gv[3]); o.z = pk2(s[4 * 33] * gv[4], s[5 * 33] * gv[5]); o.w = pk2(s[6 * 33] * gv[6], s[7 * 33] * gv[7]);
        *(v4u*)(WT + (size_t)col_perm(mode, n0 + n) * K + k0 + 8 * c) = o; }
    asm volatile("s_waitcnt lgkmcnt(0)" ::: "memory");
}
__device__ __forceinline__ void sincos_acc(float angf, float& c, float& s) {
    const double TWO_PI = 6.283185307179586476925286766559;
    double a = (double)angf; const double n = rint(a / TWO_PI); double r = a - n * TWO_PI;
    const double r2 = r * r; double cs = 1.0, sn = r, tc = 1.0, ts = r;
#pragma unroll 1
    for (int k = 1; k <= 14; ++k) { tc = -tc * r2 / (double)((2 * k - 1) * (2 * k)); ts = -ts * r2 / (double)((2 * k) * (2 * k + 1)); cs += tc; sn += ts; }
    c = (float)cs; s = (float)sn;
}

#define XB_TMO      128
#define XB_XCNT(j)  (256  + 64 * (j))
#define XB_XSUB(j)  (1280 + 64 * (j))
#define XB_XGEN(j)  (2304 + 64 * (j))
#define XB_TOP      3328
#define XB_TOPGEN   3392
#define XCD_BAR_WORDS 3456
#define XB_SPIN_CAP (1u << 18)

__device__ __forceinline__ unsigned xb_ld(unsigned* p)              { return __hip_atomic_load(p, __ATOMIC_RELAXED, __HIP_MEMORY_SCOPE_AGENT); }
__device__ __forceinline__ unsigned xb_add(unsigned* p, unsigned v) { return __hip_atomic_fetch_add(p, v, __ATOMIC_RELAXED, __HIP_MEMORY_SCOPE_AGENT); }
__device__ __forceinline__ unsigned xb_xcc_id() { return (unsigned)__builtin_amdgcn_s_getreg((3 << 11) | 20) & 0xFu; }
#define XB_SPIN(cond, bar) do { unsigned _sp = 0; while (cond) { __builtin_amdgcn_s_sleep(1); \
    if ((++_sp & 255u) == 0u) { if (xb_ld(&(bar)[XB_TMO])) break; if (_sp > XB_SPIN_CAP) { atomicAdd(&(bar)[XB_TMO], 1u); break; } } } } while (0)

struct XcdBarrier {
    unsigned* bar; unsigned x;
    volatile LAS unsigned* st;
};

__device__ __forceinline__ XcdBarrier xcd_barrier_post(unsigned* bar, volatile LAS unsigned* st) {
    XcdBarrier b; b.bar = bar; b.x = xb_xcc_id(); b.st = st;
    if (threadIdx.x == 0) (void)xb_add(&bar[XB_XCNT(b.x)], 1u);
    return b;
}
__device__ __forceinline__ void xcd_barrier_complete(unsigned* bar, unsigned x, unsigned& nloc, unsigned& nx) {
    const unsigned G = gridDim.x * gridDim.y * gridDim.z;
    unsigned sum, cnt, mine, sp = 0u;
    for (;;) {
        sum = 0u; cnt = 0u; mine = 0u;
#pragma unroll
        for (unsigned j = 0; j < 16; ++j) { const unsigned c = xb_ld(&bar[XB_XCNT(j)]); sum += c; cnt += (c > 0u) ? 1u : 0u; mine = (j == x) ? c : mine; }
        if (sum == G) break;
        __builtin_amdgcn_s_sleep(1);
        if ((++sp & 255u) == 0u) { if (xb_ld(&bar[XB_TMO])) break; if (sp > XB_SPIN_CAP) { atomicAdd(&bar[XB_TMO], 1u); break; } }
    }
    nloc = mine > 0u ? mine : 1u; nx = cnt > 0u ? cnt : 1u;
}

__device__ __forceinline__ void xcd_barrier(const XcdBarrier& b) {
    asm volatile("s_waitcnt vmcnt(0)" ::: "memory");
    __syncthreads();
    if (threadIdx.x == 0) {
        unsigned* bar = b.bar;
        __builtin_amdgcn_s_waitcnt(0);
        unsigned nloc = b.st[0], nx = b.st[1];
        if (nloc == 0u) { xcd_barrier_complete(bar, b.x, nloc, nx); b.st[0] = nloc; b.st[1] = nx; }
        const unsigned old = xb_add(&bar[XB_XSUB(b.x)], 1u);
        const unsigned gen = old / nloc;
        if (old + 1u == (gen + 1u) * nloc) {
            __builtin_amdgcn_fence(__ATOMIC_RELEASE, "agent");
            asm volatile("s_waitcnt vmcnt(0)" ::: "memory");
            const unsigned og = xb_add(&bar[XB_TOP], 1u);
            const unsigned tg = og / nx;
            if (og + 1u == (tg + 1u) * nx) xb_add(&bar[XB_TOPGEN], 1u);
            else XB_SPIN(xb_ld(&bar[XB_TOPGEN]) == tg, bar);
            __builtin_amdgcn_fence(__ATOMIC_ACQUIRE, "agent");
            xb_add(&bar[XB_XGEN(b.x)], 1u);
            asm volatile("s_waitcnt vmcnt(0)" ::: "memory");
        } else {
            XB_SPIN(xb_ld(&bar[XB_XGEN(b.x)]) == gen, bar);
            __builtin_amdgcn_fence(__ATOMIC_ACQUIRE, "agent");
            asm volatile("s_waitcnt vmcnt(0)" ::: "memory");
        }
    }
    __syncthreads();
}

constexpr int MISC_OFF = LDS_BYTES - 64;
struct Args { const float* in[18]; float* out; unsigned char* ws; int ph_lo, ph_hi; };

__device__ __forceinline__ void weight_items(const Args& a, LAS unsigned char* lds, int wave, int lane, int gw, int NGW, int it_lo, int it_hi) {
    unsigned char* ws = a.ws;
    LAS float* scr = (LAS float*)(lds + wave * 16384);
    const float* mix_g = a.in[2]; const float* ffn_g = a.in[3];
    constexpr int I_QKV = (D / 64) * (NQKV / 32), I_O = (D / 64) * (D / 32), I_GU = (D / 64) * (NGU / 32), I_DN = (DFF / 64) * (D / 32);
    for (int it = it_lo + gw; it < it_hi; it += NGW) {
        int r = it;
        if (r < I_QKV) { transpose_item(a.in[4], D, NQKV, (bf16*)(ws + WS_WQKV), mix_g, 1, scr, r, lane); continue; } r -= I_QKV;
        if (r < I_O)   { transpose_item(a.in[12], D, D, (bf16*)(ws + WS_WO), nullptr, 0, scr, r, lane); continue; } r -= I_O;
        if (r < I_GU)  { transpose_item(a.in[16], D, NGU, (bf16*)(ws + WS_WGU0), ffn_g, 2, scr, r, lane); continue; } r -= I_GU;
        if (r < I_DN)  { transpose_item(a.in[17], DFF, D, (bf16*)(ws + WS_WD0), nullptr, 0, scr, r, lane); continue; } r -= I_DN;
        if (r < I_QKV) { transpose_item(a.in[13], D, NQKV, (bf16*)(ws + WS_WIN), mix_g + D, 3, scr, r, lane); continue; } r -= I_QKV;
        if (r < I_O)   { transpose_item(a.in[15], D, D, (bf16*)(ws + WS_WOUT), nullptr, 0, scr, r, lane); continue; } r -= I_O;
        if (r < I_GU)  { transpose_item(a.in[16] + (size_t)D * NGU, D, NGU, (bf16*)(ws + WS_WGU1), ffn_g + D, 2, scr, r, lane); continue; } r -= I_GU;
        transpose_item(a.in[17] + (size_t)DFF * D, DFF, D, (bf16*)(ws + WS_WD1), nullptr, 0, scr, r, lane);
    }
}
constexpr int W_ITEMS_L0 = (D / 64) * (NQKV / 32) + (D / 64) * (D / 32) + (D / 64) * (NGU / 32) + (DFF / 64) * (D / 32), W_ITEMS = 2 * W_ITEMS_L0;
__device__ __forceinline__ void prologue(const Args& a, LAS unsigned char* lds, int wave, int lane, int gw, int NGW) {
    unsigned char* ws = a.ws;
    weight_items(a, lds, wave, lane, gw, NGW, 0, W_ITEMS_L0);
    { float* rope = (float*)(ws + WS_ROPE);
      for (int e = gw * 64 + lane; e < LTOK * 32; e += NGW * 64) { const int pos = e >> 5, i = e & 31;
          const float inv = (float)exp(-9.210340371976184 * (double)(2 * i) / 64.0);
          const float ang = (float)pos * inv; float c, s; sincos_acc(ang, c, s); rope[2 * e] = c; rope[2 * e + 1] = s; } }
    { const float* x = a.in[0]; bf16* XB = (bf16*)(ws + WS_XB); float* rs0 = (float*)(ws + WS_RS0);
      for (int m = gw; m < MP; m += NGW) {
          const float* src = x + (size_t)m * D;
          f32x4 v[4]; float s = 0.f;
#pragma unroll
          for (int j = 0; j < 4; ++j) { v[j] = *((const f32x4*)src + 64 * j + lane); s += (v[j][0] * v[j][0] + v[j][1] * v[j][1]) + (v[j][2] * v[j][2] + v[j][3] * v[j][3]); }
          s = wave_sum(s);
#pragma unroll
          for (int j = 0; j < 4; ++j) *((unsigned long long*)(XB + (size_t)m * D) + 64 * j + lane) = (unsigned long long)pk2(v[j][0], v[j][1]) | ((unsigned long long)pk2(v[j][2], v[j][3]) << 32);
          if (lane == 0) rs0[m] = s; } }
    { const float* meta = a.in[1]; bf16* MXB = (bf16*)(ws + WS_MXB); float* mrs = (float*)(ws + WS_MRS);
      if (gw < NMETA) { const int m = gw; const float* src = meta + (size_t)m * D; f32x4 v[4]; float s = 0.f;
#pragma unroll
          for (int j = 0; j < 4; ++j) { v[j] = *((const f32x4*)src + 64 * j + lane); s += (v[j][0] * v[j][0] + v[j][1] * v[j][1]) + (v[j][2] * v[j][2] + v[j][3] * v[j][3]); }
          s = wave_sum(s);
#pragma unroll
          for (int j = 0; j < 4; ++j) *((unsigned long long*)(MXB + (size_t)m * D) + 64 * j + lane) = (unsigned long long)pk2(v[j][0], v[j][1]) | ((unsigned long long)pk2(v[j][2], v[j][3]) << 32);
          if (lane == 0) mrs[m] = s; }
      v4u* mz = (v4u*)(ws + WS_MQKV);
      for (int e = gw * 64 + lane; e < 48 * 3072 * 2 / 16; e += NGW * 64) mz[e] = (v4u){0u, 0u, 0u, 0u};
      for (int e = gw * 64 + lane; e < 16 * 3072 / 4; e += NGW * 64) ((v4u*)(ws + WS_MC1))[e] = (v4u){0u, 0u, 0u, 0u};
      for (int e = gw * 64 + lane; e < 16 * 1024 / 4; e += NGW * 64) { ((v4u*)(ws + WS_MC2))[e] = (v4u){0u, 0u, 0u, 0u}; ((v4u*)(ws + WS_MC4))[e] = (v4u){0u, 0u, 0u, 0u}; }
      for (int e = gw * 64 + lane; e < 16 * 5632 / 4; e += NGW * 64) ((v4u*)(ws + WS_MC3))[e] = (v4u){0u, 0u, 0u, 0u};
      for (int e = gw * 64 + lane; e < 16 * 2048 / 4; e += NGW * 64) ((v4u*)(ws + WS_MC5))[e] = (v4u){0u, 0u, 0u, 0u}; }
}
constexpr int SK_KS = 8;
template <int AMODE> __device__ __forceinline__ void skinny_gemm(const bf16* A, const float* P, const float* Q, int K, const bf16* Bt, int mode, int n_src0, int ntiles, float* C, int ldc, int gwp, int NGW, int lane) {
    const int fr = lane & 15, fq = lane >> 4, kslice = K / SK_KS;
    for (int task = gwp; task < ntiles * SK_KS; task += NGW) {
        const int tile = task / SK_KS, k0 = (task % SK_KS) * kslice;
        const bf16* bp = Bt + (size_t)col_perm(mode, n_src0 + tile * 16 + fr) * K + 8 * fq;
        f32x4 acc = {0.f, 0.f, 0.f, 0.f};
#pragma unroll 4
        for (int kk = k0; kk < k0 + kslice; kk += 32) {
            bf16x8 av;
            if (AMODE == 0) av = *(const bf16x8*)(A + (size_t)fr * K + kk + 8 * fq);
            else { const float* pp = P + (size_t)fr * K + kk + 8 * fq; const float* qq = Q + (size_t)fr * K + kk + 8 * fq;
                const f32x4 p0 = *(const f32x4*)pp, p1 = *(const f32x4*)(pp + 4), q0 = *(const f32x4*)qq, q1 = *(const f32x4*)(qq + 4);
                v4u t; t.x = pk2(p0[0] + q0[0], p0[1] + q0[1]); t.y = pk2(p0[2] + q0[2], p0[3] + q0[3]); t.z = pk2(p1[0] + q1[0], p1[1] + q1[1]); t.w = pk2(p1[2] + q1[2], p1[3] + q1[3]);
                av = __builtin_bit_cast(bf16x8, t); }
            const bf16x8 bv = *(const bf16x8*)(bp + kk);
            acc = __builtin_amdgcn_mfma_f32_16x16x32_bf16(av, bv, acc, 0, 0, 0);
        }
#pragma unroll
        for (int j = 0; j < 4; ++j) __hip_atomic_fetch_add(C + (size_t)(4 * fq + j) * ldc + tile * 16 + fr, acc[j], __ATOMIC_RELAXED, __HIP_MEMORY_SCOPE_AGENT);
    }
}
__device__ __forceinline__ void meta_e1(const Args& a, LAS unsigned char* lds, int wave, int lane, int h, int r) {
    unsigned char* ws = a.ws;
    const float* C1 = (const float*)(ws + WS_MC1); const float* mrs = (const float*)(ws + WS_MRS); const float* rope = (const float*)(ws + WS_ROPE);
    bf16* MQ = (bf16*)(ws + WS_MQKV); bf16* OM = (bf16*)(ws + WS_MOM);
    const float* qg = a.in[5]; const float* kg = a.in[6]; const float* subg = a.in[11];
    const float lam = expf(wave_sum(a.in[7][lane] * a.in[8][lane])) - expf(wave_sum(a.in[9][lane] * a.in[10][lane])) + 0.2f;
    LAS float* kl = (LAS float*)(lds + wave * 16384);
    LAS float* vl = kl + 2048;
    const int i = lane & 31; const float kgl = kg[lane];
#pragma unroll 4
    for (int rp = 0; rp <= r; ++rp) {
        const float rs = rsqrtf(mrs[rp] * (1.0f / 1024.0f) + 1e-6f);
        const float cs = rope[(rp * 32 + i) * 2], sn = rope[(rp * 32 + i) * 2 + 1];
#pragma unroll
        for (int c = 0; c < 2; ++c) {
            float x = C1[(size_t)rp * 3072 + 1024 + h * 128 + c * 64 + lane] * rs;
            const float ss = wave_sum(x * x); x = x * rsqrtf(ss * (1.0f / 64.0f) + 1e-6f) * kgl;
            const float pr = __shfl_xor(x, 32); const float o = lane < 32 ? x * cs - pr * sn : x * cs + pr * sn;
            kl[(c * 16 + rp) * 64 + lane] = o;
            if (rp == r) MQ[(size_t)(48 + r) * 3072 + 1024 + h * 128 + c * 64 + lane] = (bf16)f2bf(o);
        }
#pragma unroll
        for (int hf = 0; hf < 2; ++hf) { const float v = C1[(size_t)rp * 3072 + 2048 + h * 128 + hf * 64 + lane] * rs; vl[rp * 128 + hf * 64 + lane] = v;
            if (rp == r) MQ[(size_t)(48 + r) * 3072 + 2048 + h * 128 + hf * 64 + lane] = (bf16)f2bf(v); }
    }
    asm volatile("s_waitcnt lgkmcnt(0)" ::: "memory");
    {
        const float rs = rsqrtf(mrs[r] * (1.0f / 1024.0f) + 1e-6f);
        const float cs = rope[(r * 32 + i) * 2], sn = rope[(r * 32 + i) * 2 + 1];
        float q0, q1;
        { float x = C1[(size_t)r * 3072 + h * 128 + lane] * rs; const float ss = wave_sum(x * x); x = x * rsqrtf(ss * (1.0f / 64.0f) + 1e-6f) * qg[lane];
          const float pr = __shfl_xor(x, 32); q0 = (lane < 32 ? x * cs - pr * sn : x * cs + pr * sn) * pg8::QSCALE_; }
        { float x = C1[(size_t)r * 3072 + h * 128 + 64 + lane] * rs; const float ss = wave_sum(x * x); x = x * rsqrtf(ss * (1.0f / 64.0f) + 1e-6f) * qg[lane];
          const float pr = __shfl_xor(x, 32); q1 = (lane < 32 ? x * cs - pr * sn : x * cs + pr * sn) * pg8::QSCALE_; }
        float l0 = 0.f, l1 = 0.f, o0a = 0.f, o0b = 0.f, o1a = 0.f, o1b = 0.f;
#pragma unroll 4
        for (int rp = 0; rp <= r; ++rp) {
            const float s0 = wave_sum(q0 * kl[rp * 64 + lane]), s1 = wave_sum(q1 * kl[(16 + rp) * 64 + lane]);
            const float p0 = __builtin_amdgcn_exp2f(s0), p1 = __builtin_amdgcn_exp2f(s1); l0 += p0; l1 += p1;
            const float va = vl[rp * 128 + lane], vb = vl[rp * 128 + 64 + lane];
            o0a += p0 * va; o0b += p0 * vb; o1a += p1 * va; o1b += p1 * vb;
        }
        const float oa = o0a / l0 - lam * o1a / l1, ob = o0b / l0 - lam * o1b / l1;
        const float rn = rsqrtf(wave_sum(oa * oa + ob * ob) * (1.0f / 128.0f) + 1e-6f) * 0.8f;
        OM[(size_t)r * 1024 + h * 128 + lane] = (bf16)f2bf(oa * rn * subg[lane]); OM[(size_t)r * 1024 + h * 128 + 64 + lane] = (bf16)f2bf(ob * rn * subg[64 + lane]);
    }
    asm volatile("s_waitcnt lgkmcnt(0)" ::: "memory");
}
__device__ __forceinline__ void meta_e3(const Args& a, int gwp, int NGW, int lane) {
    unsigned char* ws = a.ws; const float* meta = a.in[1]; const float* C2 = (const float*)(ws + WS_MC2); float* H1 = (float*)(ws + WS_MH1);
    const float* C3 = (const float*)(ws + WS_MC3); bf16* HID = (bf16*)(ws + WS_MHID);
    for (int task = gwp; task < 16 * (DFF / 64); task += NGW) { const int r = task / (DFF / 64), ch = task - r * (DFF / 64); float s = 0.f; f32x4 v[4];
#pragma unroll
        for (int j = 0; j < 4; ++j) { v[j] = *((const f32x4*)(meta + (size_t)r * D) + 64 * j + lane) + *((const f32x4*)(C2 + (size_t)r * D) + 64 * j + lane); s += (v[j][0] * v[j][0] + v[j][1] * v[j][1]) + (v[j][2] * v[j][2] + v[j][3] * v[j][3]); }
        if (ch == 0) {
#pragma unroll
            for (int j = 0; j < 4; ++j) *((f32x4*)(H1 + (size_t)r * D) + 64 * j + lane) = v[j]; }
        const float rs = rsqrtf(wave_sum(s) * (1.0f / 1024.0f) + 1e-6f);
        const int j = 64 * ch + lane; const float g = C3[(size_t)r * NGU + j] * rs, u = C3[(size_t)r * NGU + DFF + j] * rs;
        HID[(size_t)r * DFF + j] = (bf16)f2bf(g * __builtin_amdgcn_rcpf(1.0f + __expf(-g)) * u); }
}
__device__ __forceinline__ void meta_e5(const Args& a, int gwp, int NGW, int lane) {
    unsigned char* ws = a.ws; const float* H1 = (const float*)(ws + WS_MH1); const float* C4 = (const float*)(ws + WS_MC4);
    const float* C5 = (const float*)(ws + WS_MC5); bf16* MZ = (bf16*)(ws + WS_MZ);
    for (int task = gwp; task < 16 * (D / 64); task += NGW) { const int r = task >> 4, ch = task & 15; float s = 0.f;
#pragma unroll
        for (int j = 0; j < 4; ++j) { const f32x4 v = *((const f32x4*)(H1 + (size_t)r * D) + 64 * j + lane) + *((const f32x4*)(C4 + (size_t)r * D) + 64 * j + lane); s += (v[0] * v[0] + v[1] * v[1]) + (v[2] * v[2] + v[3] * v[3]); }
        const float rs = rsqrtf(wave_sum(s) * (1.0f / 1024.0f) + 1e-6f);
        const int j = 64 * ch + lane;
        MZ[(size_t)r * D + j] = (bf16)f2bf((C5[(size_t)r * 2048 + j] * rs) * (C5[(size_t)r * 2048 + 1024 + j] * rs)); }
}
__device__ __forceinline__ void conv_phase(const Args& a, int lane, int gw, int NGW) {
    const bf16* Z = (const bf16*)(a.ws + WS_BIG); const bf16* GB = Z + (size_t)MP * D; bf16* Y = (bf16*)(a.ws + WS_O); const float* cw = a.in[14];
    for (int it = gw; it < (MP / 16) * 2; it += NGW) {
        const int rb = (MP / 16 - 1) - (it >> 1), col = (it & 1) * 512 + lane * 8, row0 = rb * 16, p0 = row0 % LP;
        float w0[8], w1[8], w2[8], zm2[8], zm1[8];
#pragma unroll
        for (int e = 0; e < 8; ++e) { w0[e] = cw[col + e]; w1[e] = cw[D + col + e]; w2[e] = cw[2 * D + col + e]; zm2[e] = 0.f; zm1[e] = 0.f; }
        { const bf16* MZ = (const bf16*)(a.ws + WS_MZ);
          const v4u a2 = *(const v4u*)(p0 != 0 ? Z + (size_t)(row0 - 2) * D + col : MZ + 14 * D + col), a1 = *(const v4u*)(p0 != 0 ? Z + (size_t)(row0 - 1) * D + col : MZ + 15 * D + col);
#pragma unroll
            for (int e = 0; e < 4; ++e) { zm2[2 * e] = __uint_as_float(a2[e] << 16); zm2[2 * e + 1] = __uint_as_float(a2[e] & 0xffff0000u); zm1[2 * e] = __uint_as_float(a1[e] << 16); zm1[2 * e + 1] = __uint_as_float(a1[e] & 0xffff0000u); } }
#pragma unroll 4
        for (int i = 0; i < 16; ++i) { const size_t off = (size_t)(row0 + i) * D + col; const v4u zz = *(const v4u*)(Z + off), gg = *(const v4u*)(GB + off);
            float z[8], g[8], y[8];
#pragma unroll
            for (int e = 0; e < 4; ++e) { z[2 * e] = __uint_as_float(zz[e] << 16); z[2 * e + 1] = __uint_as_float(zz[e] & 0xffff0000u); g[2 * e] = __uint_as_float(gg[e] << 16); g[2 * e + 1] = __uint_as_float(gg[e] & 0xffff0000u); }
#pragma unroll
            for (int e = 0; e < 8; ++e) { y[e] = g[e] * (w0[e] * zm2[e] + w1[e] * zm1[e] + w2[e] * z[e]); zm2[e] = zm1[e]; zm1[e] = z[e]; }
            v4u o; o.x = pk2(y[0], y[1]); o.y = pk2(y[2], y[3]); o.z = pk2(y[4], y[5]); o.w = pk2(y[6], y[7]);
            *(v4u*)(Y + off) = o; }
    }
}

__global__ void __launch_bounds__(NWAVES * 64, 2) mega_fwd(Args args) {
    extern __shared__ __attribute__((aligned(16))) unsigned char lds_raw[];
    LAS unsigned char* lds = (LAS unsigned char*)lds_raw;
    cg::grid_group grid = cg::this_grid();
    const int wave = __builtin_amdgcn_readfirstlane(threadIdx.x >> 6);
    const int G = gridDim.x, gw = blockIdx.x * NWAVES + wave, NGW = G * NWAVES, gwp = wave * G + (int)blockIdx.x;
    unsigned char* ws = args.ws;
    bf16* XB = (bf16*)(ws + WS_XB); float* SSP = (float*)(ws + WS_SSP); bf16* BIG = (bf16*)(ws + WS_BIG); bf16* OB = (bf16*)(ws + WS_O);
    const int lo = args.ph_lo, hi = args.ph_hi;
    if (threadIdx.x < 16) ((LAS unsigned*)(lds + MISC_OFF))[threadIdx.x] = 0u;
    __syncthreads();
    XcdBarrier bar = xcd_barrier_post((unsigned*)(ws + WS_CTL), (volatile LAS unsigned*)(lds + MISC_OFF));
#ifndef PHASE_MASK
#define PHASE_MASK 0x1fff
#endif
#define IN(k) (((PHASE_MASK >> (k)) & 1) && lo <= (k) && (k) < hi)
#define SEAM(k) do { if (IN(k) && IN((k) + 1)) { if ((k) == 0) grid.sync(); else xcd_barrier(bar); } } while (0)
    bf16* MXB = (bf16*)(ws + WS_MXB); const bf16* MQKV = (const bf16*)(ws + WS_MQKV);
    if (IN(0)) REPS(0) { prologue(args, lds, wave, pg8::lane_id_v(), gw, NGW); }
    SEAM(0);
    if (IN(1)) {
        skinny_gemm<0>(MXB, nullptr, nullptr, D, (const bf16*)(ws + WS_WQKV), 1, 0, NQKV / 16, (float*)(ws + WS_MC1), NQKV, gwp, NGW, pg8::lane_id_v());
    }
    SEAM(1);
    if (IN(2)) {
        if (gwp < 128) meta_e1(args, lds, wave, pg8::lane_id_v(), gwp & 7, 15 - (gwp >> 3));
        weight_items(args, lds, wave, pg8::lane_id_v(), gw, NGW, W_ITEMS_L0, W_ITEMS);
    }
    SEAM(2);
    if (IN(3)) REPS(3) {
        skinny_gemm<0>((const bf16*)(ws + WS_MOM), nullptr, nullptr, D, (const bf16*)(ws + WS_WO), 0, 0, D / 16, (float*)(ws + WS_MC2), D, gwp, NGW, pg8::lane_id_v());
        pg8::Gemm g{XB, (const bf16*)(ws + WS_WQKV), MP, NQKV, D}; pg8::StaticOrder S; S.init(MP, NQKV, G, (int)blockIdx.x);
        pg8::EpiQKV E{BIG, (const float*)(ws + WS_RS0), (const float*)(ws + WS_ROPE), args.in[5], args.in[6], lds + pg8::SSPL_OFF};
        pg8::gemm_phase<pg8::EpiQKV, pg8::StaticOrder, true, true>(lds, g, S, E, wave);
    }
    SEAM(3);
    if (IN(4)) REPS(4) {
        skinny_gemm<1>(nullptr, args.in[1], (const float*)(ws + WS_MC2), D, (const bf16*)(ws + WS_WGU0), 2, 0, NGU / 16, (float*)(ws + WS_MC3), NGU, gwp, NGW, pg8::lane_id_v());
        const int lane = pg8::lane_id_v();
        float s1 = wave_sum(args.in[7][lane] * args.in[8][lane]), s2 = wave_sum(args.in[9][lane] * args.in[10][lane]);
        const float lam = expf(s1) - expf(s2) + 0.2f;
        for (int bh = blockIdx.x; bh < NB * 8; bh += G) { const int b = bh >> 3, h = bh & 7;
#pragma unroll 1
            for (int j = 0; j < 8; ++j) att::attn_unit<WS_BIG, WS_MQKV, WS_O>(lds, ws, b, h, 64 + 256 * j, 8, lam, args.in[11], wave); }
    }
    SEAM(4);
    if (IN(5)) {
        meta_e3(args, gwp, NGW, pg8::lane_id_v());
        pg8::Gemm g{OB, (const bf16*)(ws + WS_WO), MP, D, D}; pg8::StaticOrder S; S.init(MP, D, G, (int)blockIdx.x);
        pg8::EpiRes<1> E{nullptr, XB, SSP, nullptr};
        pg8::gemm_phase<pg8::EpiRes<1>, pg8::StaticOrder, true, true>(lds, g, S, E, wave);
    }
    SEAM(5);
    if (IN(6)) REPS(6) {
        skinny_gemm<0>((const bf16*)(ws + WS_MHID), nullptr, nullptr, DFF, (const bf16*)(ws + WS_WD0), 0, 0, D / 16, (float*)(ws + WS_MC4), D, gwp, NGW, pg8::lane_id_v());
        pg8::Gemm g{XB, (const bf16*)(ws + WS_WGU0), MP, NGU, D}; pg8::StaticOrder S; S.init(MP, NGU, G, (int)blockIdx.x);
        pg8::EpiGateUp E{BIG, SSP, lds + pg8::SSPL_OFF};
        pg8::gemm_phase<pg8::EpiGateUp, pg8::StaticOrder, true, true>(lds, g, S, E, wave);
    }
    SEAM(6);
    if (IN(7)) {
        skinny_gemm<1>(nullptr, (const float*)(ws + WS_MH1), (const float*)(ws + WS_MC4), D, (const bf16*)(ws + WS_WIN), 3, 1024, 2048 / 16, (float*)(ws + WS_MC5), 2048, gwp, NGW, pg8::lane_id_v());
        pg8::Gemm g{BIG, (const bf16*)(ws + WS_WD0), MP, D, DFF}; pg8::StaticOrder S; S.init(MP, D, G, (int)blockIdx.x, 1);
        pg8::EpiRes<1> E{nullptr, XB, SSP, nullptr};
        pg8::gemm_phase<pg8::EpiRes<1>, pg8::StaticOrder, true, true>(lds, g, S, E, wave);
    }
    SEAM(7);
    if (IN(8)) REPS(8) {
        meta_e5(args, gwp, NGW, pg8::lane_id_v());
        pg8::Gemm g{XB, (const bf16*)(ws + WS_WIN), MP, NQKV, D}; pg8::StaticOrder S; S.init(MP, NQKV, G, (int)blockIdx.x);
        pg8::EpiWin E{BIG, BIG + (size_t)MP * D, SSP, lds + pg8::SSPL_OFF};
        pg8::gemm_phase<pg8::EpiWin, pg8::StaticOrder, true, true>(lds, g, S, E, wave);
    }
    SEAM(8);
    if (IN(9)) REPS(9) { conv_phase(args, pg8::lane_id_v(), gw, NGW); }
    SEAM(9);
    if (IN(10)) {
        pg8::Gemm g{OB, (const bf16*)(ws + WS_WOUT), MP, D, D}; pg8::StaticOrder S; S.init(MP, D, G, (int)blockIdx.x);
        pg8::EpiRes<1> E{nullptr, XB, SSP, nullptr};
        pg8::gemm_phase<pg8::EpiRes<1>, pg8::StaticOrder, true, true>(lds, g, S, E, wave);
    }
    SEAM(10);
    if (IN(11)) REPS(11) {
        pg8::Gemm g{XB, (const bf16*)(ws + WS_WGU1), MP, NGU, D}; pg8::StaticOrder S; S.init(MP, NGU, G, (int)blockIdx.x);
        pg8::EpiGateUp E{BIG, SSP, lds + pg8::SSPL_OFF};
        pg8::gemm_phase<pg8::EpiGateUp, pg8::StaticOrder, true, true>(lds, g, S, E, wave);
    }
    SEAM(11);
    if (IN(12)) {
        pg8::Gemm g{BIG, (const bf16*)(ws + WS_WD1), MP, D, DFF}; pg8::StaticOrder S; S.init(MP, D, G, (int)blockIdx.x, 1);
        pg8::EpiRes<2> E{nullptr, XB, nullptr, args.out};
        pg8::gemm_phase<pg8::EpiRes<2>, pg8::StaticOrder, true, true>(lds, g, S, E, wave);
    }
#undef IN
#undef SEAM
}

extern "C" void kernel_launch(void* const* d_in, const int* in_sizes, int n_in, void* d_out, int out_size, void* d_ws, size_t ws_size, hipStream_t stream) {
    static int grid = 0;
    if (grid == 0) {
        if (n_in != 18 || ws_size < WS_END) { fprintf(stderr, "kernel_launch: need 18 inputs and %zu bytes of workspace (got %d, %zu)\n", (size_t)WS_END, n_in, ws_size); grid = -1; return; }
        int dev = 0, cus = 0, per_cu = 0;
        hipGetDevice(&dev); hipDeviceGetAttribute(&cus, hipDeviceAttributeMultiprocessorCount, dev);
        if (hipFuncSetAttribute((const void*)mega_fwd, hipFuncAttributeMaxDynamicSharedMemorySize, LDS_BYTES) != hipSuccess) { fprintf(stderr, "kernel_launch: hipFuncSetAttribute failed\n"); grid = -1; return; }
        if (hipOccupancyMaxActiveBlocksPerMultiprocessor(&per_cu, (const void*)mega_fwd, NWAVES * 64, LDS_BYTES) != hipSuccess || per_cu < 1) { fprintf(stderr, "kernel_launch: occupancy query says %d\n", per_cu); per_cu = 1; }
        (void)hipGetLastError();
        grid = cus * per_cu;
    }
    if (grid < 0) return;
    Args a{};
    for (int i = 0; i < 18; ++i) a.in[i] = (const float*)d_in[i];
    a.out = (float*)d_out; a.ws = (unsigned char*)d_ws;
#if MK_PER_PHASE
    for (int p = 0; p < NPHASE; ++p) { a.ph_lo = p; a.ph_hi = p + 1; hipLaunchKernelGGL(mega_fwd, dim3(grid), dim3(NWAVES * 64), LDS_BYTES, stream, a); }
#else
    a.ph_lo = 0; a.ph_hi = NPHASE;
    if (hipMemsetAsync((char*)d_ws + WS_CTL, 0, CTL_BYTES, stream) != hipSuccess) { fprintf(stderr, "kernel_launch: memset failed\n"); return; }
    void* kargs[] = {&a};
    hipError_t e = hipLaunchCooperativeKernel((const void*)mega_fwd, dim3(grid), dim3(NWAVES * 64), kargs, LDS_BYTES, stream);
    if (e != hipSuccess) fprintf(stderr, "kernel_launch: cooperative launch failed: %s (grid %d)\n", hipGetErrorString(e), grid);
#endif
}
```

```cpp
#include <hip/hip_runtime.h>
#include <hip/hip_cooperative_groups.h>
#include <cstdio>
#include <cstdint>
namespace cg = cooperative_groups;
namespace pg8 {
#define PG8_LAS __attribute__((address_space(3)))
typedef unsigned short bf16_t;
typedef short bf16x8 __attribute__((ext_vector_type(8)));
typedef float f32x4 __attribute__((ext_vector_type(4)));
typedef unsigned u32x4 __attribute__((ext_vector_type(4)));
constexpr int BM = 256, BK = 64, HALF = 128, HTB = HALF * BK * 2  , STAGE_BYTES = 8 * HTB, NXCD = 8, WGM = 8;

__host__ __device__ __forceinline__ int lds_byte(int r, int c) { const int st = (r >> 4) * 2 + (c >> 5), rr = r & 15, cc = c & 31, ob = rr * 64 + cc * 2; return st * 1024 + (ob ^ (((ob >> 9) & 1) << 5)); }
__host__ __device__ __forceinline__ void stage_rc(int b, int& R, int& C) { const int st = b / 1024, sb = b % 1024, swz = sb ^ (((sb >> 9) & 1) << 5); R = (st >> 1) * 16 + swz / 64; C = (st & 1) * 32 + (swz % 64) / 2; }
__host__ __device__ __forceinline__ int perm32(int rho) { const int n = rho >> 4, i = rho & 15; return 8 * (i >> 2) + 4 * n + (i & 3); }

struct Unit { int pm, pn; };
struct Gemm { const bf16_t* A; const bf16_t* Bt; int M, N, K; };

struct StaticOrder {
    int nM, nN, nwg, G, c, rev;
    __host__ __device__ void init(int M, int N, int G_, int c_, int rev_ = 0) { nM = M / BM; nN = N / BM; nwg = nM * nN; G = G_; c = c_; rev = rev_; }
    __host__ __device__ bool next(int i, Unit& u) const {
        const long L = (long)i * G + c; if (L >= nwg) return false;
        int wgid = (int)L; { const int q = nwg / NXCD, r = nwg % NXCD, xcd = wgid % NXCD, off = wgid / NXCD; wgid = (xcd < r ? xcd * (q + 1) : r * (q + 1) + (xcd - r) * q) + off; }
        const int nig = WGM * nN, gid = wgid / nig, fm = gid * WGM, gsz = (nM - fm) < WGM ? (nM - fm) : WGM;
        u.pm = fm + ((wgid % nig) % gsz); u.pn = (wgid % nig) / gsz; if (rev) u.pm = nM - 1 - u.pm; return true;
    }
    __device__ __forceinline__ void a_ready(const Unit&) const {}
    __device__ __forceinline__ void done(const Unit&) const {}
};
__device__ __forceinline__ unsigned cvt_pk_bf16(float lo, float hi) { unsigned r; asm volatile("v_cvt_pk_bf16_f32 %0, %1, %2" : "=v"(r) : "v"(lo), "v"(hi)); return r; }
typedef unsigned u32x2 __attribute__((ext_vector_type(2)));
__device__ __forceinline__ int lane_id_v() { int l; asm volatile("v_mbcnt_lo_u32_b32 %0, -1, 0\n\tv_mbcnt_hi_u32_b32 %0, -1, %0" : "=v"(l)); return l; }
constexpr int LP_ = 2048, NMETA_ = 16;
constexpr float QSCALE_ = 0.125f * 1.4426950408889634f;
__device__ __forceinline__ float row_rstd(const float* ssp, int row) {
    const f32x4* p = (const f32x4*)(ssp + (size_t)row * 16);
    const f32x4 a = p[0], b = p[1], c = p[2], d = p[3];
    const float s = (((a[0] + a[1]) + (a[2] + a[3])) + ((b[0] + b[1]) + (b[2] + b[3]))) + (((c[0] + c[1]) + (c[2] + c[3])) + ((d[0] + d[1]) + (d[2] + d[3])));
    return rsqrtf(s * (1.0f / 1024.0f) + 1e-6f);
}
__device__ __forceinline__ float row_rstd_lds(const PG8_LAS unsigned char* sspl, int rl) {
    const PG8_LAS f32x4* p = (const PG8_LAS f32x4*)(sspl + rl * 64);
    const f32x4 a = p[0], b = p[1], c = p[2], d = p[3];
    const float s = (((a[0] + a[1]) + (a[2] + a[3])) + ((b[0] + b[1]) + (b[2] + b[3]))) + (((c[0] + c[1]) + (c[2] + c[3])) + ((d[0] + d[1]) + (d[2] + d[3])));
    return rsqrtf(s * (1.0f / 1024.0f) + 1e-6f);
}
constexpr int SSPL_OFF = 131072;
constexpr int QRS_OFF = SSPL_OFF, QROPEB_OFF = SSPL_OFF + 2048, QROPEO_OFF = SSPL_OFF + 2048 + 8192;
__device__ __forceinline__ u32x4 pack8(const f32x4 v0, const f32x4 v1) { u32x4 w; w.x = cvt_pk_bf16(v0[0], v0[1]); w.y = cvt_pk_bf16(v0[2], v0[3]); w.z = cvt_pk_bf16(v1[0], v1[1]); w.w = cvt_pk_bf16(v1[2], v1[3]); return w; }

struct EpiQKV {
    static constexpr bool PERM = true, AFTER_DRAIN = false, USES_SSP = false; static constexpr int NST = 16;
    bf16_t* QKV; const float* rs0; const float* rope; const float* qg; const float* kg; const PG8_LAS unsigned char* sspl;
    __device__ __forceinline__ void prefetch_next(PG8_LAS unsigned char* lds, int pm, int wid, int lane, int par) const {
        if (wid < 4) { const int p0 = ((pm * BM) % LP_) + NMETA_;
            __builtin_amdgcn_global_load_lds((const unsigned*)((const char*)rope + (size_t)(p0 + 64 * wid) * 256 + (unsigned)((lane >> 4) * 4096 + (lane & 15) * 16)), (PG8_LAS unsigned*)(lds + QROPEB_OFF + par * 4096 + wid * 1024), 16, 0, 0); }
        else if (wid == 4) __builtin_amdgcn_global_load_lds((const unsigned*)((const char*)rs0 + (size_t)pm * (BM * 4) + (unsigned)(lane * 16)), (PG8_LAS unsigned*)(lds + QRS_OFF + par * 1024), 16, 0, 0);
    }
    __device__ __forceinline__ void prefetch_phase(PG8_LAS unsigned char* lds, int pm, int wid, int lane) const {
        if (wid >= 4) __builtin_amdgcn_global_load_lds((const unsigned*)((const char*)rope + (size_t)((wid - 4) * 1024) + (unsigned)(lane * 16)), (PG8_LAS unsigned*)(lds + QROPEO_OFF + (wid - 4) * 1024), 16, 0, 0);
        prefetch_next(lds, pm, wid, lane, 0);
    }
    __device__ __forceinline__ void operator()(const f32x4 (&acc)[2][2][4][2], const Unit& u, int wr, int wc, int fr, int fq, int par) const {
        const int row0 = u.pm * BM + wr * 64 + fr, pn = u.pn;
        const int colbase = pn * 256 + wc * 64 + 8 * fq;
        if (pn < 8) {
            const float* gp = (pn < 4) ? qg : kg; const float osc = (pn < 4) ? QSCALE_ : 1.0f;
            f32x4 g[2][2];
#pragma unroll
            for (int bj = 0; bj < 2; ++bj)
#pragma unroll
                for (int n = 0; n < 2; ++n) g[bj][n] = *(const f32x4*)(gp + 32 * bj + 8 * fq + 4 * n);
            const PG8_LAS f32x4* rop = (const PG8_LAS f32x4*)(sspl + (QROPEO_OFF - SSPL_OFF) + fr * 256 + fq * 64);
#pragma unroll
            for (int ai = 0; ai < 2; ++ai)
#pragma unroll
                for (int m = 0; m < 4; ++m) {
                    const int row = row0 + ai * HALF + m * 16; const float rs = rsqrtf(*(const PG8_LAS float*)(sspl + (QRS_OFF - SSPL_OFF) + par * 1024 + (row - u.pm * BM) * 4) * (1.0f / 1024.0f) + 1e-6f);
                    f32x4 v[2][2]; float ss = 0.f;
#pragma unroll
                    for (int bj = 0; bj < 2; ++bj)
#pragma unroll
                        for (int n = 0; n < 2; ++n) { v[bj][n] = acc[ai][bj][m][n] * rs; const f32x4 x = v[bj][n]; ss += (x[0] * x[0] + x[1] * x[1]) + (x[2] * x[2] + x[3] * x[3]); }
                    ss += __shfl_xor(ss, 16); ss += __shfl_xor(ss, 32);
                    const float rn = rsqrtf(ss * (1.0f / 64.0f) + 1e-6f);
#pragma unroll
                    for (int bj = 0; bj < 2; ++bj)
#pragma unroll
                        for (int n = 0; n < 2; ++n) v[bj][n] = v[bj][n] * rn * g[bj][n];
                    const PG8_LAS f32x4* bp = (const PG8_LAS f32x4*)(sspl + (QROPEB_OFF - SSPL_OFF) + par * 4096 + ((row - u.pm * BM) >> 4) * 256 + fq * 64);
                    f32x4 rp[4];
#pragma unroll
                    for (int qq = 0; qq < 4; ++qq) { const f32x4 bb = bp[qq], oo = rop[qq];
                        rp[qq][0] = bb[0] * oo[0] - bb[1] * oo[1]; rp[qq][1] = bb[1] * oo[0] + bb[0] * oo[1];
                        rp[qq][2] = bb[2] * oo[2] - bb[3] * oo[3]; rp[qq][3] = bb[3] * oo[2] + bb[2] * oo[3]; }
                    f32x4 o1[2], o2[2];
#pragma unroll
                    for (int n = 0; n < 2; ++n) { const f32x4 ca = rp[2 * n], cb = rp[2 * n + 1];
                        const f32x4 x1 = v[0][n], x2 = v[1][n];
                        o1[n][0] = (x1[0] * ca[0] - x2[0] * ca[1]) * osc; o2[n][0] = (x2[0] * ca[0] + x1[0] * ca[1]) * osc;
                        o1[n][1] = (x1[1] * ca[2] - x2[1] * ca[3]) * osc; o2[n][1] = (x2[1] * ca[2] + x1[1] * ca[3]) * osc;
                        o1[n][2] = (x1[2] * cb[0] - x2[2] * cb[1]) * osc; o2[n][2] = (x2[2] * cb[0] + x1[2] * cb[1]) * osc;
                        o1[n][3] = (x1[3] * cb[2] - x2[3] * cb[3]) * osc; o2[n][3] = (x2[3] * cb[2] + x1[3] * cb[3]) * osc; }
                    bf16_t* rowp = QKV + (size_t)row * 3072 + colbase;
                    *(u32x4*)(rowp) = pack8(o1[0], o1[1]); *(u32x4*)(rowp + 32) = pack8(o2[0], o2[1]);
                }
        } else {
#pragma unroll
            for (int ai = 0; ai < 2; ++ai)
#pragma unroll
                for (int m = 0; m < 4; ++m) {
                    const int row = row0 + ai * HALF + m * 16; const float rs = rsqrtf(*(const PG8_LAS float*)(sspl + (QRS_OFF - SSPL_OFF) + par * 1024 + (row - u.pm * BM) * 4) * (1.0f / 1024.0f) + 1e-6f);
                    bf16_t* rowp = QKV + (size_t)row * 3072 + colbase;
#pragma unroll
                    for (int bj = 0; bj < 2; ++bj) *(u32x4*)(rowp + 32 * bj) = pack8(acc[ai][bj][m][0] * rs, acc[ai][bj][m][1] * rs);
                }
        }
    }
};
struct EpiGateUp {
    static constexpr bool PERM = true, AFTER_DRAIN = false, USES_SSP = true; static constexpr int NST = 8;
    bf16_t* HID; const float* ssp; const PG8_LAS unsigned char* sspl;
    __device__ __forceinline__ void prefetch_phase(PG8_LAS unsigned char*, int, int, int) const {}
    __device__ __forceinline__ void prefetch_next(PG8_LAS unsigned char*, int, int, int, int) const {}
    __device__ __forceinline__ void operator()(const f32x4 (&acc)[2][2][4][2], const Unit& u, int wr, int wc, int fr, int fq, int par) const {
        const int row0 = u.pm * BM + wr * 64 + fr; const int col = u.pn * 128 + wc * 32 + 8 * fq;
#pragma unroll
        for (int ai = 0; ai < 2; ++ai)
#pragma unroll
            for (int m = 0; m < 4; ++m) {
                const int row = row0 + ai * HALF + m * 16; const float rs = row_rstd_lds(sspl, row - u.pm * BM);
                f32x4 hv[2];
                const float kx = -1.4426950408889634f * rs, rs2 = rs * rs;
#pragma unroll
                for (int n = 0; n < 2; ++n) { const f32x4 a0 = acc[ai][0][m][n], a1 = acc[ai][1][m][n];
#pragma unroll
                    for (int e = 0; e < 4; ++e) { const float r = __builtin_amdgcn_rcpf(1.0f + __builtin_amdgcn_exp2f(a0[e] * kx)); hv[n][e] = (a0[e] * a1[e]) * (rs2 * r); } }
                *(u32x4*)(HID + (size_t)row * 2816 + col) = pack8(hv[0], hv[1]);
            }
    }
};
struct EpiWin {
    static constexpr bool PERM = true, AFTER_DRAIN = false, USES_SSP = true; static constexpr int NST = 8;
    bf16_t* Z; bf16_t* GB; const float* ssp; const PG8_LAS unsigned char* sspl;
    __device__ __forceinline__ void prefetch_phase(PG8_LAS unsigned char*, int, int, int) const {}
    __device__ __forceinline__ void prefetch_next(PG8_LAS unsigned char*, int, int, int, int) const {}
    __device__ __forceinline__ void operator()(const f32x4 (&acc)[2][2][4][2], const Unit& u, int wr, int wc, int fr, int fq, int par) const {
        const int row0 = u.pm * BM + wr * 64 + fr, pn = u.pn;
#pragma unroll
        for (int ai = 0; ai < 2; ++ai)
#pragma unroll
            for (int m = 0; m < 4; ++m) {
                const int row = row0 + ai * HALF + m * 16; const float rs = row_rstd_lds(sspl, row - u.pm * BM);
                if (pn < 8) {
                    const float rs2 = rs * rs;
                    *(u32x4*)(Z + (size_t)row * 1024 + pn * 128 + wc * 32 + 8 * fq) = pack8(acc[ai][0][m][0] * acc[ai][1][m][0] * rs2, acc[ai][0][m][1] * acc[ai][1][m][1] * rs2);
                } else {
                    bf16_t* rowp = GB + (size_t)row * 1024 + (pn - 8) * 256 + wc * 32 + 8 * fq;
#pragma unroll
                    for (int bj = 0; bj < 2; ++bj) *(u32x4*)(rowp + 128 * bj) = pack8(acc[ai][bj][m][0] * rs, acc[ai][bj][m][1] * rs);
                }
            }
    }
};
__device__ __forceinline__ f32x4 bf_lo4(const u32x4 w) { f32x4 r; r[0] = __uint_as_float(w.x << 16); r[1] = __uint_as_float(w.x & 0xffff0000u); r[2] = __uint_as_float(w.y << 16); r[3] = __uint_as_float(w.y & 0xffff0000u); return r; }
__device__ __forceinline__ f32x4 bf_hi4(const u32x4 w) { f32x4 r; r[0] = __uint_as_float(w.z << 16); r[1] = __uint_as_float(w.z & 0xffff0000u); r[2] = __uint_as_float(w.w << 16); r[3] = __uint_as_float(w.w & 0xffff0000u); return r; }
template <int MODE> struct EpiRes {
    static constexpr bool PERM = true, AFTER_DRAIN = false, USES_SSP = false; static constexpr int NST = (MODE == 2) ? 32 : 8;
    const float* x; bf16_t* XB; float* ssp; float* out;
    __device__ __forceinline__ void prefetch_phase(PG8_LAS unsigned char*, int, int, int) const {}
    __device__ __forceinline__ void prefetch_next(PG8_LAS unsigned char*, int, int, int, int) const {}
    __device__ __forceinline__ void operator()(const f32x4 (&acc)[2][2][4][2], const Unit& u, int wr, int wc, int fr, int fq, int par) const {
        const int row0 = u.pm * BM + wr * 64 + fr; const int c0 = u.pn * 256 + wc * 32 + 8 * fq;
#pragma unroll
        for (int ai = 0; ai < 2; ++ai)
#pragma unroll
            for (int m = 0; m < 4; ++m) {
                const int row = row0 + ai * HALF + m * 16; float ss = 0.f;
                f32x4 nv[2][2];
#pragma unroll
                for (int bj = 0; bj < 2; ++bj) {
                    if (MODE == 0) { const float* hp = x + (size_t)row * 1024 + c0 + 128 * bj; nv[bj][0] = *(const f32x4*)hp + acc[ai][bj][m][0]; nv[bj][1] = *(const f32x4*)(hp + 4) + acc[ai][bj][m][1]; }
                    else { const u32x4 hw = *(const u32x4*)(XB + (size_t)row * 1024 + c0 + 128 * bj); nv[bj][0] = bf_lo4(hw) + acc[ai][bj][m][0]; nv[bj][1] = bf_hi4(hw) + acc[ai][bj][m][1]; }
                }
                if (MODE != 2) {
#pragma unroll
                    for (int bj = 0; bj < 2; ++bj) {
                        *(u32x4*)(XB + (size_t)row * 1024 + c0 + 128 * bj) = pack8(nv[bj][0], nv[bj][1]);
#pragma unroll
                        for (int n = 0; n < 2; ++n) { const f32x4 v = nv[bj][n]; ss += (v[0] * v[0] + v[1] * v[1]) + (v[2] * v[2] + v[3] * v[3]); }
                    }
                    ss += __shfl_xor(ss, 16); ss += __shfl_xor(ss, 32);
                    if (fq == 0) ssp[(size_t)row * 16 + 4 * u.pn + wc] = ss;
                } else {
                    float* op = out + (size_t)row * 1024 + c0;
#pragma unroll
                    for (int bj = 0; bj < 2; ++bj) { *(f32x4*)(op + 128 * bj) = nv[bj][0]; *(f32x4*)(op + 128 * bj + 4) = nv[bj][1]; }
                }
            }
    }
};
template <class Epi, class Sched, bool ALIGN_EPI = false, bool SP2 = false>
__device__ __forceinline__ void gemm_phase(PG8_LAS unsigned char* lds, const Gemm g, const Sched& S, const Epi& E, const int wid) {
    const int lane = lane_id_v(), tid = wid * 64 + lane, wr = wid >> 2, wc = wid & 3, fr = lane & 15, fq = lane >> 4;
    const int K = g.K, nt = K / BK;
    unsigned voffA[2], voffB[2];
#pragma unroll
    for (int i = 0; i < 2; ++i) { int R, C; stage_rc(tid * 16 + i * 8192, R, C); const int Rb = Epi::PERM ? ((R & ~31) + perm32(R & 31)) : R;
        voffA[i] = (unsigned)(R * K + C) * 2u; voffB[i] = (unsigned)(Rb * K + C) * 2u; }
    const size_t kstep = (size_t)(BK * 2);
    const size_t hstep = (size_t)HALF * K * 2;
    const size_t tstep = 2 * hstep;
    const unsigned ldsw = (unsigned)wid * 1024u;
    const int aoff = lds_byte(wr * 64 + fr, fq * 8), boff = lds_byte(wc * 32 + fr, fq * 8);
#define PG8_SA(b, h) (((b) * 2 + (h)) * HTB)
#define PG8_SB(b, h) ((4 + (b) * 2 + (h)) * HTB)
#define PG8_STAGE(bufoff, gbase, voff) do { _Pragma("unroll") for (int _i = 0; _i < 2; ++_i) \
        __builtin_amdgcn_global_load_lds((const unsigned*)((const char*)(gbase) + (voff)[_i]), (PG8_LAS unsigned*)(lds + (bufoff) + ldsw + _i * 8192), 16, 0, 0); } while (0)
#define PG8_SSP_DMA(pm_) do { if constexpr (Epi::USES_SSP) { _Pragma("unroll") for (int _i = 0; _i < 2; ++_i) \
        __builtin_amdgcn_global_load_lds((const unsigned*)((const char*)E.ssp + (size_t)(pm_) * (BM * 64) + (size_t)((2 * wid + _i) * 1024) + (unsigned)(lane * 16)), (PG8_LAS unsigned*)(lds + SSPL_OFF + (2 * wid + _i) * 1024), 16, 0, 0); } } while (0)
#define PG8_LDA(dst, b, h) do { _Pragma("unroll") for (int m = 0; m < 4; ++m) _Pragma("unroll") for (int k = 0; k < 2; ++k) dst[m][k] = *(const PG8_LAS bf16x8*)(lds + PG8_SA(b, h) + aoff + m * 2048 + k * 1024); } while (0)
#define PG8_LDB(dst, b, h) do { _Pragma("unroll") for (int n = 0; n < 2; ++n) _Pragma("unroll") for (int k = 0; k < 2; ++k) dst[n][k] = *(const PG8_LAS bf16x8*)(lds + PG8_SB(b, h) + boff + n * 2048 + k * 1024); } while (0)
#define PG8_MMA(ai, bj, At, Bt) do { __builtin_amdgcn_s_setprio(1); _Pragma("unroll") for (int m = 0; m < 4; ++m) _Pragma("unroll") for (int n = 0; n < 2; ++n) _Pragma("unroll") for (int k = 0; k < 2; ++k) \
        acc[ai][bj][m][n] = __builtin_amdgcn_mfma_f32_16x16x32_bf16(Bt[n][k], At[m][k], acc[ai][bj][m][n], 0, 0, 0); __builtin_amdgcn_s_setprio(0); } while (0)
#define PG8_WAIT_V(n) asm volatile("s_waitcnt vmcnt(" #n ")" ::: "memory")
#define PG8_WAIT_L(n) asm volatile("s_waitcnt lgkmcnt(" #n ")" ::: "memory")
#define PG8_BAR __builtin_amdgcn_s_barrier()
#define PG8_SCHED __builtin_amdgcn_sched_barrier(0)
    Unit cur, nxt; int ui = 0;
    if (!S.next(0, cur)) return;
    f32x4 acc[2][2][4][2];
#pragma unroll
    for (int a = 0; a < 2; ++a)
#pragma unroll
        for (int b = 0; b < 2; ++b)
#pragma unroll
            for (int m = 0; m < 4; ++m)
#pragma unroll
                for (int n = 0; n < 2; ++n) acc[a][b][m][n] = (f32x4){0.f, 0.f, 0.f, 0.f};
    bf16x8 At[4][2], B0[2][2], B1[2][2];
    const char* cA = (const char*)g.A + (size_t)cur.pm * tstep; const char* cB = (const char*)g.Bt + (size_t)cur.pn * tstep;
    S.a_ready(cur);
    PG8_SSP_DMA(cur.pm);
    E.prefetch_phase(lds, cur.pm, wid, lane);
    if constexpr (SP2) {
        PG8_STAGE(PG8_SB(0, 0), cB, voffB); PG8_STAGE(PG8_SB(0, 1), cB + hstep, voffB); PG8_STAGE(PG8_SA(0, 0), cA, voffA); PG8_STAGE(PG8_SA(0, 1), cA + hstep, voffA);
        if (wr == 1) PG8_BAR;
        PG8_WAIT_V(2); PG8_BAR;
        PG8_STAGE(PG8_SB(1, 0), cB + kstep, voffB); PG8_STAGE(PG8_SA(1, 0), cA + kstep, voffA); PG8_STAGE(PG8_SB(1, 1), cB + hstep + kstep, voffB);
        PG8_WAIT_V(6); PG8_BAR;
    } else {
        PG8_STAGE(PG8_SB(0, 0), cB, voffB); PG8_STAGE(PG8_SA(0, 0), cA, voffA); PG8_STAGE(PG8_SB(0, 1), cB + hstep, voffB); PG8_STAGE(PG8_SA(0, 1), cA + hstep, voffA);
        if (wr == 1) PG8_BAR;
        PG8_WAIT_V(4); PG8_BAR;
        PG8_STAGE(PG8_SB(1, 0), cB + kstep, voffB); PG8_STAGE(PG8_SA(1, 0), cA + kstep, voffA); PG8_STAGE(PG8_SB(1, 1), cB + hstep + kstep, voffB);
        PG8_WAIT_V(6); PG8_BAR;
    }
    static_assert(SP2, "this build keeps only the two-super-phase loop");
#define PG8_ITER(WV) do { \
            PG8_LDB(B0, 0, 0); PG8_LDB(B1, 0, 1); PG8_SCHED; PG8_LDA(At, 0, 0); PG8_STAGE(PG8_SA(1, 1), a1 + hstep, voffA); \
            WV; PG8_WAIT_L(0); PG8_BAR; PG8_MMA(0, 0, At, B0); PG8_MMA(0, 1, At, B1); PG8_BAR; PG8_SCHED; \
            PG8_LDA(At, 0, 1); PG8_STAGE(PG8_SB(0, 0), b2, voffB); PG8_STAGE(PG8_SB(0, 1), b2 + hstep, voffB); PG8_STAGE(PG8_SA(0, 0), a2, voffA); \
            WV; PG8_WAIT_L(0); PG8_BAR; PG8_MMA(1, 0, At, B0); PG8_MMA(1, 1, At, B1); PG8_BAR; PG8_SCHED; \
            PG8_LDB(B0, 1, 0); PG8_LDB(B1, 1, 1); PG8_SCHED; PG8_LDA(At, 1, 0); PG8_STAGE(PG8_SA(0, 1), a2 + hstep, voffA); \
            PG8_WAIT_V(8); PG8_WAIT_L(0); PG8_BAR; PG8_MMA(0, 0, At, B0); PG8_MMA(0, 1, At, B1); PG8_BAR; PG8_SCHED; \
            PG8_LDA(At, 1, 1); PG8_STAGE(PG8_SB(1, 0), b3, voffB); PG8_STAGE(PG8_SB(1, 1), b3 + hstep, voffB); PG8_STAGE(PG8_SA(1, 0), a3, voffA); \
            PG8_WAIT_V(8); PG8_WAIT_L(0); PG8_BAR; PG8_MMA(1, 0, At, B0); PG8_MMA(1, 1, At, B1); PG8_BAR; PG8_SCHED; } while (0)
#define PG8_WAIT_R asm volatile("s_waitcnt vmcnt(%0)" :: "n"(8 + Epi::NST) : "memory")
#define PG8_ITER_R() do { \
            PG8_LDB(B0, 0, 0); PG8_LDB(B1, 0, 1); PG8_SCHED; PG8_LDA(At, 0, 0); \
            PG8_WAIT_R; PG8_WAIT_L(0); PG8_BAR; PG8_MMA(0, 0, At, B0); PG8_MMA(0, 1, At, B1); PG8_BAR; PG8_SCHED; \
            PG8_SSP_DMA(cur.pm); PG8_SCHED;     \
            PG8_LDA(At, 0, 1); PG8_STAGE(PG8_SB(0, 0), b2, voffB); PG8_STAGE(PG8_SB(0, 1), b2 + hstep, voffB); PG8_STAGE(PG8_SA(0, 0), a2, voffA); \
            PG8_WAIT_R; PG8_WAIT_L(0); PG8_BAR; PG8_MMA(1, 0, At, B0); PG8_MMA(1, 1, At, B1); PG8_BAR; PG8_SCHED; \
            PG8_LDB(B0, 1, 0); PG8_LDB(B1, 1, 1); PG8_SCHED; PG8_LDA(At, 1, 0); PG8_STAGE(PG8_SA(0, 1), a2 + hstep, voffA); \
            PG8_WAIT_R; PG8_WAIT_L(0); PG8_BAR; PG8_MMA(0, 0, At, B0); PG8_MMA(0, 1, At, B1); PG8_BAR; PG8_SCHED; \
            PG8_LDA(At, 1, 1); PG8_STAGE(PG8_SB(1, 0), b3, voffB); PG8_STAGE(PG8_SB(1, 1), b3 + hstep, voffB); PG8_STAGE(PG8_SA(1, 0), a3, voffA); \
            PG8_WAIT_V(8); PG8_WAIT_L(0); PG8_BAR; PG8_MMA(1, 0, At, B0); PG8_MMA(1, 1, At, B1); PG8_BAR; PG8_SCHED; } while (0)
    int t0 = 0;
    for (;;) {
        const bool has_next = S.next(ui + 1, nxt);
        const char* nA = has_next ? (const char*)g.A + (size_t)nxt.pm * tstep : cA; const char* nB = has_next ? (const char*)g.Bt + (size_t)nxt.pn * tstep : cB;
        for (int t = t0; t < nt; t += 2) {
            const bool last = (t == nt - 2);
            const char* a1 = cA + (size_t)(t + 1) * kstep;
            const char* a2 = last ? nA : cA + (size_t)(t + 2) * kstep; const char* b2 = last ? nB : cB + (size_t)(t + 2) * kstep;
            const char* a3 = a2 + kstep; const char* b3 = b2 + kstep;
            if (last && has_next) S.a_ready(nxt);
            PG8_ITER(PG8_WAIT_V(8));
        }
        if constexpr (ALIGN_EPI) { if (wr == 0) PG8_BAR; }
        if (has_next) PG8_STAGE(PG8_SA(1, 1), nA + kstep + hstep, voffA);
        PG8_SCHED;
        if constexpr (!Epi::AFTER_DRAIN) { const int le = lane_id_v(); E(acc, cur, wr, wc, le & 15, le >> 4, ui & 1); if (has_next) E.prefetch_next(lds, nxt.pm, wid, le, (ui + 1) & 1); S.done(cur); }
        PG8_SCHED;
        if (!has_next) break;
#pragma unroll
        for (int a = 0; a < 2; ++a)
#pragma unroll
            for (int b = 0; b < 2; ++b)
#pragma unroll
                for (int m = 0; m < 4; ++m)
#pragma unroll
                    for (int n = 0; n < 2; ++n) acc[a][b][m][n] = (f32x4){0.f, 0.f, 0.f, 0.f};
        cur = nxt; cA = nA; cB = nB; ++ui; t0 = 2;
        if constexpr (ALIGN_EPI) { if (wr == 1) PG8_BAR; }
        PG8_SCHED;
        {
            const char* a1 = cA + kstep; const char* a2 = cA + 2 * kstep; const char* b2 = cB + 2 * kstep; const char* a3 = a2 + kstep; const char* b3 = b2 + kstep;
            (void)a1; PG8_ITER_R();
        }
    }
#undef PG8_ITER
#undef PG8_ITER_R
#undef PG8_WAIT_R
    PG8_WAIT_V(0);
    if constexpr (!ALIGN_EPI) { if (wr == 0) PG8_BAR; }
    PG8_BAR;
    if constexpr (Epi::AFTER_DRAIN) { E.fused(acc, cur, wr, wc, fr, fq, lds, wid, lane); S.done(cur); }
#undef PG8_SA
#undef PG8_SB
#undef PG8_STAGE
#undef PG8_SSP_DMA
#undef PG8_LDA
#undef PG8_LDB
#undef PG8_MMA
#undef PG8_WAIT_V
#undef PG8_WAIT_L
#undef PG8_BAR
#undef PG8_SCHED
}
}
namespace att {
#define LAS __attribute__((address_space(3)))
typedef unsigned short bf16_t;
typedef short bf16x8 __attribute__((ext_vector_type(8)));
typedef short s16x4 __attribute__((ext_vector_type(4)));
typedef float f32x16 __attribute__((ext_vector_type(16)));
typedef float f32x4 __attribute__((ext_vector_type(4)));
typedef unsigned u32x4 __attribute__((ext_vector_type(4)));
constexpr int LP = 2048, PADF = 48, PITCH = 3072;
constexpr int KV_BUF = 32768, V_OFF = 16384, OST_OFF = 65536, OST_PITCH = 272, OST_WAVE = 32 * OST_PITCH, WSF_OFF = OST_OFF + 8 * OST_WAVE, ATT_LDS = WSF_OFF + 8 * 256;
__device__ __forceinline__ int crow(int r, int hi) { return (r & 3) + 8 * (r >> 2) + 4 * hi; }
__device__ __forceinline__ unsigned cvtpk(float lo, float hi) { unsigned r; asm volatile("v_cvt_pk_bf16_f32 %0, %1, %2" : "=v"(r) : "v"(lo), "v"(hi)); return r; }
template <int K> __device__ __forceinline__ float swz_xor(float v) { return __builtin_bit_cast(float, __builtin_amdgcn_ds_swizzle(__builtin_bit_cast(int, v), (K << 10) | 0x1f)); }
__device__ __forceinline__ float xor32(float v) { const int ln = pg8::lane_id_v(); return __builtin_bit_cast(float, __builtin_amdgcn_ds_bpermute((ln ^ 32) << 2, __builtin_bit_cast(int, v))); }
__device__ __forceinline__ s16x4 vtr(const LAS unsigned char* p) { return __builtin_bit_cast(s16x4, __builtin_amdgcn_ds_read_tr16_b64_v4i16((LAS s16x4*)p)); }

__device__ __forceinline__ void stage_tile(LAS unsigned char* lds, int bufoff, const bf16_t* QKV, const bf16_t* MQKV, long rowbase, int h, int t, int wid, int lane) {
    const char* src = (t == 0) ? (const char*)MQKV : (const char*)(QKV + (size_t)(rowbase + 64 * (t - 1)) * PITCH);
    const unsigned voffK = (unsigned)lane * (PITCH * 2), voffV = (unsigned)(lane >> 2) * (PITCH * 2) + (unsigned)(lane & 3) * 16;
#pragma unroll
    for (int i = 0; i < 2; ++i) {
        const int ci = 2 * wid + i;
        const char* ks = src + (size_t)((1024 + h * 128 + ci * 8) * 2);
        __builtin_amdgcn_global_load_lds((const unsigned*)(ks + voffK), (LAS unsigned*)(lds + bufoff + ci * 1024), 16, 0, 0);
    }
#pragma unroll
    for (int i = 0; i < 2; ++i) {
        const int pi = 2 * wid + i, db = pi >> 2, kg = pi & 3;
        const char* vs = src + (size_t)(16 * kg) * (PITCH * 2) + (size_t)((2048 + h * 128 + db * 32) * 2);
        __builtin_amdgcn_global_load_lds((const unsigned*)(vs + voffV), (LAS unsigned*)(lds + bufoff + V_OFF + pi * 1024), 16, 0, 0);
    }
}

template <size_t OFF_QKV, size_t OFF_MQKV, size_t OFF_O> __device__ __forceinline__ void attn_unit(LAS unsigned char* lds, unsigned char* ws, int b, int h, int q0, int nqw, float lam, const float* subg, const int wid) {
    const bf16_t* QKV = (const bf16_t*)(ws + OFF_QKV); const bf16_t* MQKV = (const bf16_t*)(ws + OFF_MQKV); bf16_t* O = (bf16_t*)(ws + OFF_O);
    const int lane = pg8::lane_id_v(), r32 = lane & 31, hi = lane >> 5;
    const long rowbase = (long)b * LP;
    const int NT = (q0 + 32 * nqw) >> 6;
    const bool active = wid < nqw;
    const int qabs = q0 + 32 * wid + r32, qfirst = q0 + 32 * wid, qlast = qfirst + 31;
    LAS unsigned char* qw = lds + OST_OFF + wid * OST_WAVE + lane * 16;
    {
        const char* qb = (const char*)(QKV + (size_t)(rowbase + (active ? qfirst - 64 : 0)) * PITCH + h * 128);
        const bf16_t* qp = (const bf16_t*)(qb + ((unsigned)r32 * (PITCH * 2) + (unsigned)hi * 16));
#pragma unroll
        for (int j = 0; j < 8; ++j) *(LAS bf16x8*)(qw + j * 1024) = *(const bf16x8*)(qp + (j >> 2) * 64 + (j & 3) * 16);
    }
    f32x16 o[2][4];
#pragma unroll
    for (int c = 0; c < 2; ++c)
#pragma unroll
        for (int db = 0; db < 4; ++db)
#pragma unroll
            for (int r = 0; r < 16; ++r) o[c][db][r] = 0.f;
    float lsum[2] = {0.f, 0.f};
    stage_tile(lds, 0, QKV, MQKV, rowbase, h, 0, wid, lane);
    __syncthreads();
    stage_tile(lds, KV_BUF, QKV, MQKV, rowbase, h, 1, wid, lane);
    {   const int buf = 0;
    if (active) {
            const LAS unsigned char* kb = lds + buf + hi * 1024 + r32 * 16;
            const LAS unsigned char* vp = lds + buf + V_OFF + ((lane >> 4) & 1) * 32 + (lane & 3) * 8 + (4 * hi + ((lane & 15) >> 2)) * 64;
            f32x16 sA, sB;
#pragma unroll
            for (int r = 0; r < 16; ++r) { sA[r] = 0.f; sB[r] = 0.f; }
#pragma unroll
            for (int d0 = 0; d0 < 4; ++d0) {
                const bf16x8 ka = *(const LAS bf16x8*)(kb + (2 * d0) * 1024), kbb = *(const LAS bf16x8*)(kb + (8 + 2 * d0) * 1024);
                const bf16x8 qa = *(const LAS bf16x8*)(qw + d0 * 1024), qb = *(const LAS bf16x8*)(qw + (4 + d0) * 1024);
                sA = __builtin_amdgcn_mfma_f32_32x32x16_bf16(ka, qa, sA, 0, 0, 0);
                sB = __builtin_amdgcn_mfma_f32_32x32x16_bf16(kbb, qb, sB, 0, 0, 0);
            }
            float s0 = 0.f, s1 = 0.f;
#pragma unroll
            for (int r = 0; r < 8; ++r) { sA[r] = __builtin_amdgcn_exp2f(sA[r]); sB[r] = __builtin_amdgcn_exp2f(sB[r]); s0 += sA[r]; s1 += sB[r]; }
            lsum[0] += s0; lsum[1] += s1;
            const u32x4 pa = (u32x4){cvtpk(sA[0], sA[1]), cvtpk(sA[2], sA[3]), cvtpk(sA[4], sA[5]), cvtpk(sA[6], sA[7])};
            const u32x4 pb = (u32x4){cvtpk(sB[0], sB[1]), cvtpk(sB[2], sB[3]), cvtpk(sB[4], sB[5]), cvtpk(sB[6], sB[7])};
#pragma unroll
            for (int db = 0; db < 4; ++db) {
                const s16x4 lo_ = vtr(vp + db * 4096), hh_ = vtr(vp + db * 4096 + 512);
                const bf16x8 vf = (bf16x8){lo_[0], lo_[1], lo_[2], lo_[3], hh_[0], hh_[1], hh_[2], hh_[3]};
                o[0][db] = __builtin_amdgcn_mfma_f32_32x32x16_bf16(__builtin_bit_cast(bf16x8, pa), vf, o[0][db], 0, 0, 0);
                o[1][db] = __builtin_amdgcn_mfma_f32_32x32x16_bf16(__builtin_bit_cast(bf16x8, pb), vf, o[1][db], 0, 0, 0);
            }
    }
    }
    for (int t = 1; t < NT; ++t) {
        __syncthreads();
        const int buf = (t & 1) * KV_BUF;
        if (t + 1 < NT) stage_tile(lds, ((t + 1) & 1) * KV_BUF, QKV, MQKV, rowbase, h, t + 1, wid, lane);
        if (active && 64 * t <= qlast) {
            const bool needmask = (64 * t + 63 > qfirst);
            const LAS unsigned char* kb = lds + buf + hi * 1024 + r32 * 16;
            const LAS unsigned char* vp = lds + buf + V_OFF + ((lane >> 4) & 1) * 32 + (lane & 3) * 8 + (4 * hi + ((lane & 15) >> 2)) * 64;
            f32x16 sA0, sA1, sB0, sB1;
#pragma unroll
            for (int r = 0; r < 16; ++r) { sA0[r] = 0.f; sA1[r] = 0.f; sB0[r] = 0.f; sB1[r] = 0.f; }
            {
                bf16x8 fk0[3], fk1[3], fq_[3];
#define QK_LOAD(s_) do { fk0[(s_) % 3] = *(const LAS bf16x8*)(kb + (8 * ((s_) >> 2) + 2 * ((s_) & 3)) * 1024); fk1[(s_) % 3] = *(const LAS bf16x8*)(kb + (8 * ((s_) >> 2) + 2 * ((s_) & 3)) * 1024 + 512); \
                                 fq_[(s_) % 3] = *(const LAS bf16x8*)(qw + (s_) * 1024); } while (0)
                QK_LOAD(0); QK_LOAD(1);
                __builtin_amdgcn_sched_barrier(0);
#pragma unroll
                for (int s_ = 0; s_ < 8; ++s_) {
                    if (s_ + 2 < 8) QK_LOAD(s_ + 2);
                    if (s_ < 4) { sA0 = __builtin_amdgcn_mfma_f32_32x32x16_bf16(fk0[s_ % 3], fq_[s_ % 3], sA0, 0, 0, 0); sA1 = __builtin_amdgcn_mfma_f32_32x32x16_bf16(fk1[s_ % 3], fq_[s_ % 3], sA1, 0, 0, 0); }
                    else        { sB0 = __builtin_amdgcn_mfma_f32_32x32x16_bf16(fk0[s_ % 3], fq_[s_ % 3], sB0, 0, 0, 0); sB1 = __builtin_amdgcn_mfma_f32_32x32x16_bf16(fk1[s_ % 3], fq_[s_ % 3], sB1, 0, 0, 0); }
                    __builtin_amdgcn_sched_barrier(0);
                }
#undef QK_LOAD
            }
#define MASK1(P, R, LIM, OP, ADD) asm volatile("s_nop 0\n\t" OP " vcc, %2, %1\n\tv_cndmask_b32_e32 %0, 0, %0, vcc" : "+v"(P[R]) : "v"(LIM), "n"(((R) & 3) + 8 * ((R) >> 2) + (ADD)) : "vcc")
#define MASK16(P0, P1, LIM, OP) do { \
    MASK1(P0, 0, LIM, OP, 0); MASK1(P0, 1, LIM, OP, 0); MASK1(P0, 2, LIM, OP, 0); MASK1(P0, 3, LIM, OP, 0); MASK1(P0, 4, LIM, OP, 0); MASK1(P0, 5, LIM, OP, 0); MASK1(P0, 6, LIM, OP, 0); MASK1(P0, 7, LIM, OP, 0); \
    MASK1(P0, 8, LIM, OP, 0); MASK1(P0, 9, LIM, OP, 0); MASK1(P0, 10, LIM, OP, 0); MASK1(P0, 11, LIM, OP, 0); MASK1(P0, 12, LIM, OP, 0); MASK1(P0, 13, LIM, OP, 0); MASK1(P0, 14, LIM, OP, 0); MASK1(P0, 15, LIM, OP, 0); \
    MASK1(P1, 0, LIM, OP, 32); MASK1(P1, 1, LIM, OP, 32); MASK1(P1, 2, LIM, OP, 32); MASK1(P1, 3, LIM, OP, 32); MASK1(P1, 4, LIM, OP, 32); MASK1(P1, 5, LIM, OP, 32); MASK1(P1, 6, LIM, OP, 32); MASK1(P1, 7, LIM, OP, 32); \
    MASK1(P1, 8, LIM, OP, 32); MASK1(P1, 9, LIM, OP, 32); MASK1(P1, 10, LIM, OP, 32); MASK1(P1, 11, LIM, OP, 32); MASK1(P1, 12, LIM, OP, 32); MASK1(P1, 13, LIM, OP, 32); MASK1(P1, 14, LIM, OP, 32); MASK1(P1, 15, LIM, OP, 32); } while (0)
#define ATT_SOFTMAX(P0, P1, C, PW) do { \
                _Pragma("unroll") for (int r = 0; r < 16; ++r) { P0[r] = __builtin_amdgcn_exp2f(P0[r]); P1[r] = __builtin_amdgcn_exp2f(P1[r]); } \
                if (needmask) {        \
                    int mhi = qabs - 64 * t - 4 * hi; asm volatile("" : "+v"(mhi)); \
                    MASK16(P0, P1, mhi, "v_cmp_le_i32_e32"); \
                } \
                float s_ = 0.f; \
                _Pragma("unroll") for (int r = 0; r < 16; ++r) s_ += P0[r] + P1[r]; \
                lsum[C] += s_; \
                PW[0] = (u32x4){cvtpk(P0[0], P0[1]), cvtpk(P0[2], P0[3]), cvtpk(P0[4], P0[5]), cvtpk(P0[6], P0[7])}; \
                PW[1] = (u32x4){cvtpk(P0[8], P0[9]), cvtpk(P0[10], P0[11]), cvtpk(P0[12], P0[13]), cvtpk(P0[14], P0[15])}; \
                PW[2] = (u32x4){cvtpk(P1[0], P1[1]), cvtpk(P1[2], P1[3]), cvtpk(P1[4], P1[5]), cvtpk(P1[6], P1[7])}; \
                PW[3] = (u32x4){cvtpk(P1[8], P1[9]), cvtpk(P1[10], P1[11]), cvtpk(P1[12], P1[13]), cvtpk(P1[14], P1[15])}; } while (0)
            u32x4 pwA[4], pwB[4];
            ATT_SOFTMAX(sA0, sA1, 0, pwA);
            __builtin_amdgcn_sched_barrier(0);
            ATT_SOFTMAX(sB0, sB1, 1, pwB);
            __builtin_amdgcn_sched_barrier(0);
            {
                bf16x8 vr[4];
#define V_LOAD(i_) do { const s16x4 lo_ = vtr(vp + ((i_) & 3) * 4096 + ((i_) >> 2) * 1024), hh_ = vtr(vp + ((i_) & 3) * 4096 + ((i_) >> 2) * 1024 + 512); \
                                vr[(i_) & 3] = (bf16x8){lo_[0], lo_[1], lo_[2], lo_[3], hh_[0], hh_[1], hh_[2], hh_[3]}; } while (0)
                V_LOAD(0); V_LOAD(1); V_LOAD(2);
                __builtin_amdgcn_sched_barrier(0);
#pragma unroll
                for (int i_ = 0; i_ < 16; ++i_) {
                    if (i_ + 3 < 16) V_LOAD(i_ + 3);
                    o[0][i_ & 3] = __builtin_amdgcn_mfma_f32_32x32x16_bf16(__builtin_bit_cast(bf16x8, pwA[i_ >> 2]), vr[i_ & 3], o[0][i_ & 3], 0, 0, 0);
                    o[1][i_ & 3] = __builtin_amdgcn_mfma_f32_32x32x16_bf16(__builtin_bit_cast(bf16x8, pwB[i_ >> 2]), vr[i_ & 3], o[1][i_ & 3], 0, 0, 0);
                    __builtin_amdgcn_sched_barrier(0);
                }
#undef V_LOAD
            }
#undef ATT_SOFTMAX
#undef MASK1
#undef MASK16
        }
    }
    if (active) {
        const int lane_e = pg8::lane_id_v(), r32 = lane_e & 31, hi = lane_e >> 5;
        float l0 = lsum[0], l1 = lsum[1];
        l0 += xor32(l0); l1 += xor32(l1);
        LAS float* wsf = (LAS float*)(lds + WSF_OFF) + wid * 64;
        if (hi == 0) { wsf[r32] = l0; wsf[32 + r32] = l1; }
        asm volatile("s_waitcnt lgkmcnt(0)" ::: "memory");
#pragma unroll
        for (int r = 0; r < 16; ++r) { const float a0 = wsf[crow(r, hi)], a1 = wsf[32 + crow(r, hi)];
            const float rl0 = a0 > 0.f ? __builtin_amdgcn_rcpf(a0) : 0.f, rl1 = a1 > 0.f ? lam * __builtin_amdgcn_rcpf(a1) : 0.f; float s = 0.f;
#pragma unroll
            for (int db = 0; db < 4; ++db) { const float v = o[0][db][r] * rl0 - o[1][db][r] * rl1; o[0][db][r] = v; s += v * v; }
            s += swz_xor<1>(s); s += swz_xor<2>(s); s += swz_xor<4>(s); s += swz_xor<8>(s); s += swz_xor<16>(s);
            const float rn = rsqrtf(s * (1.0f / 128.0f) + 1e-6f) * 0.8f;
#pragma unroll
            for (int db = 0; db < 4; ++db) o[0][db][r] *= rn; }
        LAS unsigned short* stg = (LAS unsigned short*)(lds + OST_OFF + wid * OST_WAVE);
#pragma unroll
        for (int db = 0; db < 4; ++db) { const float sg = subg[db * 32 + r32];
#pragma unroll
            for (int r = 0; r < 16; ++r) { const unsigned w = cvtpk(o[0][db][r] * sg, 0.f); stg[crow(r, hi) * (OST_PITCH / 2) + db * 32 + r32] = (unsigned short)(w & 0xffffu); } }
        asm volatile("s_waitcnt lgkmcnt(0)" ::: "memory");
        int lsel = lane_e;
        bf16_t* Ow = O + (size_t)(rowbase + qfirst - 64 + (lsel >> 4)) * 1024 + h * 128 + (lsel & 15) * 8;
        const LAS unsigned char* sp = (const LAS unsigned char*)stg + (lsel >> 4) * OST_PITCH + (lsel & 15) * 16;
#pragma unroll
        for (int it = 0; it < 8; ++it) { const u32x4 v = *(const LAS u32x4*)(sp + it * 4 * OST_PITCH); *(u32x4*)Ow = v; Ow += 4 * 1024; asm volatile("" : "+v"(Ow)); }
    }
    __syncthreads();
}
}
typedef unsigned short bf16;
typedef unsigned v4u __attribute__((ext_vector_type(4)));
typedef float f32x4 __attribute__((ext_vector_type(4)));
typedef short bf16x8 __attribute__((ext_vector_type(8)));
constexpr int NWAVES = 8;
#ifndef MK_PER_PHASE
#define MK_PER_PHASE 0
#endif
constexpr int NPHASE = 13;
#ifndef PROBE_DUP
#define PROBE_DUP -1
#endif
#define REPS(k) for (int rep_ = 0; rep_ < ((PROBE_DUP) == (k) ? 2 : 1); ++rep_)
constexpr int D = 1024, NB = 32, SEQ = 2048, LTOK = 2064, NMETA = 16, LP = 2048, MP = NB * LP;
constexpr int NQKV = 3072, DFF = 2816, NGU = 5632;
constexpr size_t al256(size_t x) { return (x + 255) & ~(size_t)255; }
constexpr size_t WS_WQKV = 0;
constexpr size_t WS_WO   = WS_WQKV + (size_t)NQKV * D * 2;
constexpr size_t WS_WGU0 = WS_WO + (size_t)D * D * 2;
constexpr size_t WS_WD0  = WS_WGU0 + (size_t)NGU * D * 2;
constexpr size_t WS_WIN  = WS_WD0 + (size_t)D * DFF * 2;
constexpr size_t WS_WOUT = WS_WIN + (size_t)NQKV * D * 2;
constexpr size_t WS_WGU1 = WS_WOUT + (size_t)D * D * 2;
constexpr size_t WS_WD1  = WS_WGU1 + (size_t)NGU * D * 2;
constexpr size_t WS_ROPE = WS_WD1 + (size_t)D * DFF * 2;
constexpr size_t WS_SSP  = WS_ROPE + al256((size_t)LTOK * 32 * 2 * 4);
constexpr size_t WS_H    = WS_SSP + (size_t)MP * 16 * 4;
constexpr size_t WS_XB   = WS_H;
constexpr size_t WS_BIG  = WS_XB + (size_t)MP * D * 2;
constexpr size_t WS_O    = WS_BIG + (size_t)MP * NQKV * 2;
constexpr size_t WS_MXB  = WS_O + (size_t)MP * D * 2;
constexpr size_t WS_MRS  = WS_MXB + 16 * 1024 * 2;
constexpr size_t WS_MC1  = WS_MRS + 256;
constexpr size_t WS_MQKV = WS_MC1 + 16 * 3072 * 4;
constexpr size_t WS_MOM  = WS_MQKV + 64 * 3072 * 2;
constexpr size_t WS_MC2  = WS_MOM + 16 * 1024 * 2;
constexpr size_t WS_MC3  = WS_MC2 + 16 * 1024 * 4;
constexpr size_t WS_MH1  = WS_MC3 + 16 * 5632 * 4;
constexpr size_t WS_MHID = WS_MH1 + 16 * 1024 * 4;
constexpr size_t WS_MC4  = WS_MHID + 16 * 2816 * 2;
constexpr size_t WS_MC5  = WS_MC4 + 16 * 1024 * 4;
constexpr size_t WS_MZ   = WS_MC5 + 16 * 2048 * 4;
constexpr size_t WS_RS0  = WS_MZ + 16 * 1024 * 2;
constexpr size_t WS_CTL  = WS_RS0 + (size_t)MP * 4;
constexpr size_t CTL_BYTES = 16384;
constexpr size_t WS_END  = WS_CTL + CTL_BYTES;
constexpr int LDS_BYTES = 149504;
static_assert(att::ATT_LDS <= LDS_BYTES && pg8::STAGE_BYTES <= LDS_BYTES, "LDS map");

__device__ __forceinline__ unsigned f2bf(float f) { unsigned u = __builtin_bit_cast(unsigned, f); return (u + 0x7fffu + ((u >> 16) & 1u)) >> 16; }
__device__ __forceinline__ unsigned pk2(float lo, float hi) { return f2bf(lo) | (f2bf(hi) << 16); }
__device__ __forceinline__ float wave_sum(float v) {
#pragma unroll
    for (int o = 1; o < 64; o <<= 1) v += __shfl_xor(v, o);
    return v;
}
__device__ __forceinline__ float wave_max(float v) {
#pragma unroll
    for (int o = 1; o < 64; o <<= 1) v = fmaxf(v, __shfl_xor(v, o));
    return v;
}
__device__ __forceinline__ int col_perm(int mode, int n) {
    if (mode == 1) return (n & ~255) + 128 * ((n >> 5) & 1) + 32 * ((n >> 6) & 3) + (n & 31);
    if (mode == 2) { const int up = n >= DFF ? 1 : 0, j = n - up * DFF; return 256 * (j >> 7) + 128 * up + (j & 127); }
    if (mode == 3) { if (n < 1024) return 2048 + n; const int up = n >= 2048 ? 1 : 0, j = (n - 1024) & 1023; return 256 * (j >> 7) + 128 * up + (j & 127); }
    return n;
}
__device__ __forceinline__ void transpose_item(const float* W, int K, int N, bf16* WT, const float* gain, int mode, LAS float* scr, int item, int lane) {
    const int nblk = N / 32, kb = item / nblk, nb = item % nblk, k0 = 64 * kb, n0 = 32 * nb;
#pragma unroll 8
    for (int i = 0; i < 32; ++i) { const int kk = 2 * i + (lane >> 5); scr[kk * 33 + (lane & 31)] = W[(size_t)(k0 + kk) * N + n0 + (lane & 31)]; }
    asm volatile("s_waitcnt lgkmcnt(0)" ::: "memory");
    const int c = lane & 7;
    float gv[8];
#pragma unroll
    for (int e = 0; e < 8; ++e) gv[e] = gain ? gain[k0 + 8 * c + e] : 1.0f;
#pragma unroll
    for (int j = 0; j < 4; ++j) { const int n = (lane >> 3) + 8 * j; const LAS float* s = scr + (8 * c) * 33 + n;
        v4u o; o.x = pk2(s[0 * 33] * gv[0], s[1 * 33] * gv[1]); o.y = pk2(s[2 * 33] * gv[2], s[3 * 33] * gv[3]); o.z = pk2(s[4 * 33] * gv[4], s[5 * 33] * gv[5]); o.w = pk2(s[6 * 33] * gv[6], s[7 * 33] * gv[7]);
        *(v4u*)(WT + (size_t)col_perm(mode, n0 + n) * K + k0 + 8 * c) = o; }
    asm volatile("s_waitcnt lgkmcnt(0)" ::: "memory");
}
__device__ __forceinline__ void sincos_acc(float angf, float& c, float& s) {
    const double TWO_PI = 6.283185307179586476925286766559;
    double a = (double)angf; const double n = rint(a / TWO_PI); double r = a - n * TWO_PI;
    const double r2 = r * r; double cs = 1.0, sn = r, tc = 1.0, ts = r;
#pragma unroll 1
    for (int k = 1; k <= 14; ++k) { tc = -tc * r2 / (double)((2 * k - 1) * (2 * k)); ts = -ts * r2 / (double)((2 * k) * (2 * k + 1)); cs += tc; sn += ts; }
    c = (float)cs; s = (float)sn;
}

#define XB_TMO      128
#define XB_XCNT(j)  (256  + 64 * (j))
#define XB_XSUB(j)  (1280 + 64 * (j))
#define XB_XGEN(j)  (2304 + 64 * (j))
#define XB_TOP      3328
#define XB_TOPGEN   3392
#define XCD_BAR_WORDS 3456
#define XB_SPIN_CAP (1u << 18)

__device__ __forceinline__ unsigned xb_ld(unsigned* p)              { return __hip_atomic_load(p, __ATOMIC_RELAXED, __HIP_MEMORY_SCOPE_AGENT); }
__device__ __forceinline__ unsigned xb_add(unsigned* p, unsigned v) { return __hip_atomic_fetch_add(p, v, __ATOMIC_RELAXED, __HIP_MEMORY_SCOPE_AGENT); }
__device__ __forceinline__ unsigned xb_xcc_id() { return (unsigned)__builtin_amdgcn_s_getreg((3 << 11) | 20) & 0xFu; }
#define XB_SPIN(cond, bar) do { unsigned _sp = 0; while (cond) { __builtin_amdgcn_s_sleep(1); \
    if ((++_sp & 255u) == 0u) { if (xb_ld(&(bar)[XB_TMO])) break; if (_sp > XB_SPIN_CAP) { atomicAdd(&(bar)[XB_TMO], 1u); break; } } } } while (0)

struct XcdBarrier {
    unsigned* bar; unsigned x;
    volatile LAS unsigned* st;
};

__device__ __forceinline__ XcdBarrier xcd_barrier_post(unsigned* bar, volatile LAS unsigned* st) {
    XcdBarrier b; b.bar = bar; b.x = xb_xcc_id(); b.st = st;
    if (threadIdx.x == 0) (void)xb_add(&bar[XB_XCNT(b.x)], 1u);
    return b;
}
__device__ __forceinline__ void xcd_barrier_complete(unsigned* bar, unsigned x, unsigned& nloc, unsigned& nx) {
    const unsigned G = gridDim.x * gridDim.y * gridDim.z;
    unsigned sum, cnt, mine, sp = 0u;
    for (;;) {
        sum = 0u; cnt = 0u; mine = 0u;
#pragma unroll
        for (unsigned j = 0; j < 16; ++j) { const unsigned c = xb_ld(&bar[XB_XCNT(j)]); sum += c; cnt += (c > 0u) ? 1u : 0u; mine = (j == x) ? c : mine; }
        if (sum == G) break;
        __builtin_amdgcn_s_sleep(1);
        if ((++sp & 255u) == 0u) { if (xb_ld(&bar[XB_TMO])) break; if (sp > XB_SPIN_CAP) { atomicAdd(&bar[XB_TMO], 1u); break; } }
    }
    nloc = mine > 0u ? mine : 1u; nx = cnt > 0u ? cnt : 1u;
}

__device__ __forceinline__ void xcd_barrier(const XcdBarrier& b) {
    asm volatile("s_waitcnt vmcnt(0)" ::: "memory");
    __syncthreads();
    if (threadIdx.x == 0) {
        unsigned* bar = b.bar;
        __builtin_amdgcn_s_waitcnt(0);
        unsigned nloc = b.st[0], nx = b.st[1];
        if (nloc == 0u) { xcd_barrier_complete(bar, b.x, nloc, nx); b.st[0] = nloc; b.st[1] = nx; }
        const unsigned old = xb_add(&bar[XB_XSUB(b.x)], 1u);
        const unsigned gen = old / nloc;
        if (old + 1u == (gen + 1u) * nloc) {
            __builtin_amdgcn_fence(__ATOMIC_RELEASE, "agent");
            asm volatile("s_waitcnt vmcnt(0)" ::: "memory");
            const unsigned og = xb_add(&bar[XB_TOP], 1u);
            const unsigned tg = og / nx;
            if (og + 1u == (tg + 1u) * nx) xb_add(&bar[XB_TOPGEN], 1u);
            else XB_SPIN(xb_ld(&bar[XB_TOPGEN]) == tg, bar);
            __builtin_amdgcn_fence(__ATOMIC_ACQUIRE, "agent");
            xb_add(&bar[XB_XGEN(b.x)], 1u);
            asm volatile("s_waitcnt vmcnt(0)" ::: "memory");
        } else {
            XB_SPIN(xb_ld(&bar[XB_XGEN(b.x)]) == gen, bar);
            __builtin_amdgcn_fence(__ATOMIC_ACQUIRE, "agent");
            asm volatile("s_waitcnt vmcnt(0)" ::: "memory");
        }
    }
    __syncthreads();
}

constexpr int MISC_OFF = LDS_BYTES - 64;
struct Args { const float* in[18]; float* out; unsigned char* ws; int ph_lo, ph_hi; };

__device__ __forceinline__ void weight_items(const Args& a, LAS unsigned char* lds, int wave, int lane, int gw, int NGW, int it_lo, int it_hi) {
    unsigned char* ws = a.ws;
    LAS float* scr = (LAS float*)(lds + wave * 16384);
    const float* mix_g = a.in[2]; const float* ffn_g = a.in[3];
    constexpr int I_QKV = (D / 64) * (NQKV / 32), I_O = (D / 64) * (D / 32), I_GU = (D / 64) * (NGU / 32), I_DN = (DFF / 64) * (D / 32);
    for (int it = it_lo + gw; it < it_hi; it += NGW) {
        int r = it;
        if (r < I_QKV) { transpose_item(a.in[4], D, NQKV, (bf16*)(ws + WS_WQKV), mix_g, 1, scr, r, lane); continue; } r -= I_QKV;
        if (r < I_O)   { transpose_item(a.in[12], D, D, (bf16*)(ws + WS_WO), nullptr, 0, scr, r, lane); continue; } r -= I_O;
        if (r < I_GU)  { transpose_item(a.in[16], D, NGU, (bf16*)(ws + WS_WGU0), ffn_g, 2, scr, r, lane); continue; } r -= I_GU;
        if (r < I_DN)  { transpose_item(a.in[17], DFF, D, (bf16*)(ws + WS_WD0), nullptr, 0, scr, r, lane); continue; } r -= I_DN;
        if (r < I_QKV) { transpose_item(a.in[13], D, NQKV, (bf16*)(ws + WS_WIN), mix_g + D, 3, scr, r, lane); continue; } r -= I_QKV;
        if (r < I_O)   { transpose_item(a.in[15], D, D, (bf16*)(ws + WS_WOUT), nullptr, 0, scr, r, lane); continue; } r -= I_O;
        if (r < I_GU)  { transpose_item(a.in[16] + (size_t)D * NGU, D, NGU, (bf16*)(ws + WS_WGU1), ffn_g + D, 2, scr, r, lane); continue; } r -= I_GU;
        transpose_item(a.in[17] + (size_t)DFF * D, DFF, D, (bf16*)(ws + WS_WD1), nullptr, 0, scr, r, lane);
    }
}
constexpr int W_ITEMS_L0 = (D / 64) * (NQKV / 32) + (D / 64) * (D / 32) + (D / 64) * (NGU / 32) + (DFF / 64) * (D / 32), W_ITEMS = 2 * W_ITEMS_L0;
__device__ __forceinline__ void prologue(const Args& a, LAS unsigned char* lds, int wave, int lane, int gw, int NGW) {
    unsigned char* ws = a.ws;
    weight_items(a, lds, wave, lane, gw, NGW, 0, W_ITEMS_L0);
    { float* rope = (float*)(ws + WS_ROPE);
      for (int e = gw * 64 + lane; e < LTOK * 32; e += NGW * 64) { const int pos = e >> 5, i = e & 31;
          const float inv = (float)exp(-9.210340371976184 * (double)(2 * i) / 64.0);
          const float ang = (float)pos * inv; float c, s; sincos_acc(ang, c, s); rope[2 * e] = c; rope[2 * e + 1] = s; } }
    { const float* x = a.in[0]; bf16* XB = (bf16*)(ws + WS_XB); float* rs0 = (float*)(ws + WS_RS0);
      for (int m = gw; m < MP; m += NGW) {
          const float* src = x + (size_t)m * D;
          f32x4 v[4]; float s = 0.f;
#pragma unroll
          for (int j = 0; j < 4; ++j) { v[j] = *((const f32x4*)src + 64 * j + lane); s += (v[j][0] * v[j][0] + v[j][1] * v[j][1]) + (v[j][2] * v[j][2] + v[j][3] * v[j][3]); }
          s = wave_sum(s);
#pragma unroll
          for (int j = 0; j < 4; ++j) *((unsigned long long*)(XB + (size_t)m * D) + 64 * j + lane) = (unsigned long long)pk2(v[j][0], v[j][1]) | ((unsigned long long)pk2(v[j][2], v[j][3]) << 32);
          if (lane == 0) rs0[m] = s; } }
    { const float* meta = a.in[1]; bf16* MXB = (bf16*)(ws + WS_MXB); float* mrs = (float*)(ws + WS_MRS);
      if (gw < NMETA) { const int m = gw; const float* src = meta + (size_t)m * D; f32x4 v[4]; float s = 0.f;
#pragma unroll
          for (int j = 0; j < 4; ++j) { v[j] = *((const f32x4*)src + 64 * j + lane); s += (v[j][0] * v[j][0] + v[j][1] * v[j][1]) + (v[j][2] * v[j][2] + v[j][3] * v[j][3]); }
          s = wave_sum(s);
#pragma unroll
          for (int j = 0; j < 4; ++j) *((unsigned long long*)(MXB + (size_t)m * D) + 64 * j + lane) = (unsigned long long)pk2(v[j][0], v[j][1]) | ((unsigned long long)pk2(v[j][2], v[j][3]) << 32);
          if (lane == 0) mrs[m] = s; }
      v4u* mz = (v4u*)(ws + WS_MQKV + 16 * 3072 * 2);
      for (int e = gw * 64 + lane; e < 48 * 3072 * 2 / 16; e += NGW * 64) mz[e] = (v4u){0u, 0u, 0u, 0u};
      for (int e = gw * 64 + lane; e < 16 * 3072 / 4; e += NGW * 64) ((v4u*)(ws + WS_MC1))[e] = (v4u){0u, 0u, 0u, 0u};
      for (int e = gw * 64 + lane; e < 16 * 1024 / 4; e += NGW * 64) { ((v4u*)(ws + WS_MC2))[e] = (v4u){0u, 0u, 0u, 0u}; ((v4u*)(ws + WS_MC4))[e] = (v4u){0u, 0u, 0u, 0u}; }
      for (int e = gw * 64 + lane; e < 16 * 5632 / 4; e += NGW * 64) ((v4u*)(ws + WS_MC3))[e] = (v4u){0u, 0u, 0u, 0u};
      for (int e = gw * 64 + lane; e < 16 * 2048 / 4; e += NGW * 64) ((v4u*)(ws + WS_MC5))[e] = (v4u){0u, 0u, 0u, 0u}; }
}
constexpr int SK_KS = 8;
template <int AMODE> __device__ __forceinline__ void skinny_gemm(const bf16* A, const float* P, const float* Q, int K, const bf16* Bt, int mode, int n_src0, int ntiles, float* C, int ldc, int gwp, int NGW, int lane) {
    const int fr = lane & 15, fq = lane >> 4, kslice = K / SK_KS;
    for (int task = gwp; task < ntiles * SK_KS; task += NGW) {
        const int tile = task / SK_KS, k0 = (task % SK_KS) * kslice;
        const bf16* bp = Bt + (size_t)col_perm(mode, n_src0 + tile * 16 + fr) * K + 8 * fq;
        f32x4 acc = {0.f, 0.f, 0.f, 0.f};
#pragma unroll 4
        for (int kk = k0; kk < k0 + kslice; kk += 32) {
            bf16x8 av;
            if (AMODE == 0) av = *(const bf16x8*)(A + (size_t)fr * K + kk + 8 * fq);
            else { const float* pp = P + (size_t)fr * K + kk + 8 * fq; const float* qq = Q + (size_t)fr * K + kk + 8 * fq;
                const f32x4 p0 = *(const f32x4*)pp, p1 = *(const f32x4*)(pp + 4), q0 = *(const f32x4*)qq, q1 = *(const f32x4*)(qq + 4);
                v4u t; t.x = pk2(p0[0] + q0[0], p0[1] + q0[1]); t.y = pk2(p0[2] + q0[2], p0[3] + q0[3]); t.z = pk2(p1[0] + q1[0], p1[1] + q1[1]); t.w = pk2(p1[2] + q1[2], p1[3] + q1[3]);
                av = __builtin_bit_cast(bf16x8, t); }
            const bf16x8 bv = *(const bf16x8*)(bp + kk);
            acc = __builtin_amdgcn_mfma_f32_16x16x32_bf16(av, bv, acc, 0, 0, 0);
        }
#pragma unroll
        for (int j = 0; j < 4; ++j) __hip_atomic_fetch_add(C + (size_t)(4 * fq + j) * ldc + tile * 16 + fr, acc[j], __ATOMIC_RELAXED, __HIP_MEMORY_SCOPE_AGENT);
    }
}
__device__ __forceinline__ void meta_e1(const Args& a, LAS unsigned char* lds, int wave, int lane, int h, int r) {
    unsigned char* ws = a.ws;
    const float* C1 = (const float*)(ws + WS_MC1); const float* mrs = (const float*)(ws + WS_MRS); const float* rope = (const float*)(ws + WS_ROPE);
    bf16* MQ = (bf16*)(ws + WS_MQKV); bf16* OM = (bf16*)(ws + WS_MOM);
    const float* qg = a.in[5]; const float* kg = a.in[6]; const float* subg = a.in[11];
    const float lam = expf(wave_sum(a.in[7][lane] * a.in[8][lane])) - expf(wave_sum(a.in[9][lane] * a.in[10][lane])) + 0.2f;
    LAS float* kl = (LAS float*)(lds + wave * 16384);
    LAS float* vl = kl + 2048;
    const int i = lane & 31; const float kgl = kg[lane];
#pragma unroll 4
    for (int rp = 0; rp <= r; ++rp) {
        const float rs = rsqrtf(mrs[rp] * (1.0f / 1024.0f) + 1e-6f);
        const float cs = rope[(rp * 32 + i) * 2], sn = rope[(rp * 32 + i) * 2 + 1];
#pragma unroll
        for (int c = 0; c < 2; ++c) {
            float x = C1[(size_t)rp * 3072 + 1024 + h * 128 + c * 64 + lane] * rs;
            const float ss = wave_sum(x * x); x = x * rsqrtf(ss * (1.0f / 64.0f) + 1e-6f) * kgl;
            const float pr = __shfl_xor(x, 32); const float o = lane < 32 ? x * cs - pr * sn : x * cs + pr * sn;
            kl[(c * 16 + rp) * 64 + lane] = o;
            if (rp == r) MQ[(size_t)r * 3072 + 1024 + h * 128 + c * 64 + lane] = (bf16)f2bf(o);
        }
#pragma unroll
        for (int hf = 0; hf < 2; ++hf) { const float v = C1[(size_t)rp * 3072 + 2048 + h * 128 + hf * 64 + lane] * rs; vl[rp * 128 + hf * 64 + lane] = v;
            if (rp == r) MQ[(size_t)r * 3072 + 2048 + h * 128 + hf * 64 + lane] = (bf16)f2bf(v); }
    }
    asm volatile("s_waitcnt lgkmcnt(0)" ::: "memory");
    {
        const float rs = rsqrtf(mrs[r] * (1.0f / 1024.0f) + 1e-6f);
        const float cs = rope[(r * 32 + i) * 2], sn = rope[(r * 32 + i) * 2 + 1];
        float q0, q1;
        { float x = C1[(size_t)r * 3072 + h * 128 + lane] * rs; const float ss = wave_sum(x * x); x = x * rsqrtf(ss * (1.0f / 64.0f) + 1e-6f) * qg[lane];
          const float pr = __shfl_xor(x, 32); q0 = (lane < 32 ? x * cs - pr * sn : x * cs + pr * sn) * pg8::QSCALE_; }
        { float x = C1[(size_t)r * 3072 + h * 128 + 64 + lane] * rs; const float ss = wave_sum(x * x); x = x * rsqrtf(ss * (1.0f / 64.0f) + 1e-6f) * qg[lane];
          const float pr = __shfl_xor(x, 32); q1 = (lane < 32 ? x * cs - pr * sn : x * cs + pr * sn) * pg8::QSCALE_; }
        float l0 = 0.f, l1 = 0.f, o0a = 0.f, o0b = 0.f, o1a = 0.f, o1b = 0.f;
#pragma unroll 4
        for (int rp = 0; rp <= r; ++rp) {
            const float s0 = wave_sum(q0 * kl[rp * 64 + lane]), s1 = wave_sum(q1 * kl[(16 + rp) * 64 + lane]);
            const float p0 = __builtin_amdgcn_exp2f(s0), p1 = __builtin_amdgcn_exp2f(s1); l0 += p0; l1 += p1;
            const float va = vl[rp * 128 + lane], vb = vl[rp * 128 + 64 + lane];
            o0a += p0 * va; o0b += p0 * vb; o1a += p1 * va; o1b += p1 * vb;
        }
        const float oa = o0a / l0 - lam * o1a / l1, ob = o0b / l0 - lam * o1b / l1;
        const float rn = rsqrtf(wave_sum(oa * oa + ob * ob) * (1.0f / 128.0f) + 1e-6f) * 0.8f;
        OM[(size_t)r * 1024 + h * 128 + lane] = (bf16)f2bf(oa * rn * subg[lane]); OM[(size_t)r * 1024 + h * 128 + 64 + lane] = (bf16)f2bf(ob * rn * subg[64 + lane]);
    }
    asm volatile("s_waitcnt lgkmcnt(0)" ::: "memory");
}
__device__ __forceinline__ void meta_e3(const Args& a, int gwp, int NGW, int lane) {
    unsigned char* ws = a.ws; const float* meta = a.in[1]; const float* C2 = (const float*)(ws + WS_MC2); float* H1 = (float*)(ws + WS_MH1);
    const float* C3 = (const float*)(ws + WS_MC3); bf16* HID = (bf16*)(ws + WS_MHID);
    for (int task = gwp; task < 16 * (DFF / 64); task += NGW) { const int r = task / (DFF / 64), ch = task - r * (DFF / 64); float s = 0.f; f32x4 v[4];
#pragma unroll
        for (int j = 0; j < 4; ++j) { v[j] = *((const f32x4*)(meta + (size_t)r * D) + 64 * j + lane) + *((const f32x4*)(C2 + (size_t)r * D) + 64 * j + lane); s += (v[j][0] * v[j][0] + v[j][1] * v[j][1]) + (v[j][2] * v[j][2] + v[j][3] * v[j][3]); }
        if (ch == 0) {
#pragma unroll
            for (int j = 0; j < 4; ++j) *((f32x4*)(H1 + (size_t)r * D) + 64 * j + lane) = v[j]; }
        const float rs = rsqrtf(wave_sum(s) * (1.0f / 1024.0f) + 1e-6f);
        const int j = 64 * ch + lane; const float g = C3[(size_t)r * NGU + j] * rs, u = C3[(size_t)r * NGU + DFF + j] * rs;
        HID[(size_t)r * DFF + j] = (bf16)f2bf(g * __builtin_amdgcn_rcpf(1.0f + __expf(-g)) * u); }
}
__device__ __forceinline__ void meta_e5(const Args& a, int gwp, int NGW, int lane) {
    unsigned char* ws = a.ws; const float* H1 = (const float*)(ws + WS_MH1); const float* C4 = (const float*)(ws + WS_MC4);
    const float* C5 = (const float*)(ws + WS_MC5); bf16* MZ = (bf16*)(ws + WS_MZ);
    for (int task = gwp; task < 16 * (D / 64); task += NGW) { const int r = task >> 4, ch = task & 15; float s = 0.f;
#pragma unroll
        for (int j = 0; j < 4; ++j) { const f32x4 v = *((const f32x4*)(H1 + (size_t)r * D) + 64 * j + lane) + *((const f32x4*)(C4 + (size_t)r * D) + 64 * j + lane); s += (v[0] * v[0] + v[1] * v[1]) + (v[2] * v[2] + v[3] * v[3]); }
        const float rs = rsqrtf(wave_sum(s) * (1.0f / 1024.0f) + 1e-6f);
        const int j = 64 * ch + lane;
        MZ[(size_t)r * D + j] = (bf16)f2bf((C5[(size_t)r * 2048 + j] * rs) * (C5[(size_t)r * 2048 + 1024 + j] * rs)); }
}
__device__ __forceinline__ void conv_phase(const Args& a, int lane, int gw, int NGW) {
    const bf16* Z = (const bf16*)(a.ws + WS_BIG); const bf16* GB = Z + (size_t)MP * D; bf16* Y = (bf16*)(a.ws + WS_O); const float* cw = a.in[14];
    for (int it = gw; it < (MP / 16) * 2; it += NGW) {
        const int rb = (MP / 16 - 1) - (it >> 1), col = (it & 1) * 512 + lane * 8, row0 = rb * 16, p0 = row0 % LP;
        float w0[8], w1[8], w2[8], zm2[8], zm1[8];
#pragma unroll
        for (int e = 0; e < 8; ++e) { w0[e] = cw[col + e]; w1[e] = cw[D + col + e]; w2[e] = cw[2 * D + col + e]; zm2[e] = 0.f; zm1[e] = 0.f; }
        { const bf16* MZ = (const bf16*)(a.ws + WS_MZ);
          const v4u a2 = *(const v4u*)(p0 != 0 ? Z + (size_t)(row0 - 2) * D + col : MZ + 14 * D + col), a1 = *(const v4u*)(p0 != 0 ? Z + (size_t)(row0 - 1) * D + col : MZ + 15 * D + col);
#pragma unroll
            for (int e = 0; e < 4; ++e) { zm2[2 * e] = __uint_as_float(a2[e] << 16); zm2[2 * e + 1] = __uint_as_float(a2[e] & 0xffff0000u); zm1[2 * e] = __uint_as_float(a1[e] << 16); zm1[2 * e + 1] = __uint_as_float(a1[e] & 0xffff0000u); } }
#pragma unroll 4
        for (int i = 0; i < 16; ++i) { const size_t off = (size_t)(row0 + i) * D + col; const v4u zz = *(const v4u*)(Z + off), gg = *(const v4u*)(GB + off);
            float z[8], g[8], y[8];
#pragma unroll
            for (int e = 0; e < 4; ++e) { z[2 * e] = __uint_as_float(zz[e] << 16); z[2 * e + 1] = __uint_as_float(zz[e] & 0xffff0000u); g[2 * e] = __uint_as_float(gg[e] << 16); g[2 * e + 1] = __uint_as_float(gg[e] & 0xffff0000u); }
#pragma unroll
            for (int e = 0; e < 8; ++e) { y[e] = g[e] * (w0[e] * zm2[e] + w1[e] * zm1[e] + w2[e] * z[e]); zm2[e] = zm1[e]; zm1[e] = z[e]; }
            v4u o; o.x = pk2(y[0], y[1]); o.y = pk2(y[2], y[3]); o.z = pk2(y[4], y[5]); o.w = pk2(y[6], y[7]);
            *(v4u*)(Y + off) = o; }
    }
}

__global__ void __launch_bounds__(NWAVES * 64, 2) mega_fwd(Args args) {
    extern __shared__ __attribute__((aligned(16))) unsigned char lds_raw[];
    LAS unsigned char* lds = (LAS unsigned char*)lds_raw;
    cg::grid_group grid = cg::this_grid();
    const int wave = __builtin_amdgcn_readfirstlane(threadIdx.x >> 6);
    const int G = gridDim.x, gw = blockIdx.x * NWAVES + wave, NGW = G * NWAVES, gwp = wave * G + (int)blockIdx.x;
    unsigned char* ws = args.ws;
    bf16* XB = (bf16*)(ws + WS_XB); float* SSP = (float*)(ws + WS_SSP); bf16* BIG = (bf16*)(ws + WS_BIG); bf16* OB = (bf16*)(ws + WS_O);
    const int lo = args.ph_lo, hi = args.ph_hi;
    if (threadIdx.x < 16) ((LAS unsigned*)(lds + MISC_OFF))[threadIdx.x] = 0u;
    __syncthreads();
    XcdBarrier bar = xcd_barrier_post((unsigned*)(ws + WS_CTL), (volatile LAS unsigned*)(lds + MISC_OFF));
#ifndef PHASE_MASK
#define PHASE_MASK 0x1fff
#endif
#define IN(k) (((PHASE_MASK >> (k)) & 1) && lo <= (k) && (k) < hi)
#define SEAM(k) do { if (IN(k) && IN((k) + 1)) { if ((k) == 0) grid.sync(); else xcd_barrier(bar); } } while (0)
    bf16* MXB = (bf16*)(ws + WS_MXB); const bf16* MQKV = (const bf16*)(ws + WS_MQKV);
    if (IN(0)) REPS(0) { prologue(args, lds, wave, pg8::lane_id_v(), gw, NGW); }
    SEAM(0);
    if (IN(1)) {
        skinny_gemm<0>(MXB, nullptr, nullptr, D, (const bf16*)(ws + WS_WQKV), 1, 0, NQKV / 16, (float*)(ws + WS_MC1), NQKV, gwp, NGW, pg8::lane_id_v());
    }
    SEAM(1);
    if (IN(2)) {
        if (gwp < 128) meta_e1(args, lds, wave, pg8::lane_id_v(), gwp & 7, 15 - (gwp >> 3));
        weight_items(args, lds, wave, pg8::lane_id_v(), gw, NGW, W_ITEMS_L0, W_ITEMS);
    }
    SEAM(2);
    if (IN(3)) REPS(3) {
        skinny_gemm<0>((const bf16*)(ws + WS_MOM), nullptr, nullptr, D, (const bf16*)(ws + WS_WO), 0, 0, D / 16, (float*)(ws + WS_MC2), D, gwp, NGW, pg8::lane_id_v());
        pg8::Gemm g{XB, (const bf16*)(ws + WS_WQKV), MP, NQKV, D}; pg8::StaticOrder S; S.init(MP, NQKV, G, (int)blockIdx.x);
        pg8::EpiQKV E{BIG, (const float*)(ws + WS_RS0), (const float*)(ws + WS_ROPE), args.in[5], args.in[6], lds + pg8::SSPL_OFF};
        pg8::gemm_phase<pg8::EpiQKV, pg8::StaticOrder, true, true>(lds, g, S, E, wave);
    }
    SEAM(3);
    if (IN(4)) REPS(4) {
        skinny_gemm<1>(nullptr, args.in[1], (const float*)(ws + WS_MC2), D, (const bf16*)(ws + WS_WGU0), 2, 0, NGU / 16, (float*)(ws + WS_MC3), NGU, gwp, NGW, pg8::lane_id_v());
        const int lane = pg8::lane_id_v();
        float s1 = wave_sum(args.in[7][lane] * args.in[8][lane]), s2 = wave_sum(args.in[9][lane] * args.in[10][lane]);
        const float lam = expf(s1) - expf(s2) + 0.2f;
        for (int bh = blockIdx.x; bh < NB * 8; bh += G) { const int b = bh >> 3, h = bh & 7;
#pragma unroll 1
            for (int j = 0; j < 8; ++j) att::attn_unit<WS_BIG, WS_MQKV, WS_O>(lds, ws, b, h, 64 + 256 * j, 8, lam, args.in[11], wave); }
    }
    SEAM(4);
    if (IN(5)) {
        meta_e3(args, gwp, NGW, pg8::lane_id_v());
        pg8::Gemm g{OB, (const bf16*)(ws + WS_WO), MP, D, D}; pg8::StaticOrder S; S.init(MP, D, G, (int)blockIdx.x);
        pg8::EpiRes<1> E{nullptr, XB, SSP, nullptr};
        pg8::gemm_phase<pg8::EpiRes<1>, pg8::StaticOrder, true, true>(lds, g, S, E, wave);
    }
    SEAM(5);
    if (IN(6)) REPS(6) {
        skinny_gemm<0>((const bf16*)(ws + WS_MHID), nullptr, nullptr, DFF, (const bf16*)(ws + WS_WD0), 0, 0, D / 16, (float*)(ws + WS_MC4), D, gwp, NGW, pg8::lane_id_v());
        pg8::Gemm g{XB, (const bf16*)(ws + WS_WGU0), MP, NGU, D}; pg8::StaticOrder S; S.init(MP, NGU, G, (int)blockIdx.x);
        pg8::EpiGateUp E{BIG, SSP, lds + pg8::SSPL_OFF};
        pg8::gemm_phase<pg8::EpiGateUp, pg8::StaticOrder, true, true>(lds, g, S, E, wave);
    }
    SEAM(6);
    if (IN(7)) {
        skinny_gemm<1>(nullptr, (const float*)(ws + WS_MH1), (const float*)(ws + WS_MC4), D, (const bf16*)(ws + WS_WIN), 3, 1024, 2048 / 16, (float*)(ws + WS_MC5), 2048, gwp, NGW, pg8::lane_id_v());
        pg8::Gemm g{BIG, (const bf16*)(ws + WS_WD0), MP, D, DFF}; pg8::StaticOrder S; S.init(MP, D, G, (int)blockIdx.x, 1);
        pg8::EpiRes<1> E{nullptr, XB, SSP, nullptr};
        pg8::gemm_phase<pg8::EpiRes<1>, pg8::StaticOrder, true, true>(lds, g, S, E, wave);
    }
    SEAM(7);
    if (IN(8)) REPS(8) {
        meta_e5(args, gwp, NGW, pg8::lane_id_v());
        pg8::Gemm g{XB, (const bf16*)(ws + WS_WIN), MP, NQKV, D}; pg8::StaticOrder S; S.init(MP, NQKV, G, (int)blockIdx.x);
        pg8::EpiWin E{BIG, BIG + (size_t)MP * D, SSP, lds + pg8::SSPL_OFF};
        pg8::gemm_phase<pg8::EpiWin, pg8::StaticOrder, true, true>(lds, g, S, E, wave);
    }
    SEAM(8);
    if (IN(9)) REPS(9) { conv_phase(args, pg8::lane_id_v(), gw, NGW); }
    SEAM(9);
    if (IN(10)) {
        pg8::Gemm g{OB, (const bf16*)(ws + WS_WOUT), MP, D, D}; pg8::StaticOrder S; S.init(MP, D, G, (int)blockIdx.x);
        pg8::EpiRes<1> E{nullptr, XB, SSP, nullptr};
        pg8::gemm_phase<pg8::EpiRes<1>, pg8::StaticOrder, true, true>(lds, g, S, E, wave);
    }
    SEAM(10);
    if (IN(11)) REPS(11) {
        pg8::Gemm g{XB, (const bf16*)(ws + WS_WGU1), MP, NGU, D}; pg8::StaticOrder S; S.init(MP, NGU, G, (int)blockIdx.x);
        pg8::EpiGateUp E{BIG, SSP, lds + pg8::SSPL_OFF};
        pg8::gemm_phase<pg8::EpiGateUp, pg8::StaticOrder, true, true>(lds, g, S, E, wave);
    }
    SEAM(11);
    if (IN(12)) {
        pg8::Gemm g{BIG, (const bf16*)(ws + WS_WD1), MP, D, DFF}; pg8::StaticOrder S; S.init(MP, D, G, (int)blockIdx.x, 1);
        pg8::EpiRes<2> E{nullptr, XB, nullptr, args.out};
        pg8::gemm_phase<pg8::EpiRes<2>, pg8::StaticOrder, true, true>(lds, g, S, E, wave);
    }
#undef IN
#undef SEAM
}

extern "C" void kernel_launch(void* const* d_in, const int* in_sizes, int n_in, void* d_out, int out_size, void* d_ws, size_t ws_size, hipStream_t stream) {
    static int grid = 0;
    if (grid == 0) {
        if (n_in != 18 || ws_size < WS_END) { fprintf(stderr, "kernel_launch: need 18 inputs and %zu bytes of workspace (got %d, %zu)\n", (size_t)WS_END, n_in, ws_size); grid = -1; return; }
        int dev = 0, cus = 0, per_cu = 0;
        hipGetDevice(&dev); hipDeviceGetAttribute(&cus, hipDeviceAttributeMultiprocessorCount, dev);
        if (hipFuncSetAttribute((const void*)mega_fwd, hipFuncAttributeMaxDynamicSharedMemorySize, LDS_BYTES) != hipSuccess) { fprintf(stderr, "kernel_launch: hipFuncSetAttribute failed\n"); grid = -1; return; }
        if (hipOccupancyMaxActiveBlocksPerMultiprocessor(&per_cu, (const void*)mega_fwd, NWAVES * 64, LDS_BYTES) != hipSuccess || per_cu < 1) { fprintf(stderr, "kernel_launch: occupancy query says %d\n", per_cu); per_cu = 1; }
        (void)hipGetLastError();
        grid = cus * per_cu;
    }
    if (grid < 0) return;
    Args a{};
    for (int i = 0; i < 18; ++i) a.in[i] = (const float*)d_in[i];
    a.out = (float*)d_out; a.ws = (unsigned char*)d_ws;
#if MK_PER_PHASE
    for (int p = 0; p < NPHASE; ++p) { a.ph_lo = p; a.ph_hi = p + 1; hipLaunchKernelGGL(mega_fwd, dim3(grid), dim3(NWAVES * 64), LDS_BYTES, stream, a); }
#else
    a.ph_lo = 0; a.ph_hi = NPHASE;
    if (hipMemsetAsync((char*)d_ws + WS_CTL, 0, CTL_BYTES, stream) != hipSuccess) { fprintf(stderr, "kernel_launch: memset failed\n"); return; }
    void* kargs[] = {&a};
    hipError_t e = hipLaunchCooperativeKernel((const void*)mega_fwd, dim3(grid), dim3(NWAVES * 64), kargs, LDS_BYTES, stream);
    if (e != hipSuccess) fprintf(stderr, "kernel_launch: cooperative launch failed: %s (grid %d)\n", hipGetErrorString(e), grid);
#endif
}
```

```cpp
#include <hip/hip_runtime.h>
#include <hip/hip_cooperative_groups.h>
#include <cstdio>
#include <cstdint>
namespace cg = cooperative_groups;
namespace pg8 {
#define PG8_LAS __attribute__((address_space(3)))
typedef unsigned short bf16_t;
typedef short bf16x8 __attribute__((ext_vector_type(8)));
typedef float f32x4 __attribute__((ext_vector_type(4)));
typedef unsigned u32x4 __attribute__((ext_vector_type(4)));
constexpr int BM = 256, BK = 64, HALF = 128, HTB = HALF * BK * 2  , STAGE_BYTES = 8 * HTB, NXCD = 8, WGM = 8;

__host__ __device__ __forceinline__ int lds_byte(int r, int c) { const int st = (r >> 4) * 2 + (c >> 5), rr = r & 15, cc = c & 31, ob = rr * 64 + cc * 2; return st * 1024 + (ob ^ (((ob >> 9) & 1) << 5)); }
__host__ __device__ __forceinline__ void stage_rc(int b, int& R, int& C) { const int st = b / 1024, sb = b % 1024, swz = sb ^ (((sb >> 9) & 1) << 5); R = (st >> 1) * 16 + swz / 64; C = (st & 1) * 32 + (swz % 64) / 2; }
__host__ __device__ __forceinline__ int perm32(int rho) { const int n = rho >> 4, i = rho & 15; return 8 * (i >> 2) + 4 * n + (i & 3); }

struct Unit { int pm, pn; };
struct Gemm { const bf16_t* A; const bf16_t* Bt; int M, N, K; };

struct StaticOrder {
    int nM, nN, nwg, G, c, rev;
    __host__ __device__ void init(int M, int N, int G_, int c_, int rev_ = 0) { nM = M / BM; nN = N / BM; nwg = nM * nN; G = G_; c = c_; rev = rev_; }
    __host__ __device__ bool next(int i, Unit& u) const {
        const long L = (long)i * G + c; if (L >= nwg) return false;
        int wgid = (int)L; { const int q = nwg / NXCD, r = nwg % NXCD, xcd = wgid % NXCD, off = wgid / NXCD; wgid = (xcd < r ? xcd * (q + 1) : r * (q + 1) + (xcd - r) * q) + off; }
        const int nig = WGM * nN, gid = wgid / nig, fm = gid * WGM, gsz = (nM - fm) < WGM ? (nM - fm) : WGM;
        u.pm = fm + ((wgid % nig) % gsz); u.pn = (wgid % nig) / gsz; if (rev) u.pm = nM - 1 - u.pm; return true;
    }
    __device__ __forceinline__ void a_ready(const Unit&) const {}
    __device__ __forceinline__ void done(const Unit&) const {}
};
__device__ __forceinline__ unsigned cvt_pk_bf16(float lo, float hi) { unsigned r; asm volatile("v_cvt_pk_bf16_f32 %0, %1, %2" : "=v"(r) : "v"(lo), "v"(hi)); return r; }
typedef unsigned u32x2 __attribute__((ext_vector_type(2)));
__device__ __forceinline__ int lane_id_v() { int l; asm volatile("v_mbcnt_lo_u32_b32 %0, -1, 0\n\tv_mbcnt_hi_u32_b32 %0, -1, %0" : "=v"(l)); return l; }
constexpr int LP_ = 2048, NMETA_ = 16;
constexpr float QSCALE_ = 0.125f * 1.4426950408889634f;
__device__ __forceinline__ float row_rstd(const float* ssp, int row) {
    const f32x4* p = (const f32x4*)(ssp + (size_t)row * 16);
    const f32x4 a = p[0], b = p[1], c = p[2], d = p[3];
    const float s = (((a[0] + a[1]) + (a[2] + a[3])) + ((b[0] + b[1]) + (b[2] + b[3]))) + (((c[0] + c[1]) + (c[2] + c[3])) + ((d[0] + d[1]) + (d[2] + d[3])));
    return rsqrtf(s * (1.0f / 1024.0f) + 1e-6f);
}
__device__ __forceinline__ float row_rstd_lds(const PG8_LAS unsigned char* sspl, int rl) {
    const PG8_LAS f32x4* p = (const PG8_LAS f32x4*)(sspl + rl * 64);
    const f32x4 a = p[0], b = p[1], c = p[2], d = p[3];
    const float s = (((a[0] + a[1]) + (a[2] + a[3])) + ((b[0] + b[1]) + (b[2] + b[3]))) + (((c[0] + c[1]) + (c[2] + c[3])) + ((d[0] + d[1]) + (d[2] + d[3])));
    return rsqrtf(s * (1.0f / 1024.0f) + 1e-6f);
}
constexpr int SSPL_OFF = 131072;
constexpr int QRS_OFF = SSPL_OFF, QROPEB_OFF = SSPL_OFF + 2048, QROPEO_OFF = SSPL_OFF + 2048 + 8192;
__device__ __forceinline__ u32x4 pack8(const f32x4 v0, const f32x4 v1) { u32x4 w; w.x = cvt_pk_bf16(v0[0], v0[1]); w.y = cvt_pk_bf16(v0[2], v0[3]); w.z = cvt_pk_bf16(v1[0], v1[1]); w.w = cvt_pk_bf16(v1[2], v1[3]); return w; }

struct EpiQKV {
    static constexpr bool PERM = true, AFTER_DRAIN = false, USES_SSP = false; static constexpr int NST = 16;
    bf16_t* QKV; const float* rs0; const float* rope; const float* qg; const float* kg; const PG8_LAS unsigned char* sspl;
    __device__ __forceinline__ void prefetch_next(PG8_LAS unsigned char* lds, int pm, int wid, int lane, int par) const {
        if (wid < 4) { const int p0 = ((pm * BM) % LP_) + NMETA_;
            __builtin_amdgcn_global_load_lds((const unsigned*)((const char*)rope + (size_t)(p0 + 64 * wid) * 256 + (unsigned)((lane >> 4) * 4096 + (lane & 15) * 16)), (PG8_LAS unsigned*)(lds + QROPEB_OFF + par * 4096 + wid * 1024), 16, 0, 0); }
        else if (wid == 4) __builtin_amdgcn_global_load_lds((const unsigned*)((const char*)rs0 + (size_t)pm * (BM * 4) + (unsigned)(lane * 16)), (PG8_LAS unsigned*)(lds + QRS_OFF + par * 1024), 16, 0, 0);
    }
    __device__ __forceinline__ void prefetch_phase(PG8_LAS unsigned char* lds, int pm, int wid, int lane) const {
        if (wid >= 4) __builtin_amdgcn_global_load_lds((const unsigned*)((const char*)rope + (size_t)((wid - 4) * 1024) + (unsigned)(lane * 16)), (PG8_LAS unsigned*)(lds + QROPEO_OFF + (wid - 4) * 1024), 16, 0, 0);
        prefetch_next(lds, pm, wid, lane, 0);
    }
    __device__ __forceinline__ void operator()(const f32x4 (&acc)[2][2][4][2], const Unit& u, int wr, int wc, int fr, int fq, int par) const {
        const int row0 = u.pm * BM + wr * 64 + fr, pn = u.pn;
        const int colbase = pn * 256 + wc * 64 + 8 * fq;
        if (pn < 8) {
            const float* gp = (pn < 4) ? qg : kg; const float osc = (pn < 4) ? QSCALE_ : 1.0f;
            f32x4 g[2][2];
#pragma unroll
            for (int bj = 0; bj < 2; ++bj)
#pragma unroll
                for (int n = 0; n < 2; ++n) g[bj][n] = *(const f32x4*)(gp + 32 * bj + 8 * fq + 4 * n);
            const PG8_LAS f32x4* rop = (const PG8_LAS f32x4*)(sspl + (QROPEO_OFF - SSPL_OFF) + fr * 256 + fq * 64);
#pragma unroll
            for (int ai = 0; ai < 2; ++ai)
#pragma unroll
                for (int m = 0; m < 4; ++m) {
                    const int row = row0 + ai * HALF + m * 16; const float rs = rsqrtf(*(const PG8_LAS float*)(sspl + (QRS_OFF - SSPL_OFF) + par * 1024 + (row - u.pm * BM) * 4) * (1.0f / 1024.0f) + 1e-6f);
                    f32x4 v[2][2]; float ss = 0.f;
#pragma unroll
                    for (int bj = 0; bj < 2; ++bj)
#pragma unroll
                        for (int n = 0; n < 2; ++n) { v[bj][n] = acc[ai][bj][m][n] * rs; const f32x4 x = v[bj][n]; ss += (x[0] * x[0] + x[1] * x[1]) + (x[2] * x[2] + x[3] * x[3]); }
                    ss += __shfl_xor(ss, 16); ss += __shfl_xor(ss, 32);
                    const float rn = rsqrtf(ss * (1.0f / 64.0f) + 1e-6f);
#pragma unroll
                    for (int bj = 0; bj < 2; ++bj)
#pragma unroll
                        for (int n = 0; n < 2; ++n) v[bj][n] = v[bj][n] * rn * g[bj][n];
                    const PG8_LAS f32x4* bp = (const PG8_LAS f32x4*)(sspl + (QROPEB_OFF - SSPL_OFF) + par * 4096 + ((row - u.pm * BM) >> 4) * 256 + fq * 64);
                    f32x4 rp[4];
#pragma unroll
                    for (int qq = 0; qq < 4; ++qq) { const f32x4 bb = bp[qq], oo = rop[qq];
                        rp[qq][0] = bb[0] * oo[0] - bb[1] * oo[1]; rp[qq][1] = bb[1] * oo[0] + bb[0] * oo[1];
                        rp[qq][2] = bb[2] * oo[2] - bb[3] * oo[3]; rp[qq][3] = bb[3] * oo[2] + bb[2] * oo[3]; }
                    f32x4 o1[2], o2[2];
#pragma unroll
                    for (int n = 0; n < 2; ++n) { const f32x4 ca = rp[2 * n], cb = rp[2 * n + 1];
                        const f32x4 x1 = v[0][n], x2 = v[1][n];
                        o1[n][0] = (x1[0] * ca[0] - x2[0] * ca[1]) * osc; o2[n][0] = (x2[0] * ca[0] + x1[0] * ca[1]) * osc;
                        o1[n][1] = (x1[1] * ca[2] - x2[1] * ca[3]) * osc; o2[n][1] = (x2[1] * ca[2] + x1[1] * ca[3]) * osc;
                        o1[n][2] = (x1[2] * cb[0] - x2[2] * cb[1]) * osc; o2[n][2] = (x2[2] * cb[0] + x1[2] * cb[1]) * osc;
                        o1[n][3] = (x1[3] * cb[2] - x2[3] * cb[3]) * osc; o2[n][3] = (x2[3] * cb[2] + x1[3] * cb[3]) * osc; }
                    bf16_t* rowp = QKV + (size_t)row * 3072 + colbase;
                    *(u32x4*)(rowp) = pack8(o1[0], o1[1]); *(u32x4*)(rowp + 32) = pack8(o2[0], o2[1]);
                }
        } else {
#pragma unroll
            for (int ai = 0; ai < 2; ++ai)
#pragma unroll
                for (int m = 0; m < 4; ++m) {
                    const int row = row0 + ai * HALF + m * 16; const float rs = rsqrtf(*(const PG8_LAS float*)(sspl + (QRS_OFF - SSPL_OFF) + par * 1024 + (row - u.pm * BM) * 4) * (1.0f / 1024.0f) + 1e-6f);
                    bf16_t* rowp = QKV + (size_t)row * 3072 + colbase;
#pragma unroll
                    for (int bj = 0; bj < 2; ++bj) *(u32x4*)(rowp + 32 * bj) = pack8(acc[ai][bj][m][0] * rs, acc[ai][bj][m][1] * rs);
                }
        }
    }
};
struct EpiGateUp {
    static constexpr bool PERM = true, AFTER_DRAIN = false, USES_SSP = true; static constexpr int NST = 8;
    bf16_t* HID; const float* ssp; const PG8_LAS unsigned char* sspl;
    __device__ __forceinline__ void prefetch_phase(PG8_LAS unsigned char*, int, int, int) const {}
    __device__ __forceinline__ void prefetch_next(PG8_LAS unsigned char*, int, int, int, int) const {}
    __device__ __forceinline__ void operator()(const f32x4 (&acc)[2][2][4][2], const Unit& u, int wr, int wc, int fr, int fq, int par) const {
        const int row0 = u.pm * BM + wr * 64 + fr; const int col = u.pn * 128 + wc * 32 + 8 * fq;
#pragma unroll
        for (int ai = 0; ai < 2; ++ai)
#pragma unroll
            for (int m = 0; m < 4; ++m) {
                const int row = row0 + ai * HALF + m * 16; const float rs = row_rstd_lds(sspl, row - u.pm * BM);
                f32x4 hv[2];
                const float kx = -1.4426950408889634f * rs, rs2 = rs * rs;
#pragma unroll
                for (int n = 0; n < 2; ++n) { const f32x4 a0 = acc[ai][0][m][n], a1 = acc[ai][1][m][n];
#pragma unroll
                    for (int e = 0; e < 4; ++e) { const float r = __builtin_amdgcn_rcpf(1.0f + __builtin_amdgcn_exp2f(a0[e] * kx)); hv[n][e] = (a0[e] * a1[e]) * (rs2 * r); } }
                *(u32x4*)(HID + (size_t)row * 2816 + col) = pack8(hv[0], hv[1]);
            }
    }
};
struct EpiWin {
    static constexpr bool PERM = true, AFTER_DRAIN = false, USES_SSP = true; static constexpr int NST = 8;
    bf16_t* Z; bf16_t* GB; const float* ssp; const PG8_LAS unsigned char* sspl;
    __device__ __forceinline__ void prefetch_phase(PG8_LAS unsigned char*, int, int, int) const {}
    __device__ __forceinline__ void prefetch_next(PG8_LAS unsigned char*, int, int, int, int) const {}
    __device__ __forceinline__ void operator()(const f32x4 (&acc)[2][2][4][2], const Unit& u, int wr, int wc, int fr, int fq, int par) const {
        const int row0 = u.pm * BM + wr * 64 + fr, pn = u.pn;
#pragma unroll
        for (int ai = 0; ai < 2; ++ai)
#pragma unroll
            for (int m = 0; m < 4; ++m) {
                const int row = row0 + ai * HALF + m * 16; const float rs = row_rstd_lds(sspl, row - u.pm * BM);
                if (pn < 8) {
                    const float rs2 = rs * rs;
                    *(u32x4*)(Z + (size_t)row * 1024 + pn * 128 + wc * 32 + 8 * fq) = pack8(acc[ai][0][m][0] * acc[ai][1][m][0] * rs2, acc[ai][0][m][1] * acc[ai][1][m][1] * rs2);
                } else {
                    bf16_t* rowp = GB + (size_t)row * 1024 + (pn - 8) * 256 + wc * 32 + 8 * fq;
#pragma unroll
                    for (int bj = 0; bj < 2; ++bj) *(u32x4*)(rowp + 128 * bj) = pack8(acc[ai][bj][m][0] * rs, acc[ai][bj][m][1] * rs);
                }
            }
    }
};
__device__ __forceinline__ f32x4 bf_lo4(const u32x4 w) { f32x4 r; r[0] = __uint_as_float(w.x << 16); r[1] = __uint_as_float(w.x & 0xffff0000u); r[2] = __uint_as_float(w.y << 16); r[3] = __uint_as_float(w.y & 0xffff0000u); return r; }
__device__ __forceinline__ f32x4 bf_hi4(const u32x4 w) { f32x4 r; r[0] = __uint_as_float(w.z << 16); r[1] = __uint_as_float(w.z & 0xffff0000u); r[2] = __uint_as_float(w.w << 16); r[3] = __uint_as_float(w.w & 0xffff0000u); return r; }
template <int MODE> struct EpiRes {
    static constexpr bool PERM = true, AFTER_DRAIN = false, USES_SSP = false; static constexpr int NST = (MODE == 2) ? 32 : 8;
    const float* x; bf16_t* XB; float* ssp; float* out;
    __device__ __forceinline__ void prefetch_phase(PG8_LAS unsigned char*, int, int, int) const {}
    __device__ __forceinline__ void prefetch_next(PG8_LAS unsigned char*, int, int, int, int) const {}
    __device__ __forceinline__ void operator()(const f32x4 (&acc)[2][2][4][2], const Unit& u, int wr, int wc, int fr, int fq, int par) const {
        const int row0 = u.pm * BM + wr * 64 + fr; const int c0 = u.pn * 256 + wc * 32 + 8 * fq;
#pragma unroll
        for (int ai = 0; ai < 2; ++ai)
#pragma unroll
            for (int m = 0; m < 4; ++m) {
                const int row = row0 + ai * HALF + m * 16; float ss = 0.f;
                f32x4 nv[2][2];
#pragma unroll
                for (int bj = 0; bj < 2; ++bj) {
                    if (MODE == 0) { const float* hp = x + (size_t)row * 1024 + c0 + 128 * bj; nv[bj][0] = *(const f32x4*)hp + acc[ai][bj][m][0]; nv[bj][1] = *(const f32x4*)(hp + 4) + acc[ai][bj][m][1]; }
                    else { const u32x4 hw = *(const u32x4*)(XB + (size_t)row * 1024 + c0 + 128 * bj); nv[bj][0] = bf_lo4(hw) + acc[ai][bj][m][0]; nv[bj][1] = bf_hi4(hw) + acc[ai][bj][m][1]; }
                }
                if (MODE != 2) {
#pragma unroll
                    for (int bj = 0; bj < 2; ++bj) {
                        *(u32x4*)(XB + (size_t)row * 1024 + c0 + 128 * bj) = pack8(nv[bj][0], nv[bj][1]);
#pragma unroll
                        for (int n = 0; n < 2; ++n) { const f32x4 v = nv[bj][n]; ss += (v[0] * v[0] + v[1] * v[1]) + (v[2] * v[2] + v[3] * v[3]); }
                    }
                    ss += __shfl_xor(ss, 16); ss += __shfl_xor(ss, 32);
                    if (fq == 0) ssp[(size_t)row * 16 + 4 * u.pn + wc] = ss;
                } else {
                    float* op = out + (size_t)row * 1024 + c0;
#pragma unroll
                    for (int bj = 0; bj < 2; ++bj) { *(f32x4*)(op + 128 * bj) = nv[bj][0]; *(f32x4*)(op + 128 * bj + 4) = nv[bj][1]; }
                }
            }
    }
};
template <class Epi, class Sched, bool ALIGN_EPI = false, bool SP2 = false>
__device__ __forceinline__ void gemm_phase(PG8_LAS unsigned char* lds, const Gemm g, const Sched& S, const Epi& E, const int wid) {
    const int lane = lane_id_v(), tid = wid * 64 + lane, wr = wid >> 2, wc = wid & 3, fr = lane & 15, fq = lane >> 4;
    const int K = g.K, nt = K / BK;
    unsigned voffA[2], voffB[2];
#pragma unroll
    for (int i = 0; i < 2; ++i) { int R, C; stage_rc(tid * 16 + i * 8192, R, C); const int Rb = Epi::PERM ? ((R & ~31) + perm32(R & 31)) : R;
        voffA[i] = (unsigned)(R * K + C) * 2u; voffB[i] = (unsigned)(Rb * K + C) * 2u; }
    const size_t kstep = (size_t)(BK * 2);
    const size_t hstep = (size_t)HALF * K * 2;
    const size_t tstep = 2 * hstep;
    const unsigned ldsw = (unsigned)wid * 1024u;
    const int aoff = lds_byte(wr * 64 + fr, fq * 8), boff = lds_byte(wc * 32 + fr, fq * 8);
#define PG8_SA(b, h) (((b) * 2 + (h)) * HTB)
#define PG8_SB(b, h) ((4 + (b) * 2 + (h)) * HTB)
#define PG8_STAGE(bufoff, gbase, voff) do { _Pragma("unroll") for (int _i = 0; _i < 2; ++_i) \
        __builtin_amdgcn_global_load_lds((const unsigned*)((const char*)(gbase) + (voff)[_i]), (PG8_LAS unsigned*)(lds + (bufoff) + ldsw + _i * 8192), 16, 0, 0); } while (0)
#define PG8_SSP_DMA(pm_) do { if constexpr (Epi::USES_SSP) { _Pragma("unroll") for (int _i = 0; _i < 2; ++_i) \
        __builtin_amdgcn_global_load_lds((const unsigned*)((const char*)E.ssp + (size_t)(pm_) * (BM * 64) + (size_t)((2 * wid + _i) * 1024) + (unsigned)(lane * 16)), (PG8_LAS unsigned*)(lds + SSPL_OFF + (2 * wid + _i) * 1024), 16, 0, 0); } } while (0)
#define PG8_LDA(dst, b, h) do { _Pragma("unroll") for (int m = 0; m < 4; ++m) _Pragma("unroll") for (int k = 0; k < 2; ++k) dst[m][k] = *(const PG8_LAS bf16x8*)(lds + PG8_SA(b, h) + aoff + m * 2048 + k * 1024); } while (0)
#define PG8_LDB(dst, b, h) do { _Pragma("unroll") for (int n = 0; n < 2; ++n) _Pragma("unroll") for (int k = 0; k < 2; ++k) dst[n][k] = *(const PG8_LAS bf16x8*)(lds + PG8_SB(b, h) + boff + n * 2048 + k * 1024); } while (0)
#define PG8_MMA(ai, bj, At, Bt) do { __builtin_amdgcn_s_setprio(1); _Pragma("unroll") for (int m = 0; m < 4; ++m) _Pragma("unroll") for (int n = 0; n < 2; ++n) _Pragma("unroll") for (int k = 0; k < 2; ++k) \
        acc[ai][bj][m][n] = __builtin_amdgcn_mfma_f32_16x16x32_bf16(Bt[n][k], At[m][k], acc[ai][bj][m][n], 0, 0, 0); __builtin_amdgcn_s_setprio(0); } while (0)
#define PG8_WAIT_V(n) asm volatile("s_waitcnt vmcnt(" #n ")" ::: "memory")
#define PG8_WAIT_L(n) asm volatile("s_waitcnt lgkmcnt(" #n ")" ::: "memory")
#define PG8_BAR __builtin_amdgcn_s_barrier()
#define PG8_SCHED __builtin_amdgcn_sched_barrier(0)
    Unit cur, nxt; int ui = 0;
    if (!S.next(0, cur)) return;
    f32x4 acc[2][2][4][2];
#pragma unroll
    for (int a = 0; a < 2; ++a)
#pragma unroll
        for (int b = 0; b < 2; ++b)
#pragma unroll
            for (int m = 0; m < 4; ++m)
#pragma unroll
                for (int n = 0; n < 2; ++n) acc[a][b][m][n] = (f32x4){0.f, 0.f, 0.f, 0.f};
    bf16x8 At[4][2], B0[2][2], B1[2][2];
    const char* cA = (const char*)g.A + (size_t)cur.pm * tstep; const char* cB = (const char*)g.Bt + (size_t)cur.pn * tstep;
    S.a_ready(cur);
    PG8_SSP_DMA(cur.pm);
    E.prefetch_phase(lds, cur.pm, wid, lane);
    if constexpr (SP2) {
        PG8_STAGE(PG8_SB(0, 0), cB, voffB); PG8_STAGE(PG8_SB(0, 1), cB + hstep, voffB); PG8_STAGE(PG8_SA(0, 0), cA, voffA); PG8_STAGE(PG8_SA(0, 1), cA + hstep, voffA);
        if (wr == 1) PG8_BAR;
        PG8_WAIT_V(2); PG8_BAR;
        PG8_STAGE(PG8_SB(1, 0), cB + kstep, voffB); PG8_STAGE(PG8_SA(1, 0), cA + kstep, voffA); PG8_STAGE(PG8_SB(1, 1), cB + hstep + kstep, voffB);
        PG8_WAIT_V(6); PG8_BAR;
    } else {
        PG8_STAGE(PG8_SB(0, 0), cB, voffB); PG8_STAGE(PG8_SA(0, 0), cA, voffA); PG8_STAGE(PG8_SB(0, 1), cB + hstep, voffB); PG8_STAGE(PG8_SA(0, 1), cA + hstep, voffA);
        if (wr == 1) PG8_BAR;
        PG8_WAIT_V(4); PG8_BAR;
        PG8_STAGE(PG8_SB(1, 0), cB + kstep, voffB); PG8_STAGE(PG8_SA(1, 0), cA + kstep, voffA); PG8_STAGE(PG8_SB(1, 1), cB + hstep + kstep, voffB);
        PG8_WAIT_V(6); PG8_BAR;
    }
    static_assert(SP2, "this build keeps only the two-super-phase loop");
#define PG8_ITER(WV) do { \
            PG8_LDB(B0, 0, 0); PG8_LDB(B1, 0, 1); PG8_SCHED; PG8_LDA(At, 0, 0); PG8_STAGE(PG8_SA(1, 1), a1 + hstep, voffA); \
            WV; PG8_WAIT_L(0); PG8_BAR; PG8_MMA(0, 0, At, B0); PG8_MMA(0, 1, At, B1); PG8_BAR; PG8_SCHED; \
            PG8_LDA(At, 0, 1); PG8_STAGE(PG8_SB(0, 0), b2, voffB); PG8_STAGE(PG8_SB(0, 1), b2 + hstep, voffB); PG8_STAGE(PG8_SA(0, 0), a2, voffA); \
            WV; PG8_WAIT_L(0); PG8_BAR; PG8_MMA(1, 0, At, B0); PG8_MMA(1, 1, At, B1); PG8_BAR; PG8_SCHED; \
            PG8_LDB(B0, 1, 0); PG8_LDB(B1, 1, 1); PG8_SCHED; PG8_LDA(At, 1, 0); PG8_STAGE(PG8_SA(0, 1), a2 + hstep, voffA); \
            PG8_WAIT_V(8); PG8_WAIT_L(0); PG8_BAR; PG8_MMA(0, 0, At, B0); PG8_MMA(0, 1, At, B1); PG8_BAR; PG8_SCHED; \
            PG8_LDA(At, 1, 1); PG8_STAGE(PG8_SB(1, 0), b3, voffB); PG8_STAGE(PG8_SB(1, 1), b3 + hstep, voffB); PG8_STAGE(PG8_SA(1, 0), a3, voffA); \
            PG8_WAIT_V(8); PG8_WAIT_L(0); PG8_BAR; PG8_MMA(1, 0, At, B0); PG8_MMA(1, 1, At, B1); PG8_BAR; PG8_SCHED; } while (0)
#define PG8_WAIT_R asm volatile("s_waitcnt vmcnt(%0)" :: "n"(8 + Epi::NST) : "memory")
#define PG8_ITER_R() do { \
            PG8_LDB(B0, 0, 0); PG8_LDB(B1, 0, 1); PG8_SCHED; PG8_LDA(At, 0, 0); \
            PG8_WAIT_R; PG8_WAIT_L(0); PG8_BAR; PG8_MMA(0, 0, At, B0); PG8_MMA(0, 1, At, B1); PG8_BAR; PG8_SCHED; \
            PG8_SSP_DMA(cur.pm); PG8_SCHED;     \
            PG8_LDA(At, 0, 1); PG8_STAGE(PG8_SB(0, 0), b2, voffB); PG8_STAGE(PG8_SB(0, 1), b2 + hstep, voffB); PG8_STAGE(PG8_SA(0, 0), a2, voffA); \
            PG8_WAIT_R; PG8_WAIT_L(0); PG8_BAR; PG8_MMA(1, 0, At, B0); PG8_MMA(1, 1, At, B1); PG8_BAR; PG8_SCHED; \
            PG8_LDB(B0, 1, 0); PG8_LDB(B1, 1, 1); PG8_SCHED; PG8_LDA(At, 1, 0); PG8_STAGE(PG8_SA(0, 1), a2 + hstep, voffA); \
            PG8_WAIT_R; PG8_WAIT_L(0); PG8_BAR; PG8_MMA(0, 0, At, B0); PG8_MMA(0, 1, At, B1); PG8_BAR; PG8_SCHED; \
            PG8_LDA(At, 1, 1); PG8_STAGE(PG8_SB(1, 0), b3, voffB); PG8_STAGE(PG8_SB(1, 1), b3 + hstep, voffB); PG8_STAGE(PG8_SA(1, 0), a3, voffA); \
            PG8_WAIT_V(8); PG8_WAIT_L(0); PG8_BAR; PG8_MMA(1, 0, At, B0); PG8_MMA(1, 1, At, B1); PG8_BAR; PG8_SCHED; } while (0)
    int t0 = 0;
    for (;;) {
        const bool has_next = S.next(ui + 1, nxt);
        const char* nA = has_next ? (const char*)g.A + (size_t)nxt.pm * tstep : cA; const char* nB = has_next ? (const char*)g.Bt + (size_t)nxt.pn * tstep : cB;
        for (int t = t0; t < nt; t += 2) {
            const bool last = (t == nt - 2);
            const char* a1 = cA + (size_t)(t + 1) * kstep;
            const char* a2 = last ? nA : cA + (size_t)(t + 2) * kstep; const char* b2 = last ? nB : cB + (size_t)(t + 2) * kstep;
            const char* a3 = a2 + kstep; const char* b3 = b2 + kstep;
            if (last && has_next) S.a_ready(nxt);
            PG8_ITER(PG8_WAIT_V(8));
        }
        if constexpr (ALIGN_EPI) { if (wr == 0) PG8_BAR; }
        if (has_next) PG8_STAGE(PG8_SA(1, 1), nA + kstep + hstep, voffA);
        PG8_SCHED;
        if constexpr (!Epi::AFTER_DRAIN) { const int le = lane_id_v(); E(acc, cur, wr, wc, le & 15, le >> 4, ui & 1); if (has_next) E.prefetch_next(lds, nxt.pm, wid, le, (ui + 1) & 1); S.done(cur); }
        PG8_SCHED;
        if (!has_next) break;
#pragma unroll
        for (int a = 0; a < 2; ++a)
#pragma unroll
            for (int b = 0; b < 2; ++b)
#pragma unroll
                for (int m = 0; m < 4; ++m)
#pragma unroll
                    for (int n = 0; n < 2; ++n) acc[a][b][m][n] = (f32x4){0.f, 0.f, 0.f, 0.f};
        cur = nxt; cA = nA; cB = nB; ++ui; t0 = 2;
        if constexpr (ALIGN_EPI) { if (wr == 1) PG8_BAR; }
        PG8_SCHED;
        {
            const char* a1 = cA + kstep; const char* a2 = cA + 2 * kstep; const char* b2 = cB + 2 * kstep; const char* a3 = a2 + kstep; const char* b3 = b2 + kstep;
            (void)a1; PG8_ITER_R();
        }
    }
#undef PG8_ITER
#undef PG8_ITER_R
#undef PG8_WAIT_R
    PG8_WAIT_V(0);
    if constexpr (!ALIGN_EPI) { if (wr == 0) PG8_BAR; }
    PG8_BAR;
    if constexpr (Epi::AFTER_DRAIN) { E.fused(acc, cur, wr, wc, fr, fq, lds, wid, lane); S.done(cur); }
#undef PG8_SA
#undef PG8_SB
#undef PG8_STAGE
#undef PG8_SSP_DMA
#undef PG8_LDA
#undef PG8_LDB
#undef PG8_MMA
#undef PG8_WAIT_V
#undef PG8_WAIT_L
#undef PG8_BAR
#undef PG8_SCHED
}
}
namespace att {
#define LAS __attribute__((address_space(3)))
typedef unsigned short bf16_t;
typedef short bf16x8 __attribute__((ext_vector_type(8)));
typedef short s16x4 __attribute__((ext_vector_type(4)));
typedef float f32x16 __attribute__((ext_vector_type(16)));
typedef float f32x4 __attribute__((ext_vector_type(4)));
typedef unsigned u32x4 __attribute__((ext_vector_type(4)));
constexpr int LP = 2048, PADF = 48, PITCH = 3072;
constexpr int KV_BUF = 32768, V_OFF = 16384, OST_OFF = 65536, OST_PITCH = 272, OST_WAVE = 32 * OST_PITCH, WSF_OFF = OST_OFF + 8 * OST_WAVE, ATT_LDS = WSF_OFF + 8 * 256;
__device__ __forceinline__ int crow(int r, int hi) { return (r & 3) + 8 * (r >> 2) + 4 * hi; }
__device__ __forceinline__ unsigned cvtpk(float lo, float hi) { unsigned r; asm volatile("v_cvt_pk_bf16_f32 %0, %1, %2" : "=v"(r) : "v"(lo), "v"(hi)); return r; }
template <int K> __device__ __forceinline__ float swz_xor(float v) { return __builtin_bit_cast(float, __builtin_amdgcn_ds_swizzle(__builtin_bit_cast(int, v), (K << 10) | 0x1f)); }
__device__ __forceinline__ float xor32(float v) { const int ln = pg8::lane_id_v(); return __builtin_bit_cast(float, __builtin_amdgcn_ds_bpermute((ln ^ 32) << 2, __builtin_bit_cast(int, v))); }
__device__ __forceinline__ s16x4 vtr(const LAS unsigned char* p) { return __builtin_bit_cast(s16x4, __builtin_amdgcn_ds_read_tr16_b64_v4i16((LAS s16x4*)p)); }

__device__ __forceinline__ void stage_tile(LAS unsigned char* lds, int bufoff, const bf16_t* QKV, const bf16_t* MQKV, long rowbase, int h, int t, int wid, int lane) {
    const char* src = (t == 0) ? (const char*)MQKV : (const char*)(QKV + (size_t)(rowbase + 64 * (t - 1)) * PITCH);
    const unsigned voffK = (unsigned)lane * (PITCH * 2), voffV = (unsigned)(lane >> 2) * (PITCH * 2) + (unsigned)(lane & 3) * 16;
#pragma unroll
    for (int i = 0; i < 2; ++i) {
        const int ci = 2 * wid + i;
        const char* ks = src + (size_t)((1024 + h * 128 + ci * 8) * 2);
        __builtin_amdgcn_global_load_lds((const unsigned*)(ks + voffK), (LAS unsigned*)(lds + bufoff + ci * 1024), 16, 0, 0);
    }
#pragma unroll
    for (int i = 0; i < 2; ++i) {
        const int pi = 2 * wid + i, db = pi >> 2, kg = pi & 3;
        const char* vs = src + (size_t)(16 * kg) * (PITCH * 2) + (size_t)((2048 + h * 128 + db * 32) * 2);
        __builtin_amdgcn_global_load_lds((const unsigned*)(vs + voffV), (LAS unsigned*)(lds + bufoff + V_OFF + pi * 1024), 16, 0, 0);
    }
}

template <size_t OFF_QKV, size_t OFF_MQKV, size_t OFF_O> __device__ __forceinline__ void attn_unit(LAS unsigned char* lds, unsigned char* ws, int b, int h, int q0, int nqw, float lam, const float* subg, const int wid) {
    const bf16_t* QKV = (const bf16_t*)(ws + OFF_QKV); const bf16_t* MQKV = (const bf16_t*)(ws + OFF_MQKV); bf16_t* O = (bf16_t*)(ws + OFF_O);
    const int lane = pg8::lane_id_v(), r32 = lane & 31, hi = lane >> 5;
    const long rowbase = (long)b * LP;
    const int NT = (q0 + 32 * nqw) >> 6;
    const bool active = wid < nqw;
    const int qabs = q0 + 32 * wid + r32, qfirst = q0 + 32 * wid, qlast = qfirst + 31;
    LAS unsigned char* qw = lds + OST_OFF + wid * OST_WAVE + lane * 16;
    {
        const char* qb = (const char*)(QKV + (size_t)(rowbase + (active ? qfirst - 64 : 0)) * PITCH + h * 128);
        const bf16_t* qp = (const bf16_t*)(qb + ((unsigned)r32 * (PITCH * 2) + (unsigned)hi * 16));
#pragma unroll
        for (int j = 0; j < 8; ++j) *(LAS bf16x8*)(qw + j * 1024) = *(const bf16x8*)(qp + (j >> 2) * 64 + (j & 3) * 16);
    }
    f32x16 o[2][4];
#pragma unroll
    for (int c = 0; c < 2; ++c)
#pragma unroll
        for (int db = 0; db < 4; ++db)
#pragma unroll
            for (int r = 0; r < 16; ++r) o[c][db][r] = 0.f;
    float lsum[2] = {0.f, 0.f};
    stage_tile(lds, 0, QKV, MQKV, rowbase, h, 0, wid, lane);
    __syncthreads();
    stage_tile(lds, KV_BUF, QKV, MQKV, rowbase, h, 1, wid, lane);
    {   const int buf = 0;
    if (active) {
            const LAS unsigned char* kb = lds + buf + hi * 1024 + r32 * 16;
            const LAS unsigned char* vp = lds + buf + V_OFF + ((lane >> 4) & 1) * 32 + (lane & 3) * 8 + (4 * hi + ((lane & 15) >> 2)) * 64;
            f32x16 sA, sB;
#pragma unroll
            for (int r = 0; r < 16; ++r) { sA[r] = 0.f; sB[r] = 0.f; }
#pragma unroll
            for (int d0 = 0; d0 < 4; ++d0) {
                const bf16x8 ka = *(const LAS bf16x8*)(kb + (2 * d0) * 1024), kbb = *(const LAS bf16x8*)(kb + (8 + 2 * d0) * 1024);
                const bf16x8 qa = *(const LAS bf16x8*)(qw + d0 * 1024), qb = *(const LAS bf16x8*)(qw + (4 + d0) * 1024);
                sA = __builtin_amdgcn_mfma_f32_32x32x16_bf16(ka, qa, sA, 0, 0, 0);
                sB = __builtin_amdgcn_mfma_f32_32x32x16_bf16(kbb, qb, sB, 0, 0, 0);
            }
            float s0 = 0.f, s1 = 0.f;
#pragma unroll
            for (int r = 0; r < 8; ++r) { sA[r] = __builtin_amdgcn_exp2f(sA[r]); sB[r] = __builtin_amdgcn_exp2f(sB[r]); s0 += sA[r]; s1 += sB[r]; }
            lsum[0] += s0; lsum[1] += s1;
            const u32x4 pa = (u32x4){cvtpk(sA[0], sA[1]), cvtpk(sA[2], sA[3]), cvtpk(sA[4], sA[5]), cvtpk(sA[6], sA[7])};
            const u32x4 pb = (u32x4){cvtpk(sB[0], sB[1]), cvtpk(sB[2], sB[3]), cvtpk(sB[4], sB[5]), cvtpk(sB[6], sB[7])};
#pragma unroll
            for (int db = 0; db < 4; ++db) {
                const s16x4 lo_ = vtr(vp + db * 4096), hh_ = vtr(vp + db * 4096 + 512);
                const bf16x8 vf = (bf16x8){lo_[0], lo_[1], lo_[2], lo_[3], hh_[0], hh_[1], hh_[2], hh_[3]};
                o[0][db] = __builtin_amdgcn_mfma_f32_32x32x16_bf16(__builtin_bit_cast(bf16x8, pa), vf, o[0][db], 0, 0, 0);
                o[1][db] = __builtin_amdgcn_mfma_f32_32x32x16_bf16(__builtin_bit_cast(bf16x8, pb), vf, o[1][db], 0, 0, 0);
            }
    }
    }
    for (int t = 1; t < NT; ++t) {
        __syncthreads();
        const int buf = (t & 1) * KV_BUF;
        if (t + 1 < NT) stage_tile(lds, ((t + 1) & 1) * KV_BUF, QKV, MQKV, rowbase, h, t + 1, wid, lane);
        if (active && 64 * t <= qlast) {
            const bool needmask = (64 * t + 63 > qfirst);
            const LAS unsigned char* kb = lds + buf + hi * 1024 + r32 * 16;
            const LAS unsigned char* vp = lds + buf + V_OFF + ((lane >> 4) & 1) * 32 + (lane & 3) * 8 + (4 * hi + ((lane & 15) >> 2)) * 64;
            f32x16 sA0, sA1, sB0, sB1;
#pragma unroll
            for (int r = 0; r < 16; ++r) { sA0[r] = 0.f; sA1[r] = 0.f; sB0[r] = 0.f; sB1[r] = 0.f; }
            {
                bf16x8 fk0[3], fk1[3], fq_[3];
#define QK_LOAD(s_) do { fk0[(s_) % 3] = *(const LAS bf16x8*)(kb + (8 * ((s_) >> 2) + 2 * ((s_) & 3)) * 1024); fk1[(s_) % 3] = *(const LAS bf16x8*)(kb + (8 * ((s_) >> 2) + 2 * ((s_) & 3)) * 1024 + 512); \
                                 fq_[(s_) % 3] = *(const LAS bf16x8*)(qw + (s_) * 1024); } while (0)
                QK_LOAD(0); QK_LOAD(1);
                __builtin_amdgcn_sched_barrier(0);
#pragma unroll
                for (int s_ = 0; s_ < 8; ++s_) {
                    if (s_ + 2 < 8) QK_LOAD(s_ + 2);
                    if (s_ < 4) { sA0 = __builtin_amdgcn_mfma_f32_32x32x16_bf16(fk0[s_ % 3], fq_[s_ % 3], sA0, 0, 0, 0); sA1 = __builtin_amdgcn_mfma_f32_32x32x16_bf16(fk1[s_ % 3], fq_[s_ % 3], sA1, 0, 0, 0); }
                    else        { sB0 = __builtin_amdgcn_mfma_f32_32x32x16_bf16(fk0[s_ % 3], fq_[s_ % 3], sB0, 0, 0, 0); sB1 = __builtin_amdgcn_mfma_f32_32x32x16_bf16(fk1[s_ % 3], fq_[s_ % 3], sB1, 0, 0, 0); }
                    __builtin_amdgcn_sched_barrier(0);
                }
#undef QK_LOAD
            }
#define MASK1(P, R, LIM, OP, ADD) asm volatile("s_nop 0\n\t" OP " vcc, %2, %1\n\tv_cndmask_b32_e32 %0, 0, %0, vcc" : "+v"(P[R]) : "v"(LIM), "n"(((R) & 3) + 8 * ((R) >> 2) + (ADD)) : "vcc")
#define MASK16(P0, P1, LIM, OP) do { \
    MASK1(P0, 0, LIM, OP, 0); MASK1(P0, 1, LIM, OP, 0); MASK1(P0, 2, LIM, OP, 0); MASK1(P0, 3, LIM, OP, 0); MASK1(P0, 4, LIM, OP, 0); MASK1(P0, 5, LIM, OP, 0); MASK1(P0, 6, LIM, OP, 0); MASK1(P0, 7, LIM, OP, 0); \
    MASK1(P0, 8, LIM, OP, 0); MASK1(P0, 9, LIM, OP, 0); MASK1(P0, 10, LIM, OP, 0); MASK1(P0, 11, LIM, OP, 0); MASK1(P0, 12, LIM, OP, 0); MASK1(P0, 13, LIM, OP, 0); MASK1(P0, 14, LIM, OP, 0); MASK1(P0, 15, LIM, OP, 0); \
    MASK1(P1, 0, LIM, OP, 32); MASK1(P1, 1, LIM, OP, 32); MASK1(P1, 2, LIM, OP, 32); MASK1(P1, 3, LIM, OP, 32); MASK1(P1, 4, LIM, OP, 32); MASK1(P1, 5, LIM, OP, 32); MASK1(P1, 6, LIM, OP, 32); MASK1(P1, 7, LIM, OP, 32); \
    MASK1(P1, 8, LIM, OP, 32); MASK1(P1, 9, LIM, OP, 32); MASK1(P1, 10, LIM, OP, 32); MASK1(P1, 11, LIM, OP, 32); MASK1(P1, 12, LIM, OP, 32); MASK1(P1, 13, LIM, OP, 32); MASK1(P1, 14, LIM, OP, 32); MASK1(P1, 15, LIM, OP, 32); } while (0)
#define ATT_SOFTMAX(P0, P1, C, PW) do { \
                _Pragma("unroll") for (int r = 0; r < 16; ++r) { P0[r] = __builtin_amdgcn_exp2f(P0[r]); P1[r] = __builtin_amdgcn_exp2f(P1[r]); } \
                if (needmask) {        \
                    int mhi = qabs - 64 * t - 4 * hi; asm volatile("" : "+v"(mhi)); \
                    MASK16(P0, P1, mhi, "v_cmp_le_i32_e32"); \
                } \
                float s_ = 0.f; \
                _Pragma("unroll") for (int r = 0; r < 16; ++r) s_ += P0[r] + P1[r]; \
                lsum[C] += s_; \
                PW[0] = (u32x4){cvtpk(P0[0], P0[1]), cvtpk(P0[2], P0[3]), cvtpk(P0[4], P0[5]), cvtpk(P0[6], P0[7])}; \
                PW[1] = (u32x4){cvtpk(P0[8], P0[9]), cvtpk(P0[10], P0[11]), cvtpk(P0[12], P0[13]), cvtpk(P0[14], P0[15])}; \
                PW[2] = (u32x4){cvtpk(P1[0], P1[1]), cvtpk(P1[2], P1[3]), cvtpk(P1[4], P1[5]), cvtpk(P1[6], P1[7])}; \
                PW[3] = (u32x4){cvtpk(P1[8], P1[9]), cvtpk(P1[10], P1[11]), cvtpk(P1[12], P1[13]), cvtpk(P1[14], P1[15])}; } while (0)
            u32x4 pwA[4], pwB[4];
            ATT_SOFTMAX(sA0, sA1, 0, pwA);
            __builtin_amdgcn_sched_barrier(0);
            ATT_SOFTMAX(sB0, sB1, 1, pwB);
            __builtin_amdgcn_sched_barrier(0);
            {
                bf16x8 vr[4];
#define V_LOAD(i_) do { const s16x4 lo_ = vtr(vp + ((i_) & 3) * 4096 + ((i_) >> 2) * 1024), hh_ = vtr(vp + ((i_) & 3) * 4096 + ((i_) >> 2) * 1024 + 512); \
                                vr[(i_) & 3] = (bf16x8){lo_[0], lo_[1], lo_[2], lo_[3], hh_[0], hh_[1], hh_[2], hh_[3]}; } while (0)
                V_LOAD(0); V_LOAD(1); V_LOAD(2);
                __builtin_amdgcn_sched_barrier(0);
#pragma unroll
                for (int i_ = 0; i_ < 16; ++i_) {
                    if (i_ + 3 < 16) V_LOAD(i_ + 3);
                    o[0][i_ & 3] = __builtin_amdgcn_mfma_f32_32x32x16_bf16(__builtin_bit_cast(bf16x8, pwA[i_ >> 2]), vr[i_ & 3], o[0][i_ & 3], 0, 0, 0);
                    o[1][i_ & 3] = __builtin_amdgcn_mfma_f32_32x32x16_bf16(__builtin_bit_cast(bf16x8, pwB[i_ >> 2]), vr[i_ & 3], o[1][i_ & 3], 0, 0, 0);
                    __builtin_amdgcn_sched_barrier(0);
                }
#undef V_LOAD
            }
#undef ATT_SOFTMAX
#undef MASK1
#undef MASK16
        }
    }
    if (active) {
        const int lane_e = pg8::lane_id_v(), r32 = lane_e & 31, hi = lane_e >> 5;
        float l0 = lsum[0], l1 = lsum[1];
        l0 += xor32(l0); l1 += xor32(l1);
        LAS float* wsf = (LAS float*)(lds + WSF_OFF) + wid * 64;
        if (hi == 0) { wsf[r32] = l0; wsf[32 + r32] = l1; }
        asm volatile("s_waitcnt lgkmcnt(0)" ::: "memory");
#pragma unroll
        for (int r = 0; r < 16; ++r) { const float a0 = wsf[crow(r, hi)], a1 = wsf[32 + crow(r, hi)];
            const float rl0 = a0 > 0.f ? __builtin_amdgcn_rcpf(a0) : 0.f, rl1 = a1 > 0.f ? lam * __builtin_amdgcn_rcpf(a1) : 0.f; float s = 0.f;
#pragma unroll
            for (int db = 0; db < 4; ++db) { const float v = o[0][db][r] * rl0 - o[1][db][r] * rl1; o[0][db][r] = v; s += v * v; }
            s += swz_xor<1>(s); s += swz_xor<2>(s); s += swz_xor<4>(s); s += swz_xor<8>(s); s += swz_xor<16>(s);
            const float rn = rsqrtf(s * (1.0f / 128.0f) + 1e-6f) * 0.8f;
#pragma unroll
            for (int db = 0; db < 4; ++db) o[0][db][r] *= rn; }
        LAS unsigned short* stg = (LAS unsigned short*)(lds + OST_OFF + wid * OST_WAVE);
#pragma unroll
        for (int db = 0; db < 4; ++db) { const float sg = subg[db * 32 + r32];
#pragma unroll
            for (int r = 0; r < 16; ++r) { const unsigned w = cvtpk(o[0][db][r] * sg, 0.f); stg[crow(r, hi) * (OST_PITCH / 2) + db * 32 + r32] = (unsigned short)(w & 0xffffu); } }
        asm volatile("s_waitcnt lgkmcnt(0)" ::: "memory");
        int lsel = lane_e;
        bf16_t* Ow = O + (size_t)(rowbase + qfirst - 64 + (lsel >> 4)) * 1024 + h * 128 + (lsel & 15) * 8;
        const LAS unsigned char* sp = (const LAS unsigned char*)stg + (lsel >> 4) * OST_PITCH + (lsel & 15) * 16;
#pragma unroll
        for (int it = 0; it < 8; ++it) { const u32x4 v = *(const LAS u32x4*)(sp + it * 4 * OST_PITCH); *(u32x4*)Ow = v; Ow += 4 * 1024; asm volatile("" : "+v"(Ow)); }
    }
    __syncthreads();
}
}
typedef unsigned short bf16;
typedef unsigned v4u __attribute__((ext_vector_type(4)));
typedef float f32x4 __attribute__((ext_vector_type(4)));
typedef short bf16x8 __attribute__((ext_vector_type(8)));
constexpr int NWAVES = 8;
#ifndef MK_PER_PHASE
#define MK_PER_PHASE 0
#endif
constexpr int NPHASE = 13;
#ifndef PROBE_DUP
#define PROBE_DUP -1
#endif
#define REPS(k) for (int rep_ = 0; rep_ < ((PROBE_DUP) == (k) ? 2 : 1); ++rep_)
constexpr int D = 1024, NB = 32, SEQ = 2048, LTOK = 2064, NMETA = 16, LP = 2048, MP = NB * LP;
constexpr int NQKV = 3072, DFF = 2816, NGU = 5632;
constexpr size_t al256(size_t x) { return (x + 255) & ~(size_t)255; }
constexpr size_t WS_WQKV = 0;
constexpr size_t WS_WO   = WS_WQKV + (size_t)NQKV * D * 2;
constexpr size_t WS_WGU0 = WS_WO + (size_t)D * D * 2;
constexpr size_t WS_WD0  = WS_WGU0 + (size_t)NGU * D * 2;
constexpr size_t WS_WIN  = WS_WD0 + (size_t)D * DFF * 2;
constexpr size_t WS_WOUT = WS_WIN + (size_t)NQKV * D * 2;
constexpr size_t WS_WGU1 = WS_WOUT + (size_t)D * D * 2;
constexpr size_t WS_WD1  = WS_WGU1 + (size_t)NGU * D * 2;
constexpr size_t WS_ROPE = WS_WD1 + (size_t)D * DFF * 2;
constexpr size_t WS_SSP  = WS_ROPE + al256((size_t)LTOK * 32 * 2 * 4);
constexpr size_t WS_H    = WS_SSP + (size_t)MP * 16 * 4;
constexpr size_t WS_XB   = WS_H;
constexpr size_t WS_BIG  = WS_XB + (size_t)MP * D * 2;
constexpr size_t WS_O    = WS_BIG + (size_t)MP * NQKV * 2;
constexpr size_t WS_MXB  = WS_O + (size_t)MP * D * 2;
constexpr size_t WS_MRS  = WS_MXB + 16 * 1024 * 2;
constexpr size_t WS_MC1  = WS_MRS + 256;
constexpr size_t WS_MQKV = WS_MC1 + 16 * 3072 * 4;
constexpr size_t WS_MOM  = WS_MQKV + 64 * 3072 * 2;
constexpr size_t WS_MC2  = WS_MOM + 16 * 1024 * 2;
constexpr size_t WS_MC3  = WS_MC2 + 16 * 1024 * 4;
constexpr size_t WS_MH1  = WS_MC3 + 16 * 5632 * 4;
constexpr size_t WS_MHID = WS_MH1 + 16 * 1024 * 4;
constexpr size_t WS_MC4  = WS_MHID + 16 * 2816 * 2;
constexpr size_t WS_MC5  = WS_MC4 + 16 * 1024 * 4;
constexpr size_t WS_MZ   = WS_MC5 + 16 * 2048 * 4;
constexpr size_t WS_RS0  = WS_MZ + 16 * 1024 * 2;
constexpr size_t WS_CTL  = WS_RS0 + (size_t)MP * 4;
constexpr size_t CTL_BYTES = 16384;
constexpr size_t WS_END  = WS_CTL + CTL_BYTES;
constexpr int LDS_BYTES = 149504;
static_assert(att::ATT_LDS <= LDS_BYTES && pg8::STAGE_BYTES <= LDS_BYTES, "LDS map");

__device__ __forceinline__ unsigned f2bf(float f) { unsigned u = __builtin_bit_cast(unsigned, f); return (u + 0x7fffu + ((u >> 16) & 1u)) >> 16; }
__device__ __forceinline__ unsigned pk2(float lo, float hi) { return f2bf(lo) | (f2bf(hi) << 16); }
__device__ __forceinline__ float wave_sum(float v) {
#pragma unroll
    for (int o = 1; o < 64; o <<= 1) v += __shfl_xor(v, o);
    return v;
}
__device__ __forceinline__ float wave_max(float v) {
#pragma unroll
    for (int o = 1; o < 64; o <<= 1) v = fmaxf(v, __shfl_xor(v, o));
    return v;
}
__device__ __forceinline__ int col_perm(int mode, int n) {
    if (mode == 1) return (n & ~255) + 128 * ((n >> 5) & 1) + 32 * ((n >> 6) & 3) + (n & 31);
    if (mode == 2) { const int up = n >= DFF ? 1 : 0, j = n - up * DFF; return 256 * (j >> 7) + 128 * up + (j & 127); }
    if (mode == 3) { if (n < 1024) return 2048 + n; const int up = n >= 2048 ? 1 : 0, j = (n - 1024) & 1023; return 256 * (j >> 7) + 128 * up + (j & 127); }
    return n;
}
__device__ __forceinline__ void transpose_item(const float* W, int K, int N, bf16* WT, const float* gain, int mode, LAS float* scr, int item, int lane) {
    const int nblk = N / 32, kb = item / nblk, nb = item % nblk, k0 = 64 * kb, n0 = 32 * nb;
#pragma unroll 8
    for (int i = 0; i < 32; ++i) { const int kk = 2 * i + (lane >> 5); scr[kk * 33 + (lane & 31)] = W[(size_t)(k0 + kk) * N + n0 + (lane & 31)]; }
    asm volatile("s_waitcnt lgkmcnt(0)" ::: "memory");
    const int c = lane & 7;
    float gv[8];
#pragma unroll
    for (int e = 0; e < 8; ++e) gv[e] = gain ? gain[k0 + 8 * c + e] : 1.0f;
#pragma unroll
    for (int j = 0; j < 4; ++j) { const int n = (lane >> 3) + 8 * j; const LAS float* s = scr + (8 * c) * 33 + n;
        v4u o; o.x = pk2(s[0 * 33] * gv[0], s[1 * 33] * gv[1]); o.y = pk2(s[2 * 33] * gv[2], s[3 * 33] * gv[3]); o.z = pk2(s[4 * 33] * gv[4], s[5 * 33] * gv[5]); o.w = pk2(s[6 * 33] * gv[6], s[7 * 33] * gv[7]);
        *(v4u*)(WT + (size_t)col_perm(mode, n0 + n) * K + k0 + 8 * c) = o; }
    asm volatile("s_waitcnt lgkmcnt(0)" ::: "memory");
}
__device__ __forceinline__ void sincos_acc(float angf, float& c, float& s) {
    const double TWO_PI = 6.283185307179586476925286766559;
    double a = (double)angf; const double n = rint(a / TWO_PI); double r = a - n * TWO_PI;
    const double r2 = r * r; double cs = 1.0, sn = r, tc = 1.0, ts = r;
#pragma unroll 1
    for (int k = 1; k <= 14; ++k) { tc = -tc * r2 / (double)((2 * k - 1) * (2 * k)); ts = -ts * r2 / (double)((2 * k) * (2 * k + 1)); cs += tc; sn += ts; }
    c = (float)cs; s = (float)sn;
}

#define XB_TMO      128
#define XB_XCNT(j)  (256  + 64 * (j))
#define XB_XSUB(j)  (1280 + 64 * (j))
#define XB_XGEN(j)  (2304 + 64 * (j))
#define XB_TOP      3328
#define XB_TOPGEN   3392
#define XCD_BAR_WORDS 3456
#define XB_SPIN_CAP (1u << 18)

__device__ __forceinline__ unsigned xb_ld(unsigned* p)              { return __hip_atomic_load(p, __ATOMIC_RELAXED, __HIP_MEMORY_SCOPE_AGENT); }
__device__ __forceinline__ unsigned xb_add(unsigned* p, unsigned v) { return __hip_atomic_fetch_add(p, v, __ATOMIC_RELAXED, __HIP_MEMORY_SCOPE_AGENT); }
__device__ __forceinline__ unsigned xb_xcc_id() { return (unsigned)__builtin_amdgcn_s_getreg((3 << 11) | 20) & 0xFu; }
#define XB_SPIN(cond, bar) do { unsigned _sp = 0; while (cond) { __builtin_amdgcn_s_sleep(1); \
    if ((++_sp & 255u) == 0u) { if (xb_ld(&(bar)[XB_TMO])) break; if (_sp > XB_SPIN_CAP) { atomicAdd(&(bar)[XB_TMO], 1u); break; } } } } while (0)

struct XcdBarrier {
    unsigned* bar; unsigned x;
    volatile LAS unsigned* st;
};

__device__ __forceinline__ XcdBarrier xcd_barrier_post(unsigned* bar, volatile LAS unsigned* st) {
    XcdBarrier b; b.bar = bar; b.x = xb_xcc_id(); b.st = st;
    if (threadIdx.x == 0) (void)xb_add(&bar[XB_XCNT(b.x)], 1u);
    return b;
}
__device__ __forceinline__ void xcd_barrier_complete(unsigned* bar, unsigned x, unsigned& nloc, unsigned& nx) {
    const unsigned G = gridDim.x * gridDim.y * gridDim.z;
    unsigned sum, cnt, mine, sp = 0u;
    for (;;) {
        sum = 0u; cnt = 0u; mine = 0u;
#pragma unroll
        for (unsigned j = 0; j < 16; ++j) { const unsigned c = xb_ld(&bar[XB_XCNT(j)]); sum += c; cnt += (c > 0u) ? 1u : 0u; mine = (j == x) ? c : mine; }
        if (sum == G) break;
        __builtin_amdgcn_s_sleep(1);
        if ((++sp & 255u) == 0u) { if (xb_ld(&bar[XB_TMO])) break; if (sp > XB_SPIN_CAP) { atomicAdd(&bar[XB_TMO], 1u); break; } }
    }
    nloc = mine > 0u ? mine : 1u; nx = cnt > 0u ? cnt : 1u;
}

__device__ __forceinline__ void xcd_barrier(const XcdBarrier& b) {
    asm volatile("s_waitcnt vmcnt(0)" ::: "memory");
    __syncthreads();
    if (threadIdx.x == 0) {
        unsigned* bar = b.bar;
        __builtin_amdgcn_s_waitcnt(0);
        unsigned nloc = b.st[0], nx = b.st[1];
        if (nloc == 0u) { xcd_barrier_complete(bar, b.x, nloc, nx); b.st[0] = nloc; b.st[1] = nx; }
        const unsigned old = xb_add(&bar[XB_XSUB(b.x)], 1u);
        const unsigned gen = old / nloc;
        if (old + 1u == (gen + 1u) * nloc) {
            __builtin_amdgcn_fence(__ATOMIC_RELEASE, "agent");
            asm volatile("s_waitcnt vmcnt(0)" ::: "memory");
            const unsigned og = xb_add(&bar[XB_TOP], 1u);
            const unsigned tg = og / nx;
            if (og + 1u == (tg + 1u) * nx) xb_add(&bar[XB_TOPGEN], 1u);
            else XB_SPIN(xb_ld(&bar[XB_TOPGEN]) == tg, bar);
            __builtin_amdgcn_fence(__ATOMIC_ACQUIRE, "agent");
            xb_add(&bar[XB_XGEN(b.x)], 1u);
            asm volatile("s_waitcnt vmcnt(0)" ::: "memory");
        } else {
            XB_SPIN(xb_ld(&bar[XB_XGEN(b.x)]) == gen, bar);
            __builtin_amdgcn_fence(__ATOMIC_ACQUIRE, "agent");
            asm volatile("s_waitcnt vmcnt(0)" ::: "memory");
        }
    }
    __syncthreads();
}

constexpr int MISC_OFF = LDS_BYTES - 64;
struct Args { const float* in[18]; float* out; unsigned char* ws; int ph_lo, ph_hi; };

__device__ __forceinline__ void weight_items(const Args& a, LAS unsigned char* lds, int wave, int lane, int gw, int NGW, int it_lo, int it_hi) {
    unsigned char* ws = a.ws;
    LAS float* scr = (LAS float*)(lds + wave * 16384);
    const float* mix_g = a.in[2]; const float* ffn_g = a.in[3];
    constexpr int I_QKV = (D / 64) * (NQKV / 32), I_O = (D / 64) * (D / 32), I_GU = (D / 64) * (NGU / 32), I_DN = (DFF / 64) * (D / 32);
    for (int it = it_lo + gw; it < it_hi; it += NGW) {
        int r = it;
        if (r < I_QKV) { transpose_item(a.in[4], D, NQKV, (bf16*)(ws + WS_WQKV), mix_g, 1, scr, r, lane); continue; } r -= I_QKV;
        if (r < I_O)   { transpose_item(a.in[12], D, D, (bf16*)(ws + WS_WO), nullptr, 0, scr, r, lane); continue; } r -= I_O;
        if (r < I_GU)  { transpose_item(a.in[16], D, NGU, (bf16*)(ws + WS_WGU0), ffn_g, 2, scr, r, lane); continue; } r -= I_GU;
        if (r < I_DN)  { transpose_item(a.in[17], DFF, D, (bf16*)(ws + WS_WD0), nullptr, 0, scr, r, lane); continue; } r -= I_DN;
        if (r < I_QKV) { transpose_item(a.in[13], D, NQKV, (bf16*)(ws + WS_WIN), mix_g + D, 3, scr, r, lane); continue; } r -= I_QKV;
        if (r < I_O)   { transpose_item(a.in[15], D, D, (bf16*)(ws + WS_WOUT), nullptr, 0, scr, r, lane); continue; } r -= I_O;
        if (r < I_GU)  { transpose_item(a.in[16] + (size_t)D * NGU, D, NGU, (bf16*)(ws + WS_WGU1), ffn_g + D, 2, scr, r, lane); continue; } r -= I_GU;
        transpose_item(a.in[17] + (size_t)DFF * D, DFF, D, (bf16*)(ws + WS_WD1), nullptr, 0, scr, r, lane);
    }
}
constexpr int W_ITEMS_L0 = (D / 64) * (NQKV / 32) + (D / 64) * (D / 32) + (D / 64) * (NGU / 32) + (DFF / 64) * (D / 32), W_ITEMS = 2 * W_ITEMS_L0;
__device__ __forceinline__ void prologue(const Args& a, LAS unsigned char* lds, int wave, int lane, int gw, int NGW) {
    unsigned char* ws = a.ws;
    weight_items(a, lds, wave, lane, gw, NGW, 0, W_ITEMS_L0);
    { float* rope = (float*)(ws + WS_ROPE);
      for (int e = gw * 64 + lane; e < LTOK * 32; e += NGW * 64) { const int pos = e >> 5, i = e & 31;
          const float inv = (float)exp(-9.210340371976184 * (double)(2 * i) / 64.0);
          const float ang = (float)pos * inv; float c, s; sincos_acc(ang, c, s); rope[2 * e] = c; rope[2 * e + 1] = s; } }
    { const float* x = a.in[0]; bf16* XB = (bf16*)(ws + WS_XB); float* rs0 = (float*)(ws + WS_RS0);
      for (int m = gw; m < MP; m += NGW) {
          const float* src = x + (size_t)m * D;
          f32x4 v[4]; float s = 0.f;
#pragma unroll
          for (int j = 0; j < 4; ++j) { v[j] = *((const f32x4*)src + 64 * j + lane); s += (v[j][0] * v[j][0] + v[j][1] * v[j][1]) + (v[j][2] * v[j][2] + v[j][3] * v[j][3]); }
          s = wave_sum(s);
#pragma unroll
          for (int j = 0; j < 4; ++j) *((unsigned long long*)(XB + (size_t)m * D) + 64 * j + lane) = (unsigned long long)pk2(v[j][0], v[j][1]) | ((unsigned long long)pk2(v[j][2], v[j][3]) << 32);
          if (lane == 0) rs0[m] = s; } }
    { const float* meta = a.in[1]; bf16* MXB = (bf16*)(ws + WS_MXB); float* mrs = (float*)(ws + WS_MRS);
      if (gw < NMETA) { const int m = gw; const float* src = meta + (size_t)m * D; f32x4 v[4]; float s = 0.f;
#pragma unroll
          for (int j = 0; j < 4; ++j) { v[j] = *((const f32x4*)src + 64 * j + lane); s += (v[j][0] * v[j][0] + v[j][1] * v[j][1]) + (v[j][2] * v[j][2] + v[j][3] * v[j][3]); }
          s = wave_sum(s);
#pragma unroll
          for (int j = 0; j < 4; ++j) *((unsigned long long*)(MXB + (size_t)m * D) + 64 * j + lane) = (unsigned long long)pk2(v[j][0], v[j][1]) | ((unsigned long long)pk2(v[j][2], v[j][3]) << 32);
          if (lane == 0) mrs[m] = s; }
      v4u* mz = (v4u*)(ws + WS_MQKV + 16 * 3072 * 2);
      for (int e = gw * 64 + lane; e < 48 * 3072 * 2 / 16; e += NGW * 64) mz[e] = (v4u){0u, 0u, 0u, 0u};
      for (int e = gw * 64 + lane; e < 16 * 3072 / 4; e += NGW * 64) ((v4u*)(ws + WS_MC1))[e] = (v4u){0u, 0u, 0u, 0u};
      for (int e = gw * 64 + lane; e < 16 * 1024 / 4; e += NGW * 64) { ((v4u*)(ws + WS_MC2))[e] = (v4u){0u, 0u, 0u, 0u}; ((v4u*)(ws + WS_MC4))[e] = (v4u){0u, 0u, 0u, 0u}; }
      for (int e = gw * 64 + lane; e < 16 * 5632 / 4; e += NGW * 64) ((v4u*)(ws + WS_MC3))[e] = (v4u){0u, 0u, 0u, 0u};
      for (int e = gw * 64 + lane; e < 16 * 2048 / 4; e += NGW * 64) ((v4u*)(ws + WS_MC5))[e] = (v4u){0u, 0u, 0u, 0u}; }
}
constexpr int SK_KS = 8;
template <int AMODE> __device__ __forceinline__ void skinny_gemm(const bf16* A, const float* P, const float* Q, int K, const bf16* Bt, int mode, int n_src0, int ntiles, float* C, int ldc, int gwp, int NGW, int lane) {
    const int fr = lane & 15, fq = lane >> 4, kslice = K / SK_KS;
    for (int task = gwp; task < ntiles * SK_KS; task += NGW) {
        const int tile = task / SK_KS, k0 = (task % SK_KS) * kslice;
        const bf16* bp = Bt + (size_t)col_perm(mode, n_src0 + tile * 16 + fr) * K + 8 * fq;
        f32x4 acc = {0.f, 0.f, 0.f, 0.f};
#pragma unroll 4
        for (int kk = k0; kk < k0 + kslice; kk += 32) {
            bf16x8 av;
            if (AMODE == 0) av = *(const bf16x8*)(A + (size_t)fr * K + kk + 8 * fq);
            else { const float* pp = P + (size_t)fr * K + kk + 8 * fq; const float* qq = Q + (size_t)fr * K + kk + 8 * fq;
                const f32x4 p0 = *(const f32x4*)pp, p1 = *(const f32x4*)(pp + 4), q0 = *(const f32x4*)qq, q1 = *(const f32x4*)(qq + 4);
                v4u t; t.x = pk2(p0[0] + q0[0], p0[1] + q0[1]); t.y = pk2(p0[2] + q0[2], p0[3] + q0[3]); t.z = pk2(p1[0] + q1[0], p1[1] + q1[1]); t.w = pk2(p1[2] + q1[2], p1[3] + q1[3]);
                av = __builtin_bit_cast(bf16x8, t); }
            const bf16x8 bv = *(const bf16x8*)(bp + kk);
            acc = __builtin_amdgcn_mfma_f32_16x16x32_bf16(av, bv, acc, 0, 0, 0);
        }
#pragma unroll
        for (int j = 0; j < 4; ++j) __hip_atomic_fetch_add(C + (size_t)(4 * fq + j) * ldc + tile * 16 + fr, acc[j], __ATOMIC_RELAXED, __HIP_MEMORY_SCOPE_AGENT);
    }
}
__device__ __forceinline__ void meta_e1(const Args& a, LAS unsigned char* lds, int wave, int lane, int h, int r) {
    unsigned char* ws = a.ws;
    const float* C1 = (const float*)(ws + WS_MC1); const float* mrs = (const float*)(ws + WS_MRS); const float* rope = (const float*)(ws + WS_ROPE);
    bf16* MQ = (bf16*)(ws + WS_MQKV); bf16* OM = (bf16*)(ws + WS_MOM);
    const float* qg = a.in[5]; const float* kg = a.in[6]; const float* subg = a.in[11];
    const float lam = expf(wave_sum(a.in[7][lane] * a.in[8][lane])) - expf(wave_sum(a.in[9][lane] * a.in[10][lane])) + 0.2f;
    LAS float* kl = (LAS float*)(lds + wave * 16384);
    LAS float* vl = kl + 2048;
    const int i = lane & 31; const float kgl = kg[lane];
#pragma unroll 4
    for (int rp = 0; rp <= r; ++rp) {
        const float rs = rsqrtf(mrs[rp] * (1.0f / 1024.0f) + 1e-6f);
        const float cs = rope[(rp * 32 + i) * 2], sn = rope[(rp * 32 + i) * 2 + 1];
#pragma unroll
        for (int c = 0; c < 2; ++c) {
            float x = C1[(size_t)rp * 3072 + 1024 + h * 128 + c * 64 + lane] * rs;
            const float ss = wave_sum(x * x); x = x * rsqrtf(ss * (1.0f / 64.0f) + 1e-6f) * kgl;
            const float pr = __shfl_xor(x, 32); const float o = lane < 32 ? x * cs - pr * sn : x * cs + pr * sn;
            kl[(c * 16 + rp) * 64 + lane] = o;
            if (rp == r) MQ[(size_t)r * 3072 + 1024 + h * 128 + c * 64 + lane] = (bf16)f2bf(o);
        }
#pragma unroll
        for (int hf = 0; hf < 2; ++hf) { const float v = C1[(size_t)rp * 3072 + 2048 + h * 128 + hf * 64 + lane] * rs; vl[rp * 128 + hf * 64 + lane] = v;
            if (rp == r) MQ[(size_t)r * 3072 + 2048 + h * 128 + hf * 64 + lane] = (bf16)f2bf(v); }
    }
    asm volatile("s_waitcnt lgkmcnt(0)" ::: "memory");
    {
        const float rs = rsqrtf(mrs[r] * (1.0f / 1024.0f) + 1e-6f);
        const float cs = rope[(r * 32 + i) * 2], sn = rope[(r * 32 + i) * 2 + 1];
        float q0, q1;
        { float x = C1[(size_t)r * 3072 + h * 128 + lane] * rs; const float ss = wave_sum(x * x); x = x * rsqrtf(ss * (1.0f / 64.0f) + 1e-6f) * qg[lane];
          const float pr = __shfl_xor(x, 32); q0 = (lane < 32 ? x * cs - pr * sn : x * cs + pr * sn) * pg8::QSCALE_; }
        { float x = C1[(size_t)r * 3072 + h * 128 + 64 + lane] * rs; const float ss = wave_sum(x * x); x = x * rsqrtf(ss * (1.0f / 64.0f) + 1e-6f) * qg[lane];
          const float pr = __shfl_xor(x, 32); q1 = (lane < 32 ? x * cs - pr * sn : x * cs + pr * sn) * pg8::QSCALE_; }
        float l0 = 0.f, l1 = 0.f, o0a = 0.f, o0b = 0.f, o1a = 0.f, o1b = 0.f;
#pragma unroll 4
        for (int rp = 0; rp <= r; ++rp) {
            const float s0 = wave_sum(q0 * kl[rp * 64 + lane]), s1 = wave_sum(q1 * kl[(16 + rp) * 64 + lane]);
            const float p0 = __builtin_amdgcn_exp2f(s0), p1 = __builtin_amdgcn_exp2f(s1); l0 += p0; l1 += p1;
            const float va = vl[rp * 128 + lane], vb = vl[rp * 128 + 64 + lane];
            o0a += p0 * va; o0b += p0 * vb; o1a += p1 * va; o1b += p1 * vb;
        }
        const float oa = o0a / l0 - lam * o1a / l1, ob = o0b / l0 - lam * o1b / l1;
        const float rn = rsqrtf(wave_sum(oa * oa + ob * ob) * (1.0f / 128.0f) + 1e-6f) * 0.8f;
        OM[(size_t)r * 1024 + h * 128 + lane] = (bf16)f2bf(oa * rn * subg[lane]); OM[(size_t)r * 1024 + h * 128 + 64 + lane] = (bf16)f2bf(ob * rn * subg[64 + lane]);
    }
    asm volatile("s_waitcnt lgkmcnt(0)" ::: "memory");
}
__device__ __forceinline__ void meta_e3(const Args& a, int gwp, int NGW, int lane) {
    unsigned char* ws = a.ws; const float* meta = a.in[1]; const float* C2 = (const float*)(ws + WS_MC2); float* H1 = (float*)(ws + WS_MH1);
    const float* C3 = (const float*)(ws + WS_MC3); bf16* HID = (bf16*)(ws + WS_MHID);
    for (int task = gwp; task < 16 * (DFF / 64); task += NGW) { const int r = task / (DFF / 64), ch = task - r * (DFF / 64); float s = 0.f; f32x4 v[4];
#pragma unroll
        for (int j = 0; j < 4; ++j) { v[j] = *((const f32x4*)(meta + (size_t)r * D) + 64 * j + lane) + *((const f32x4*)(C2 + (size_t)r * D) + 64 * j + lane); s += (v[j][0] * v[j][0] + v[j][1] * v[j][1]) + (v[j][2] * v[j][2] + v[j][3] * v[j][3]); }
        if (ch == 0) {
#pragma unroll
            for (int j = 0; j < 4; ++j) *((f32x4*)(H1 + (size_t)r * D) + 64 * j + lane) = v[j]; }
        const float rs = rsqrtf(wave_sum(s) * (1.0f / 1024.0f) + 1e-6f);
        const int j = 64 * ch + lane; const float g = C3[(size_t)r * NGU + j] * rs, u = C3[(size_t)r * NGU + DFF + j] * rs;
        HID[(size_t)r * DFF + j] = (bf16)f2bf(g * __builtin_amdgcn_rcpf(1.0f + __expf(-g)) * u); }
}
__device__ __forceinline__ void meta_e5(const Args& a, int gwp, int NGW, int lane) {
    unsigned char* ws = a.ws; const float* H1 = (const float*)(ws + WS_MH1); const float* C4 = (const float*)(ws + WS_MC4);
    const float* C5 = (const float*)(ws + WS_MC5); bf16* MZ = (bf16*)(ws + WS_MZ);
    for (int task = gwp; task < 16 * (D / 64); task += NGW) { const int r = task >> 4, ch = task & 15; float s = 0.f;
#pragma unroll
        for (int j = 0; j < 4; ++j) { const f32x4 v = *((const f32x4*)(H1 + (size_t)r * D) + 64 * j + lane) + *((const f32x4*)(C4 + (size_t)r * D) + 64 * j + lane); s += (v[0] * v[0] + v[1] * v[1]) + (v[2] * v[2] + v[3] * v[3]); }
        const float rs = rsqrtf(wave_sum(s) * (1.0f / 1024.0f) + 1e-6f);
        const int j = 64 * ch + lane;
        MZ[(size_t)r * D + j] = (bf16)f2bf((C5[(size_t)r * 2048 + j] * rs) * (C5[(size_t)r * 2048 + 1024 + j] * rs)); }
}
__device__ __forceinline__ void conv_phase(const Args& a, int lane, int gw, int NGW) {
    const bf16* Z = (const bf16*)(a.ws + WS_BIG); const bf16* GB = Z + (size_t)MP * D; bf16* Y = (bf16*)(a.ws + WS_O); const float* cw = a.in[14];
    for (int it = gw; it < (MP / 16) * 2; it += NGW) {
        const int rb = (MP / 16 - 1) - (it >> 1), col = (it & 1) * 512 + lane * 8, row0 = rb * 16, p0 = row0 % LP;
        float w0[8], w1[8], w2[8], zm2[8], zm1[8];
#pragma unroll
        for (int e = 0; e < 8; ++e) { w0[e] = cw[col + e]; w1[e] = cw[D + col + e]; w2[e] = cw[2 * D + col + e]; zm2[e] = 0.f; zm1[e] = 0.f; }
        { const bf16* MZ = (const bf16*)(a.ws + WS_MZ);
          const v4u a2 = *(const v4u*)(p0 != 0 ? Z + (size_t)(row0 - 2) * D + col : MZ + 14 * D + col), a1 = *(const v4u*)(p0 != 0 ? Z + (size_t)(row0 - 1) * D + col : MZ + 15 * D + col);
#pragma unroll
            for (int e = 0; e < 4; ++e) { zm2[2 * e] = __uint_as_float(a2[e] << 16); zm2[2 * e + 1] = __uint_as_float(a2[e] & 0xffff0000u); zm1[2 * e] = __uint_as_float(a1[e] << 16); zm1[2 * e + 1] = __uint_as_float(a1[e] & 0xffff0000u); } }
#pragma unroll 4
        for (int i = 0; i < 16; ++i) { const size_t off = (size_t)(row0 + i) * D + col; const v4u zz = *(const v4u*)(Z + off), gg = *(const v4u*)(GB + off);
            float z[8], g[8], y[8];
#pragma unroll
            for (int e = 0; e < 4; ++e) { z[2 * e] = __uint_as_float(zz[e] << 16); z[2 * e + 1] = __uint_as_float(zz[e] & 0xffff0000u); g[2 * e] = __uint_as_float(gg[e] << 16); g[2 * e + 1] = __uint_as_float(gg[e] & 0xffff0000u); }
#pragma unroll
            for (int e = 0; e < 8; ++e) { y[e] = g[e] * (w0[e] * zm2[e] + w1[e] * zm1[e] + w2[e] * z[e]); zm2[e] = zm1[e]; zm1[e] = z[e]; }
            v4u o; o.x = pk2(y[0], y[1]); o.y = pk2(y[2], y[3]); o.z = pk2(y[4], y[5]); o.w = pk2(y[6], y[7]);
            *(v4u*)(Y + off) = o; }
    }
}

__global__ void __launch_bounds__(NWAVES * 64, 2) mega_fwd(Args args) {
    extern __shared__ __attribute__((aligned(16))) unsigned char lds_raw[];
    LAS unsigned char* lds = (LAS unsigned char*)lds_raw;
    cg::grid_group grid = cg::this_grid();
    const int wave = __builtin_amdgcn_readfirstlane(threadIdx.x >> 6);
    const int G = gridDim.x, gw = blockIdx.x * NWAVES + wave, NGW = G * NWAVES, gwp = wave * G + (int)blockIdx.x;
    unsigned char* ws = args.ws;
    bf16* XB = (bf16*)(ws + WS_XB); float* SSP = (float*)(ws + WS_SSP); bf16* BIG = (bf16*)(ws + WS_BIG); bf16* OB = (bf16*)(ws + WS_O);
    const int lo = args.ph_lo, hi = args.ph_hi;
    if (threadIdx.x < 16) ((LAS unsigned*)(lds + MISC_OFF))[threadIdx.x] = 0u;
    __syncthreads();
    XcdBarrier bar = xcd_barrier_post((unsigned*)(ws + WS_CTL), (volatile LAS unsigned*)(lds + MISC_OFF));
#ifndef PHASE_MASK
#define PHASE_MASK 0x1fff
#endif
#define IN(k) (((PHASE_MASK >> (k)) & 1) && lo <= (k) && (k) < hi)
#define SEAM(k) do { if (IN(k) && IN((k) + 1)) { if ((k) == 0) grid.sync(); else xcd_barrier(bar); } } while (0)
    bf16* MXB = (bf16*)(ws + WS_MXB); const bf16* MQKV = (const bf16*)(ws + WS_MQKV);
    if (IN(0)) REPS(0) { prologue(args, lds, wave, pg8::lane_id_v(), gw, NGW); }
    SEAM(0);
    if (IN(1)) {
        skinny_gemm<0>(MXB, nullptr, nullptr, D, (const bf16*)(ws + WS_WQKV), 1, 0, NQKV / 16, (float*)(ws + WS_MC1), NQKV, gwp, NGW, pg8::lane_id_v());
    }
    SEAM(1);
    if (IN(2)) {
        if (gwp < 128) meta_e1(args, lds, wave, pg8::lane_id_v(), gwp & 7, 15 - (gwp >> 3));
        else weight_items(args, lds, wave, pg8::lane_id_v(), gwp - 128, NGW - 128, W_ITEMS_L0, W_ITEMS);
    }
    SEAM(2);
    if (IN(3)) REPS(3) {
        skinny_gemm<0>((const bf16*)(ws + WS_MOM), nullptr, nullptr, D, (const bf16*)(ws + WS_WO), 0, 0, D / 16, (float*)(ws + WS_MC2), D, gwp, NGW, pg8::lane_id_v());
        pg8::Gemm g{XB, (const bf16*)(ws + WS_WQKV), MP, NQKV, D}; pg8::StaticOrder S; S.init(MP, NQKV, G, (int)blockIdx.x);
        pg8::EpiQKV E{BIG, (const float*)(ws + WS_RS0), (const float*)(ws + WS_ROPE), args.in[5], args.in[6], lds + pg8::SSPL_OFF};
        pg8::gemm_phase<pg8::EpiQKV, pg8::StaticOrder, true, true>(lds, g, S, E, wave);
    }
    SEAM(3);
    if (IN(4)) REPS(4) {
        skinny_gemm<1>(nullptr, args.in[1], (const float*)(ws + WS_MC2), D, (const bf16*)(ws + WS_WGU0), 2, 0, NGU / 16, (float*)(ws + WS_MC3), NGU, gwp, NGW, pg8::lane_id_v());
        const int lane = pg8::lane_id_v();
        float s1 = wave_sum(args.in[7][lane] * args.in[8][lane]), s2 = wave_sum(args.in[9][lane] * args.in[10][lane]);
        const float lam = expf(s1) - expf(s2) + 0.2f;
        for (int bh = blockIdx.x; bh < NB * 8; bh += G) { const int b = bh >> 3, h = bh & 7;
#pragma unroll 1
            for (int j = 0; j < 8; ++j) att::attn_unit<WS_BIG, WS_MQKV, WS_O>(lds, ws, b, h, 64 + 256 * j, 8, lam, args.in[11], wave); }
    }
    SEAM(4);
    if (IN(5)) {
        meta_e3(args, gwp, NGW, pg8::lane_id_v());
        pg8::Gemm g{OB, (const bf16*)(ws + WS_WO), MP, D, D}; pg8::StaticOrder S; S.init(MP, D, G, (int)blockIdx.x);
        pg8::EpiRes<1> E{nullptr, XB, SSP, nullptr};
        pg8::gemm_phase<pg8::EpiRes<1>, pg8::StaticOrder, true, true>(lds, g, S, E, wave);
    }
    SEAM(5);
    if (IN(6)) REPS(6) {
        skinny_gemm<0>((const bf16*)(ws + WS_MHID), nullptr, nullptr, DFF, (const bf16*)(ws + WS_WD0), 0, 0, D / 16, (float*)(ws + WS_MC4), D, gwp, NGW, pg8::lane_id_v());
        pg8::Gemm g{XB, (const bf16*)(ws + WS_WGU0), MP, NGU, D}; pg8::StaticOrder S; S.init(MP, NGU, G, (int)blockIdx.x);
        pg8::EpiGateUp E{BIG, SSP, lds + pg8::SSPL_OFF};
        pg8::gemm_phase<pg8::EpiGateUp, pg8::StaticOrder, true, true>(lds, g, S, E, wave);
    }
    SEAM(6);
    if (IN(7)) {
        skinny_gemm<1>(nullptr, (const float*)(ws + WS_MH1), (const float*)(ws + WS_MC4), D, (const bf16*)(ws + WS_WIN), 3, 1024, 2048 / 16, (float*)(ws + WS_MC5), 2048, gwp, NGW, pg8::lane_id_v());
        pg8::Gemm g{BIG, (const bf16*)(ws + WS_WD0), MP, D, DFF}; pg8::StaticOrder S; S.init(MP, D, G, (int)blockIdx.x, 1);
        pg8::EpiRes<1> E{nullptr, XB, SSP, nullptr};
        pg8::gemm_phase<pg8::EpiRes<1>, pg8::StaticOrder, true, true>(lds, g, S, E, wave);
    }
    SEAM(7);
    if (IN(8)) REPS(8) {
        meta_e5(args, gwp, NGW, pg8::lane_id_v());
        pg8::Gemm g{XB, (const bf16*)(ws + WS_WIN), MP, NQKV, D}; pg8::StaticOrder S; S.init(MP, NQKV, G, (int)blockIdx.x);
        pg8::EpiWin E{BIG, BIG + (size_t)MP * D, SSP, lds + pg8::SSPL_OFF};
        pg8::gemm_phase<pg8::EpiWin, pg8::StaticOrder, true, true>(lds, g, S, E, wave);
    }
    SEAM(8);
    if (IN(9)) REPS(9) { conv_phase(args, pg8::lane_id_v(), gw, NGW); }
    SEAM(9);
    if (IN(10)) {
        pg8::Gemm g{OB, (const bf16*)(ws + WS_WOUT), MP, D, D}; pg8::StaticOrder S; S.init(MP, D, G, (int)blockIdx.x);
        pg8::EpiRes<1> E{nullptr, XB, SSP, nullptr};
        pg8::gemm_phase<pg8::EpiRes<1>, pg8::StaticOrder, true, true>(lds, g, S, E, wave);
    }
    SEAM(10);
    if (IN(11)) REPS(11) {
        pg8::Gemm g{XB, (const bf16*)(ws + WS_WGU1), MP, NGU, D}; pg8::StaticOrder S; S.init(MP, NGU, G, (int)blockIdx.x);
        pg8::EpiGateUp E{BIG, SSP, lds + pg8::SSPL_OFF};
        pg8::gemm_phase<pg8::EpiGateUp, pg8::StaticOrder, true, true>(lds, g, S, E, wave);
    }
    SEAM(11);
    if (IN(12)) {
        pg8::Gemm g{BIG, (const bf16*)(ws + WS_WD1), MP, D, DFF}; pg8::StaticOrder S; S.init(MP, D, G, (int)blockIdx.x, 1);
        pg8::EpiRes<2> E{nullptr, XB, nullptr, args.out};
        pg8::gemm_phase<pg8::EpiRes<2>, pg8::StaticOrder, true, true>(lds, g, S, E, wave);
    }
#undef IN
#undef SEAM
}

extern "C" void kernel_launch(void* const* d_in, const int* in_sizes, int n_in, void* d_out, int out_size, void* d_ws, size_t ws_size, hipStream_t stream) {
    static int grid = 0;
    if (grid == 0) {
        if (n_in != 18 || ws_size < WS_END) { fprintf(stderr, "kernel_launch: need 18 inputs and %zu bytes of workspace (got %d, %zu)\n", (size_t)WS_END, n_in, ws_size); grid = -1; return; }
        int dev = 0, cus = 0, per_cu = 0;
        hipGetDevice(&dev); hipDeviceGetAttribute(&cus, hipDeviceAttributeMultiprocessorCount, dev);
        if (hipFuncSetAttribute((const void*)mega_fwd, hipFuncAttributeMaxDynamicSharedMemorySize, LDS_BYTES) != hipSuccess) { fprintf(stderr, "kernel_launch: hipFuncSetAttribute failed\n"); grid = -1; return; }
        if (hipOccupancyMaxActiveBlocksPerMultiprocessor(&per_cu, (const void*)mega_fwd, NWAVES * 64, LDS_BYTES) != hipSuccess || per_cu < 1) { fprintf(stderr, "kernel_launch: occupancy query says %d\n", per_cu); per_cu = 1; }
        (void)hipGetLastError();
        grid = cus * per_cu;
    }
    if (grid < 0) return;
    Args a{};
    for (int i = 0; i < 18; ++i) a.in[i] = (const float*)d_in[i];
    a.out = (float*)d_out; a.ws = (unsigned char*)d_ws;
#if MK_PER_PHASE
    for (int p = 0; p < NPHASE; ++p) { a.ph_lo = p; a.ph_hi = p + 1; hipLaunchKernelGGL(mega_fwd, dim3(grid), dim3(NWAVES * 64), LDS_BYTES, stream, a); }
#else
    a.ph_lo = 0; a.ph_hi = NPHASE;
    if (hipMemsetAsync((char*)d_ws + WS_CTL, 0, CTL_BYTES, stream) != hipSuccess) { fprintf(stderr, "kernel_launch: memset failed\n"); return; }
    void* kargs[] = {&a};
    hipError_t e = hipLaunchCooperativeKernel((const void*)mega_fwd, dim3(grid), dim3(NWAVES * 64), kargs, LDS_BYTES, stream);
    if (e != hipSuccess) fprintf(stderr, "kernel_launch: cooperative launch failed: %s (grid %d)\n", hipGetErrorString(e), grid);
#endif
}
```

```cpp
#include <hip/hip_runtime.h>
#include <hip/hip_cooperative_groups.h>
#include <cstdio>
#include <cstdint>
namespace cg = cooperative_groups;
namespace pg8 {
#define PG8_LAS __attribute__((address_space(3)))
typedef unsigned short bf16_t;
typedef short bf16x8 __attribute__((ext_vector_type(8)));
typedef float f32x4 __attribute__((ext_vector_type(4)));
typedef unsigned u32x4 __attribute__((ext_vector_type(4)));
constexpr int BM = 256, BK = 64, HALF = 128, HTB = HALF * BK * 2  , STAGE_BYTES = 8 * HTB, NXCD = 8, WGM = 8;

__host__ __device__ __forceinline__ int lds_byte(int r, int c) { const int st = (r >> 4) * 2 + (c >> 5), rr = r & 15, cc = c & 31, ob = rr * 64 + cc * 2; return st * 1024 + (ob ^ (((ob >> 9) & 1) << 5)); }
__host__ __device__ __forceinline__ void stage_rc(int b, int& R, int& C) { const int st = b / 1024, sb = b % 1024, swz = sb ^ (((sb >> 9) & 1) << 5); R = (st >> 1) * 16 + swz / 64; C = (st & 1) * 32 + (swz % 64) / 2; }
__host__ __device__ __forceinline__ int perm32(int rho) { const int n = rho >> 4, i = rho & 15; return 8 * (i >> 2) + 4 * n + (i & 3); }

struct Unit { int pm, pn; };
struct Gemm { const bf16_t* A; const bf16_t* Bt; int M, N, K; };

struct StaticOrder {
    int nM, nN, nwg, G, c, rev;
    __host__ __device__ void init(int M, int N, int G_, int c_, int rev_ = 0) { nM = M / BM; nN = N / BM; nwg = nM * nN; G = G_; c = c_; rev = rev_; }
    __host__ __device__ bool next(int i, Unit& u) const {
        const long L = (long)i * G + c; if (L >= nwg) return false;
        int wgid = (int)L; { const int q = nwg / NXCD, r = nwg % NXCD, xcd = wgid % NXCD, off = wgid / NXCD; wgid = (xcd < r ? xcd * (q + 1) : r * (q + 1) + (xcd - r) * q) + off; }
        const int nig = WGM * nN, gid = wgid / nig, fm = gid * WGM, gsz = (nM - fm) < WGM ? (nM - fm) : WGM;
        u.pm = fm + ((wgid % nig) % gsz); u.pn = (wgid % nig) / gsz; if (rev) u.pm = nM - 1 - u.pm; return true;
    }
    __device__ __forceinline__ void a_ready(const Unit&) const {}
    __device__ __forceinline__ void done(const Unit&) const {}
};
__device__ __forceinline__ unsigned cvt_pk_bf16(float lo, float hi) { unsigned r; asm volatile("v_cvt_pk_bf16_f32 %0, %1, %2" : "=v"(r) : "v"(lo), "v"(hi)); return r; }
typedef unsigned u32x2 __attribute__((ext_vector_type(2)));
__device__ __forceinline__ int lane_id_v() { int l; asm volatile("v_mbcnt_lo_u32_b32 %0, -1, 0\n\tv_mbcnt_hi_u32_b32 %0, -1, %0" : "=v"(l)); return l; }
constexpr int LP_ = 2048, NMETA_ = 16;
constexpr float QSCALE_ = 0.125f * 1.4426950408889634f;
__device__ __forceinline__ float row_rstd(const float* ssp, int row) {
    const f32x4* p = (const f32x4*)(ssp + (size_t)row * 16);
    const f32x4 a = p[0], b = p[1], c = p[2], d = p[3];
    const float s = (((a[0] + a[1]) + (a[2] + a[3])) + ((b[0] + b[1]) + (b[2] + b[3]))) + (((c[0] + c[1]) + (c[2] + c[3])) + ((d[0] + d[1]) + (d[2] + d[3])));
    return rsqrtf(s * (1.0f / 1024.0f) + 1e-6f);
}
__device__ __forceinline__ float row_rstd_lds(const PG8_LAS unsigned char* sspl, int rl) {
    const PG8_LAS f32x4* p = (const PG8_LAS f32x4*)(sspl + rl * 64);
    const f32x4 a = p[0], b = p[1], c = p[2], d = p[3];
    const float s = (((a[0] + a[1]) + (a[2] + a[3])) + ((b[0] + b[1]) + (b[2] + b[3]))) + (((c[0] + c[1]) + (c[2] + c[3])) + ((d[0] + d[1]) + (d[2] + d[3])));
    return rsqrtf(s * (1.0f / 1024.0f) + 1e-6f);
}
constexpr int SSPL_OFF = 131072;
constexpr int QRS_OFF = SSPL_OFF, QROPEB_OFF = SSPL_OFF + 2048, QROPEO_OFF = SSPL_OFF + 2048 + 8192;
__device__ __forceinline__ u32x4 pack8(const f32x4 v0, const f32x4 v1) { u32x4 w; w.x = cvt_pk_bf16(v0[0], v0[1]); w.y = cvt_pk_bf16(v0[2], v0[3]); w.z = cvt_pk_bf16(v1[0], v1[1]); w.w = cvt_pk_bf16(v1[2], v1[3]); return w; }

struct EpiQKV {
    static constexpr bool PERM = true, AFTER_DRAIN = false, USES_SSP = false; static constexpr int NST = 16;
    bf16_t* QKV; const float* rs0; const float* rope; const float* qg; const float* kg; const PG8_LAS unsigned char* sspl;
    __device__ __forceinline__ void prefetch_next(PG8_LAS unsigned char* lds, int pm, int wid, int lane, int par) const {
        if (wid < 4) { const int p0 = ((pm * BM) % LP_) + NMETA_;
            __builtin_amdgcn_global_load_lds((const unsigned*)((const char*)rope + (size_t)(p0 + 64 * wid) * 256 + (unsigned)((lane >> 4) * 4096 + (lane & 15) * 16)), (PG8_LAS unsigned*)(lds + QROPEB_OFF + par * 4096 + wid * 1024), 16, 0, 0); }
        else if (wid == 4) __builtin_amdgcn_global_load_lds((const unsigned*)((const char*)rs0 + (size_t)pm * (BM * 4) + (unsigned)(lane * 16)), (PG8_LAS unsigned*)(lds + QRS_OFF + par * 1024), 16, 0, 0);
    }
    __device__ __forceinline__ void prefetch_phase(PG8_LAS unsigned char* lds, int pm, int wid, int lane) const {
        if (wid >= 4) __builtin_amdgcn_global_load_lds((const unsigned*)((const char*)rope + (size_t)((wid - 4) * 1024) + (unsigned)(lane * 16)), (PG8_LAS unsigned*)(lds + QROPEO_OFF + (wid - 4) * 1024), 16, 0, 0);
        prefetch_next(lds, pm, wid, lane, 0);
    }
    __device__ __forceinline__ void operator()(const f32x4 (&acc)[2][2][4][2], const Unit& u, int wr, int wc, int fr, int fq, int par) const {
        const int row0 = u.pm * BM + wr * 64 + fr, pn = u.pn;
        const int colbase = pn * 256 + wc * 64 + 8 * fq;
        if (pn < 8) {
            const float* gp = (pn < 4) ? qg : kg; const float osc = (pn < 4) ? QSCALE_ : 1.0f;
            f32x4 g[2][2];
#pragma unroll
            for (int bj = 0; bj < 2; ++bj)
#pragma unroll
                for (int n = 0; n < 2; ++n) g[bj][n] = *(const f32x4*)(gp + 32 * bj + 8 * fq + 4 * n);
            const PG8_LAS f32x4* rop = (const PG8_LAS f32x4*)(sspl + (QROPEO_OFF - SSPL_OFF) + fr * 256 + fq * 64);
#pragma unroll
            for (int ai = 0; ai < 2; ++ai)
#pragma unroll
                for (int m = 0; m < 4; ++m) {
                    const int row = row0 + ai * HALF + m * 16; const float rs = rsqrtf(*(const PG8_LAS float*)(sspl + (QRS_OFF - SSPL_OFF) + par * 1024 + (row - u.pm * BM) * 4) * (1.0f / 1024.0f) + 1e-6f);
                    f32x4 v[2][2]; float ss = 0.f;
#pragma unroll
                    for (int bj = 0; bj < 2; ++bj)
#pragma unroll
                        for (int n = 0; n < 2; ++n) { v[bj][n] = acc[ai][bj][m][n] * rs; const f32x4 x = v[bj][n]; ss += (x[0] * x[0] + x[1] * x[1]) + (x[2] * x[2] + x[3] * x[3]); }
                    ss += __shfl_xor(ss, 16); ss += __shfl_xor(ss, 32);
                    const float rn = rsqrtf(ss * (1.0f / 64.0f) + 1e-6f);
#pragma unroll
                    for (int bj = 0; bj < 2; ++bj)
#pragma unroll
                        for (int n = 0; n < 2; ++n) v[bj][n] = v[bj][n] * rn * g[bj][n];
                    const PG8_LAS f32x4* bp = (const PG8_LAS f32x4*)(sspl + (QROPEB_OFF - SSPL_OFF) + par * 4096 + ((row - u.pm * BM) >> 4) * 256 + fq * 64);
                    f32x4 rp[4];
#pragma unroll
                    for (int qq = 0; qq < 4; ++qq) { const f32x4 bb = bp[qq], oo = rop[qq];
                        rp[qq][0] = bb[0] * oo[0] - bb[1] * oo[1]; rp[qq][1] = bb[1] * oo[0] + bb[0] * oo[1];
                        rp[qq][2] = bb[2] * oo[2] - bb[3] * oo[3]; rp[qq][3] = bb[3] * oo[2] + bb[2] * oo[3]; }
                    f32x4 o1[2], o2[2];
#pragma unroll
                    for (int n = 0; n < 2; ++n) { const f32x4 ca = rp[2 * n], cb = rp[2 * n + 1];
                        const f32x4 x1 = v[0][n], x2 = v[1][n];
                        o1[n][0] = (x1[0] * ca[0] - x2[0] * ca[1]) * osc; o2[n][0] = (x2[0] * ca[0] + x1[0] * ca[1]) * osc;
                        o1[n][1] = (x1[1] * ca[2] - x2[1] * ca[3]) * osc; o2[n][1] = (x2[1] * ca[2] + x1[1] * ca[3]) * osc;
                        o1[n][2] = (x1[2] * cb[0] - x2[2] * cb[1]) * osc; o2[n][2] = (x2[2] * cb[0] + x1[2] * cb[1]) * osc;
                        o1[n][3] = (x1[3] * cb[2] - x2[3] * cb[3]) * osc; o2[n][3] = (x2[3] * cb[2] + x1[3] * cb[3]) * osc; }
                    bf16_t* rowp = QKV + (size_t)row * 3072 + colbase;
                    *(u32x4*)(rowp) = pack8(o1[0], o1[1]); *(u32x4*)(rowp + 32) = pack8(o2[0], o2[1]);
                }
        } else {
#pragma unroll
            for (int ai = 0; ai < 2; ++ai)
#pragma unroll
                for (int m = 0; m < 4; ++m) {
                    const int row = row0 + ai * HALF + m * 16; const float rs = rsqrtf(*(const PG8_LAS float*)(sspl + (QRS_OFF - SSPL_OFF) + par * 1024 + (row - u.pm * BM) * 4) * (1.0f / 1024.0f) + 1e-6f);
                    bf16_t* rowp = QKV + (size_t)row * 3072 + colbase;
#pragma unroll
                    for (int bj = 0; bj < 2; ++bj) *(u32x4*)(rowp + 32 * bj) = pack8(acc[ai][bj][m][0] * rs, acc[ai][bj][m][1] * rs);
                }
        }
    }
};
struct EpiGateUp {
    static constexpr bool PERM = true, AFTER_DRAIN = false, USES_SSP = true; static constexpr int NST = 8;
    bf16_t* HID; const float* ssp; const PG8_LAS unsigned char* sspl;
    __device__ __forceinline__ void prefetch_phase(PG8_LAS unsigned char*, int, int, int) const {}
    __device__ __forceinline__ void prefetch_next(PG8_LAS unsigned char*, int, int, int, int) const {}
    __device__ __forceinline__ void operator()(const f32x4 (&acc)[2][2][4][2], const Unit& u, int wr, int wc, int fr, int fq, int par) const {
        const int row0 = u.pm * BM + wr * 64 + fr; const int col = u.pn * 128 + wc * 32 + 8 * fq;
#pragma unroll
        for (int ai = 0; ai < 2; ++ai)
#pragma unroll
            for (int m = 0; m < 4; ++m) {
                const int row = row0 + ai * HALF + m * 16; const float rs = row_rstd_lds(sspl, row - u.pm * BM);
                f32x4 hv[2];
                const float kx = -1.4426950408889634f * rs, rs2 = rs * rs;
#pragma unroll
                for (int n = 0; n < 2; ++n) { const f32x4 a0 = acc[ai][0][m][n], a1 = acc[ai][1][m][n];
#pragma unroll
                    for (int e = 0; e < 4; ++e) { const float r = __builtin_amdgcn_rcpf(1.0f + __builtin_amdgcn_exp2f(a0[e] * kx)); hv[n][e] = (a0[e] * a1[e]) * (rs2 * r); } }
                *(u32x4*)(HID + (size_t)row * 2816 + col) = pack8(hv[0], hv[1]);
            }
    }
};
struct EpiWin {
    static constexpr bool PERM = true, AFTER_DRAIN = false, USES_SSP = true; static constexpr int NST = 8;
    bf16_t* Z; bf16_t* GB; const float* ssp; const PG8_LAS unsigned char* sspl;
    __device__ __forceinline__ void prefetch_phase(PG8_LAS unsigned char*, int, int, int) const {}
    __device__ __forceinline__ void prefetch_next(PG8_LAS unsigned char*, int, int, int, int) const {}
    __device__ __forceinline__ void operator()(const f32x4 (&acc)[2][2][4][2], const Unit& u, int wr, int wc, int fr, int fq, int par) const {
        const int row0 = u.pm * BM + wr * 64 + fr, pn = u.pn;
#pragma unroll
        for (int ai = 0; ai < 2; ++ai)
#pragma unroll
            for (int m = 0; m < 4; ++m) {
                const int row = row0 + ai * HALF + m * 16; const float rs = row_rstd_lds(sspl, row - u.pm * BM);
                if (pn < 8) {
                    const float rs2 = rs * rs;
                    *(u32x4*)(Z + (size_t)row * 1024 + pn * 128 + wc * 32 + 8 * fq) = pack8(acc[ai][0][m][0] * acc[ai][1][m][0] * rs2, acc[ai][0][m][1] * acc[ai][1][m][1] * rs2);
                } else {
                    bf16_t* rowp = GB + (size_t)row * 1024 + (pn - 8) * 256 + wc * 32 + 8 * fq;
#pragma unroll
                    for (int bj = 0; bj < 2; ++bj) *(u32x4*)(rowp + 128 * bj) = pack8(acc[ai][bj][m][0] * rs, acc[ai][bj][m][1] * rs);
                }
            }
    }
};
__device__ __forceinline__ f32x4 bf_lo4(const u32x4 w) { f32x4 r; r[0] = __uint_as_float(w.x << 16); r[1] = __uint_as_float(w.x & 0xffff0000u); r[2] = __uint_as_float(w.y << 16); r[3] = __uint_as_float(w.y & 0xffff0000u); return r; }
__device__ __forceinline__ f32x4 bf_hi4(const u32x4 w) { f32x4 r; r[0] = __uint_as_float(w.z << 16); r[1] = __uint_as_float(w.z & 0xffff0000u); r[2] = __uint_as_float(w.w << 16); r[3] = __uint_as_float(w.w & 0xffff0000u); return r; }
template <int MODE> struct EpiRes {
    static constexpr bool PERM = true, AFTER_DRAIN = false, USES_SSP = false; static constexpr int NST = (MODE == 2) ? 32 : 8;
    const float* x; bf16_t* XB; float* ssp; float* out;
    __device__ __forceinline__ void prefetch_phase(PG8_LAS unsigned char*, int, int, int) const {}
    __device__ __forceinline__ void prefetch_next(PG8_LAS unsigned char*, int, int, int, int) const {}
    __device__ __forceinline__ void operator()(const f32x4 (&acc)[2][2][4][2], const Unit& u, int wr, int wc, int fr, int fq, int par) const {
        const int row0 = u.pm * BM + wr * 64 + fr; const int c0 = u.pn * 256 + wc * 32 + 8 * fq;
#pragma unroll
        for (int ai = 0; ai < 2; ++ai)
#pragma unroll
            for (int m = 0; m < 4; ++m) {
                const int row = row0 + ai * HALF + m * 16; float ss = 0.f;
                f32x4 nv[2][2];
#pragma unroll
                for (int bj = 0; bj < 2; ++bj) {
                    if (MODE == 0) { const float* hp = x + (size_t)row * 1024 + c0 + 128 * bj; nv[bj][0] = *(const f32x4*)hp + acc[ai][bj][m][0]; nv[bj][1] = *(const f32x4*)(hp + 4) + acc[ai][bj][m][1]; }
                    else { const u32x4 hw = *(const u32x4*)(XB + (size_t)row * 1024 + c0 + 128 * bj); nv[bj][0] = bf_lo4(hw) + acc[ai][bj][m][0]; nv[bj][1] = bf_hi4(hw) + acc[ai][bj][m][1]; }
                }
                if (MODE != 2) {
#pragma unroll
                    for (int bj = 0; bj < 2; ++bj) {
                        *(u32x4*)(XB + (size_t)row * 1024 + c0 + 128 * bj) = pack8(nv[bj][0], nv[bj][1]);
#pragma unroll
                        for (int n = 0; n < 2; ++n) { const f32x4 v = nv[bj][n]; ss += (v[0] * v[0] + v[1] * v[1]) + (v[2] * v[2] + v[3] * v[3]); }
                    }
                    ss += __shfl_xor(ss, 16); ss += __shfl_xor(ss, 32);
                    if (fq == 0) ssp[(size_t)row * 16 + 4 * u.pn + wc] = ss;
                } else {
                    float* op = out + (size_t)row * 1024 + c0;
#pragma unroll
                    for (int bj = 0; bj < 2; ++bj) { *(f32x4*)(op + 128 * bj) = nv[bj][0]; *(f32x4*)(op + 128 * bj + 4) = nv[bj][1]; }
                }
            }
    }
};
template <class Epi, class Sched, bool ALIGN_EPI = false, bool SP2 = false>
__device__ __forceinline__ void gemm_phase(PG8_LAS unsigned char* lds, const Gemm g, const Sched& S, const Epi& E, const int wid) {
    const int lane = lane_id_v(), tid = wid * 64 + lane, wr = wid >> 2, wc = wid & 3, fr = lane & 15, fq = lane >> 4;
    const int K = g.K, nt = K / BK;
    unsigned voffA[2], voffB[2];
#pragma unroll
    for (int i = 0; i < 2; ++i) { int R, C; stage_rc(tid * 16 + i * 8192, R, C); const int Rb = Epi::PERM ? ((R & ~31) + perm32(R & 31)) : R;
        voffA[i] = (unsigned)(R * K + C) * 2u; voffB[i] = (unsigned)(Rb * K + C) * 2u; }
    const size_t kstep = (size_t)(BK * 2);
    const size_t hstep = (size_t)HALF * K * 2;
    const size_t tstep = 2 * hstep;
    const unsigned ldsw = (unsigned)wid * 1024u;
    const int aoff = lds_byte(wr * 64 + fr, fq * 8), boff = lds_byte(wc * 32 + fr, fq * 8);
#define PG8_SA(b, h) (((b) * 2 + (h)) * HTB)
#define PG8_SB(b, h) ((4 + (b) * 2 + (h)) * HTB)
#define PG8_STAGE(bufoff, gbase, voff) do { _Pragma("unroll") for (int _i = 0; _i < 2; ++_i) \
        __builtin_amdgcn_global_load_lds((const unsigned*)((const char*)(gbase) + (voff)[_i]), (PG8_LAS unsigned*)(lds + (bufoff) + ldsw + _i * 8192), 16, 0, 0); } while (0)
#define PG8_SSP_DMA(pm_) do { if constexpr (Epi::USES_SSP) { _Pragma("unroll") for (int _i = 0; _i < 2; ++_i) \
        __builtin_amdgcn_global_load_lds((const unsigned*)((const char*)E.ssp + (size_t)(pm_) * (BM * 64) + (size_t)((2 * wid + _i) * 1024) + (unsigned)(lane * 16)), (PG8_LAS unsigned*)(lds + SSPL_OFF + (2 * wid + _i) * 1024), 16, 0, 0); } } while (0)
#define PG8_LDA(dst, b, h) do { _Pragma("unroll") for (int m = 0; m < 4; ++m) _Pragma("unroll") for (int k = 0; k < 2; ++k) dst[m][k] = *(const PG8_LAS bf16x8*)(lds + PG8_SA(b, h) + aoff + m * 2048 + k * 1024); } while (0)
#define PG8_LDB(dst, b, h) do { _Pragma("unroll") for (int n = 0; n < 2; ++n) _Pragma("unroll") for (int k = 0; k < 2; ++k) dst[n][k] = *(const PG8_LAS bf16x8*)(lds + PG8_SB(b, h) + boff + n * 2048 + k * 1024); } while (0)
#define PG8_MMA(ai, bj, At, Bt) do { __builtin_amdgcn_s_setprio(1); _Pragma("unroll") for (int m = 0; m < 4; ++m) _Pragma("unroll") for (int n = 0; n < 2; ++n) _Pragma("unroll") for (int k = 0; k < 2; ++k) \
        acc[ai][bj][m][n] = __builtin_amdgcn_mfma_f32_16x16x32_bf16(Bt[n][k], At[m][k], acc[ai][bj][m][n], 0, 0, 0); __builtin_amdgcn_s_setprio(0); } while (0)
#define PG8_WAIT_V(n) asm volatile("s_waitcnt vmcnt(" #n ")" ::: "memory")
#define PG8_WAIT_L(n) asm volatile("s_waitcnt lgkmcnt(" #n ")" ::: "memory")
#define PG8_BAR __builtin_amdgcn_s_barrier()
#define PG8_SCHED __builtin_amdgcn_sched_barrier(0)
    Unit cur, nxt; int ui = 0;
    if (!S.next(0, cur)) return;
    f32x4 acc[2][2][4][2];
#pragma unroll
    for (int a = 0; a < 2; ++a)
#pragma unroll
        for (int b = 0; b < 2; ++b)
#pragma unroll
            for (int m = 0; m < 4; ++m)
#pragma unroll
                for (int n = 0; n < 2; ++n) acc[a][b][m][n] = (f32x4){0.f, 0.f, 0.f, 0.f};
    bf16x8 At[4][2], B0[2][2], B1[2][2];
    const char* cA = (const char*)g.A + (size_t)cur.pm * tstep; const char* cB = (const char*)g.Bt + (size_t)cur.pn * tstep;
    S.a_ready(cur);
    PG8_SSP_DMA(cur.pm);
    E.prefetch_phase(lds, cur.pm, wid, lane);
    if constexpr (SP2) {
        PG8_STAGE(PG8_SB(0, 0), cB, voffB); PG8_STAGE(PG8_SB(0, 1), cB + hstep, voffB); PG8_STAGE(PG8_SA(0, 0), cA, voffA); PG8_STAGE(PG8_SA(0, 1), cA + hstep, voffA);
        if (wr == 1) PG8_BAR;
        PG8_WAIT_V(2); PG8_BAR;
        PG8_STAGE(PG8_SB(1, 0), cB + kstep, voffB); PG8_STAGE(PG8_SA(1, 0), cA + kstep, voffA); PG8_STAGE(PG8_SB(1, 1), cB + hstep + kstep, voffB);
        PG8_WAIT_V(6); PG8_BAR;
    } else {
        PG8_STAGE(PG8_SB(0, 0), cB, voffB); PG8_STAGE(PG8_SA(0, 0), cA, voffA); PG8_STAGE(PG8_SB(0, 1), cB + hstep, voffB); PG8_STAGE(PG8_SA(0, 1), cA + hstep, voffA);
        if (wr == 1) PG8_BAR;
        PG8_WAIT_V(4); PG8_BAR;
        PG8_STAGE(PG8_SB(1, 0), cB + kstep, voffB); PG8_STAGE(PG8_SA(1, 0), cA + kstep, voffA); PG8_STAGE(PG8_SB(1, 1), cB + hstep + kstep, voffB);
        PG8_WAIT_V(6); PG8_BAR;
    }
    static_assert(SP2, "this build keeps only the two-super-phase loop");
#define PG8_ITER(WV) do { \
            PG8_LDB(B0, 0, 0); PG8_LDB(B1, 0, 1); PG8_SCHED; PG8_LDA(At, 0, 0); PG8_STAGE(PG8_SA(1, 1), a1 + hstep, voffA); \
            WV; PG8_WAIT_L(0); PG8_BAR; PG8_MMA(0, 0, At, B0); PG8_MMA(0, 1, At, B1); PG8_BAR; PG8_SCHED; \
            PG8_LDA(At, 0, 1); PG8_STAGE(PG8_SB(0, 0), b2, voffB); PG8_STAGE(PG8_SB(0, 1), b2 + hstep, voffB); PG8_STAGE(PG8_SA(0, 0), a2, voffA); \
            WV; PG8_WAIT_L(0); PG8_BAR; PG8_MMA(1, 0, At, B0); PG8_MMA(1, 1, At, B1); PG8_BAR; PG8_SCHED; \
            PG8_LDB(B0, 1, 0); PG8_LDB(B1, 1, 1); PG8_SCHED; PG8_LDA(At, 1, 0); PG8_STAGE(PG8_SA(0, 1), a2 + hstep, voffA); \
            PG8_WAIT_V(8); PG8_WAIT_L(0); PG8_BAR; PG8_MMA(0, 0, At, B0); PG8_MMA(0, 1, At, B1); PG8_BAR; PG8_SCHED; \
            PG8_LDA(At, 1, 1); PG8_STAGE(PG8_SB(1, 0), b3, voffB); PG8_STAGE(PG8_SB(1, 1), b3 + hstep, voffB); PG8_STAGE(PG8_SA(1, 0), a3, voffA); \
            PG8_WAIT_V(8); PG8_WAIT_L(0); PG8_BAR; PG8_MMA(1, 0, At, B0); PG8_MMA(1, 1, At, B1); PG8_BAR; PG8_SCHED; } while (0)
#define PG8_WAIT_R asm volatile("s_waitcnt vmcnt(%0)" :: "n"(8 + Epi::NST) : "memory")
#define PG8_ITER_R() do { \
            PG8_LDB(B0, 0, 0); PG8_LDB(B1, 0, 1); PG8_SCHED; PG8_LDA(At, 0, 0); \
            PG8_WAIT_R; PG8_WAIT_L(0); PG8_BAR; PG8_MMA(0, 0, At, B0); PG8_MMA(0, 1, At, B1); PG8_BAR; PG8_SCHED; \
            PG8_SSP_DMA(cur.pm); PG8_SCHED;     \
            PG8_LDA(At, 0, 1); PG8_STAGE(PG8_SB(0, 0), b2, voffB); PG8_STAGE(PG8_SB(0, 1), b2 + hstep, voffB); PG8_STAGE(PG8_SA(0, 0), a2, voffA); \
            PG8_WAIT_R; PG8_WAIT_L(0); PG8_BAR; PG8_MMA(1, 0, At, B0); PG8_MMA(1, 1, At, B1); PG8_BAR; PG8_SCHED; \
            PG8_LDB(B0, 1, 0); PG8_LDB(B1, 1, 1); PG8_SCHED; PG8_LDA(At, 1, 0); PG8_STAGE(PG8_SA(0, 1), a2 + hstep, voffA); \
            PG8_WAIT_R; PG8_WAIT_L(0); PG8_BAR; PG8_MMA(0, 0, At, B0); PG8_MMA(0, 1, At, B1); PG8_BAR; PG8_SCHED; \
            PG8_LDA(At, 1, 1); PG8_STAGE(PG8_SB(1, 0), b3, voffB); PG8_STAGE(PG8_SB(1, 1), b3 + hstep, voffB); PG8_STAGE(PG8_SA(1, 0), a3, voffA); \
            PG8_WAIT_V(8); PG8_WAIT_L(0); PG8_BAR; PG8_MMA(1, 0, At, B0); PG8_MMA(1, 1, At, B1); PG8_BAR; PG8_SCHED; } while (0)
    int t0 = 0;
    for (;;) {
        const bool has_next = S.next(ui + 1, nxt);
        const char* nA = has_next ? (const char*)g.A + (size_t)nxt.pm * tstep : cA; const char* nB = has_next ? (const char*)g.Bt + (size_t)nxt.pn * tstep : cB;
        for (int t = t0; t < nt; t += 2) {
            const bool last = (t == nt - 2);
            const char* a1 = cA + (size_t)(t + 1) * kstep;
            const char* a2 = last ? nA : cA + (size_t)(t + 2) * kstep; const char* b2 = last ? nB : cB + (size_t)(t + 2) * kstep;
            const char* a3 = a2 + kstep; const char* b3 = b2 + kstep;
            if (last && has_next) S.a_ready(nxt);
            PG8_ITER(PG8_WAIT_V(8));
        }
        if constexpr (ALIGN_EPI) { if (wr == 0) PG8_BAR; }
        if (has_next) PG8_STAGE(PG8_SA(1, 1), nA + kstep + hstep, voffA);
        PG8_SCHED;
        if constexpr (!Epi::AFTER_DRAIN) { const int le = lane_id_v(); E(acc, cur, wr, wc, le & 15, le >> 4, ui & 1); if (has_next) E.prefetch_next(lds, nxt.pm, wid, le, (ui + 1) & 1); S.done(cur); }
        PG8_SCHED;
        if (!has_next) break;
#pragma unroll
        for (int a = 0; a < 2; ++a)
#pragma unroll
            for (int b = 0; b < 2; ++b)
#pragma unroll
                for (int m = 0; m < 4; ++m)
#pragma unroll
                    for (int n = 0; n < 2; ++n) acc[a][b][m][n] = (f32x4){0.f, 0.f, 0.f, 0.f};
        cur = nxt; cA = nA; cB = nB; ++ui; t0 = 2;
        if constexpr (ALIGN_EPI) { if (wr == 1) PG8_BAR; }
        PG8_SCHED;
        {
            const char* a1 = cA + kstep; const char* a2 = cA + 2 * kstep; const char* b2 = cB + 2 * kstep; const char* a3 = a2 + kstep; const char* b3 = b2 + kstep;
            (void)a1; PG8_ITER_R();
        }
    }
#undef PG8_ITER
#undef PG8_ITER_R
#undef PG8_WAIT_R
    PG8_WAIT_V(0);
    if constexpr (!ALIGN_EPI) { if (wr == 0) PG8_BAR; }
    PG8_BAR;
    if constexpr (Epi::AFTER_DRAIN) { E.fused(acc, cur, wr, wc, fr, fq, lds, wid, lane); S.done(cur); }
#undef PG8_SA
#undef PG8_SB
#undef PG8_STAGE
#undef PG8_SSP_DMA
#undef PG8_LDA
#undef PG8_LDB
#undef PG8_MMA
#undef PG8_WAIT_V
#undef PG8_WAIT_L
#undef PG8_BAR
#undef PG8_SCHED
}
}
namespace att {
#define LAS __attribute__((address_space(3)))
typedef unsigned short bf16_t;
typedef short bf16x8 __attribute__((ext_vector_type(8)));
typedef short s16x4 __attribute__((ext_vector_type(4)));
typedef float f32x16 __attribute__((ext_vector_type(16)));
typedef float f32x4 __attribute__((ext_vector_type(4)));
typedef unsigned u32x4 __attribute__((ext_vector_type(4)));
constexpr int LP = 2048, PADF = 48, PITCH = 3072;
constexpr int KV_BUF = 32768, V_OFF = 16384, OST_OFF = 65536, OST_PITCH = 272, OST_WAVE = 32 * OST_PITCH, WSF_OFF = OST_OFF + 8 * OST_WAVE, ATT_LDS = WSF_OFF + 8 * 256;
__device__ __forceinline__ int crow(int r, int hi) { return (r & 3) + 8 * (r >> 2) + 4 * hi; }
__device__ __forceinline__ unsigned cvtpk(float lo, float hi) { unsigned r; asm volatile("v_cvt_pk_bf16_f32 %0, %1, %2" : "=v"(r) : "v"(lo), "v"(hi)); return r; }
template <int K> __device__ __forceinline__ float swz_xor(float v) { return __builtin_bit_cast(float, __builtin_amdgcn_ds_swizzle(__builtin_bit_cast(int, v), (K << 10) | 0x1f)); }
__device__ __forceinline__ float xor32(float v) { const int ln = pg8::lane_id_v(); return __builtin_bit_cast(float, __builtin_amdgcn_ds_bpermute((ln ^ 32) << 2, __builtin_bit_cast(int, v))); }
__device__ __forceinline__ s16x4 vtr(const LAS unsigned char* p) { return __builtin_bit_cast(s16x4, __builtin_amdgcn_ds_read_tr16_b64_v4i16((LAS s16x4*)p)); }

__device__ __forceinline__ void stage_tile(LAS unsigned char* lds, int bufoff, const bf16_t* QKV, const bf16_t* MQKV, long rowbase, int h, int t, int wid, int lane) {
    const char* src = (t == 0) ? (const char*)MQKV : (const char*)(QKV + (size_t)(rowbase + 64 * (t - 1)) * PITCH);
    const unsigned voffK = (unsigned)lane * (PITCH * 2), voffV = (unsigned)(lane >> 2) * (PITCH * 2) + (unsigned)(lane & 3) * 16;
#pragma unroll
    for (int i = 0; i < 2; ++i) {
        const int ci = 2 * wid + i;
        const char* ks = src + (size_t)((1024 + h * 128 + ci * 8) * 2);
        __builtin_amdgcn_global_load_lds((const unsigned*)(ks + voffK), (LAS unsigned*)(lds + bufoff + ci * 1024), 16, 0, 0);
    }
#pragma unroll
    for (int i = 0; i < 2; ++i) {
        const int pi = 2 * wid + i, db = pi >> 2, kg = pi & 3;
        const char* vs = src + (size_t)(16 * kg) * (PITCH * 2) + (size_t)((2048 + h * 128 + db * 32) * 2);
        __builtin_amdgcn_global_load_lds((const unsigned*)(vs + voffV), (LAS unsigned*)(lds + bufoff + V_OFF + pi * 1024), 16, 0, 0);
    }
}

template <size_t OFF_QKV, size_t OFF_MQKV, size_t OFF_O> __device__ __forceinline__ void attn_unit(LAS unsigned char* lds, unsigned char* ws, int b, int h, int q0, int nqw, float lam, const float* subg, const int wid) {
    const bf16_t* QKV = (const bf16_t*)(ws + OFF_QKV); const bf16_t* MQKV = (const bf16_t*)(ws + OFF_MQKV); bf16_t* O = (bf16_t*)(ws + OFF_O);
    const int lane = pg8::lane_id_v(), r32 = lane & 31, hi = lane >> 5;
    const long rowbase = (long)b * LP;
    const int NT = (q0 + 32 * nqw) >> 6;
    const bool active = wid < nqw;
    const int qabs = q0 + 32 * wid + r32, qfirst = q0 + 32 * wid, qlast = qfirst + 31;
    LAS unsigned char* qw = lds + OST_OFF + wid * OST_WAVE + lane * 16;
    {
        const char* qb = (const char*)(QKV + (size_t)(rowbase + (active ? qfirst - 64 : 0)) * PITCH + h * 128);
        const bf16_t* qp = (const bf16_t*)(qb + ((unsigned)r32 * (PITCH * 2) + (unsigned)hi * 16));
#pragma unroll
        for (int j = 0; j < 8; ++j) *(LAS bf16x8*)(qw + j * 1024) = *(const bf16x8*)(qp + (j >> 2) * 64 + (j & 3) * 16);
    }
    f32x16 o[2][4];
#pragma unroll
    for (int c = 0; c < 2; ++c)
#pragma unroll
        for (int db = 0; db < 4; ++db)
#pragma unroll
            for (int r = 0; r < 16; ++r) o[c][db][r] = 0.f;
    float lsum[2] = {0.f, 0.f};
    stage_tile(lds, 0, QKV, MQKV, rowbase, h, 0, wid, lane);
    __syncthreads();
    stage_tile(lds, KV_BUF, QKV, MQKV, rowbase, h, 1, wid, lane);
    {   const int buf = 0;
    if (active) {
            const LAS unsigned char* kb = lds + buf + hi * 1024 + r32 * 16;
            const LAS unsigned char* vp = lds + buf + V_OFF + ((lane >> 4) & 1) * 32 + (lane & 3) * 8 + (4 * hi + ((lane & 15) >> 2)) * 64;
            f32x16 sA, sB;
#pragma unroll
            for (int r = 0; r < 16; ++r) { sA[r] = 0.f; sB[r] = 0.f; }
#pragma unroll
            for (int d0 = 0; d0 < 4; ++d0) {
                const bf16x8 ka = *(const LAS bf16x8*)(kb + (2 * d0) * 1024), kbb = *(const LAS bf16x8*)(kb + (8 + 2 * d0) * 1024);
                const bf16x8 qa = *(const LAS bf16x8*)(qw + d0 * 1024), qb = *(const LAS bf16x8*)(qw + (4 + d0) * 1024);
                sA = __builtin_amdgcn_mfma_f32_32x32x16_bf16(ka, qa, sA, 0, 0, 0);
                sB = __builtin_amdgcn_mfma_f32_32x32x16_bf16(kbb, qb, sB, 0, 0, 0);
            }
            float s0 = 0.f, s1 = 0.f;
#pragma unroll
            for (int r = 0; r < 8; ++r) { sA[r] = __builtin_amdgcn_exp2f(sA[r]); sB[r] = __builtin_amdgcn_exp2f(sB[r]); s0 += sA[r]; s1 += sB[r]; }
            lsum[0] += s0; lsum[1] += s1;
            const u32x4 pa = (u32x4){cvtpk(sA[0], sA[1]), cvtpk(sA[2], sA[3]), cvtpk(sA[4], sA[5]), cvtpk(sA[6], sA[7])};
            const u32x4 pb = (u32x4){cvtpk(sB[0], sB[1]), cvtpk(sB[2], sB[3]), cvtpk(sB[4], sB[5]), cvtpk(sB[6], sB[7])};
#pragma unroll
            for (int db = 0; db < 4; ++db) {
                const s16x4 lo_ = vtr(vp + db * 4096), hh_ = vtr(vp + db * 4096 + 512);
                const bf16x8 vf = (bf16x8){lo_[0], lo_[1], lo_[2], lo_[3], hh_[0], hh_[1], hh_[2], hh_[3]};
                o[0][db] = __builtin_amdgcn_mfma_f32_32x32x16_bf16(__builtin_bit_cast(bf16x8, pa), vf, o[0][db], 0, 0, 0);
                o[1][db] = __builtin_amdgcn_mfma_f32_32x32x16_bf16(__builtin_bit_cast(bf16x8, pb), vf, o[1][db], 0, 0, 0);
            }
    }
    }
    for (int t = 1; t < NT; ++t) {
        __syncthreads();
        const int buf = (t & 1) * KV_BUF;
        if (t + 1 < NT) stage_tile(lds, ((t + 1) & 1) * KV_BUF, QKV, MQKV, rowbase, h, t + 1, wid, lane);
        if (active && 64 * t <= qlast) {
            const bool needmask = (64 * t + 63 > qfirst);
            const LAS unsigned char* kb = lds + buf + hi * 1024 + r32 * 16;
            const LAS unsigned char* vp = lds + buf + V_OFF + ((lane >> 4) & 1) * 32 + (lane & 3) * 8 + (4 * hi + ((lane & 15) >> 2)) * 64;
            f32x16 sA0, sA1, sB0, sB1;
#pragma unroll
            for (int r = 0; r < 16; ++r) { sA0[r] = 0.f; sA1[r] = 0.f; sB0[r] = 0.f; sB1[r] = 0.f; }
            {
                bf16x8 fk0[3], fk1[3], fq_[3];
#define QK_LOAD(s_) do { fk0[(s_) % 3] = *(const LAS bf16x8*)(kb + (8 * ((s_) >> 2) + 2 * ((s_) & 3)) * 1024); fk1[(s_) % 3] = *(const LAS bf16x8*)(kb + (8 * ((s_) >> 2) + 2 * ((s_) & 3)) * 1024 + 512); \
                                 fq_[(s_) % 3] = *(const LAS bf16x8*)(qw + (s_) * 1024); } while (0)
                QK_LOAD(0); QK_LOAD(1);
                __builtin_amdgcn_sched_barrier(0);
#pragma unroll
                for (int s_ = 0; s_ < 8; ++s_) {
                    if (s_ + 2 < 8) QK_LOAD(s_ + 2);
                    if (s_ < 4) { sA0 = __builtin_amdgcn_mfma_f32_32x32x16_bf16(fk0[s_ % 3], fq_[s_ % 3], sA0, 0, 0, 0); sA1 = __builtin_amdgcn_mfma_f32_32x32x16_bf16(fk1[s_ % 3], fq_[s_ % 3], sA1, 0, 0, 0); }
                    else        { sB0 = __builtin_amdgcn_mfma_f32_32x32x16_bf16(fk0[s_ % 3], fq_[s_ % 3], sB0, 0, 0, 0); sB1 = __builtin_amdgcn_mfma_f32_32x32x16_bf16(fk1[s_ % 3], fq_[s_ % 3], sB1, 0, 0, 0); }
                    __builtin_amdgcn_sched_barrier(0);
                }
#undef QK_LOAD
            }
#define MASK1(P, R, LIM, OP, ADD) asm volatile("s_nop 0\n\t" OP " vcc, %2, %1\n\tv_cndmask_b32_e32 %0, 0, %0, vcc" : "+v"(P[R]) : "v"(LIM), "n"(((R) & 3) + 8 * ((R) >> 2) + (ADD)) : "vcc")
#define MASK16(P0, P1, LIM, OP) do { \
    MASK1(P0, 0, LIM, OP, 0); MASK1(P0, 1, LIM, OP, 0); MASK1(P0, 2, LIM, OP, 0); MASK1(P0, 3, LIM, OP, 0); MASK1(P0, 4, LIM, OP, 0); MASK1(P0, 5, LIM, OP, 0); MASK1(P0, 6, LIM, OP, 0); MASK1(P0, 7, LIM, OP, 0); \
    MASK1(P0, 8, LIM, OP, 0); MASK1(P0, 9, LIM, OP, 0); MASK1(P0, 10, LIM, OP, 0); MASK1(P0, 11, LIM, OP, 0); MASK1(P0, 12, LIM, OP, 0); MASK1(P0, 13, LIM, OP, 0); MASK1(P0, 14, LIM, OP, 0); MASK1(P0, 15, LIM, OP, 0); \
    MASK1(P1, 0, LIM, OP, 32); MASK1(P1, 1, LIM, OP, 32); MASK1(P1, 2, LIM, OP, 32); MASK1(P1, 3, LIM, OP, 32); MASK1(P1, 4, LIM, OP, 32); MASK1(P1, 5, LIM, OP, 32); MASK1(P1, 6, LIM, OP, 32); MASK1(P1, 7, LIM, OP, 32); \
    MASK1(P1, 8, LIM, OP, 32); MASK1(P1, 9, LIM, OP, 32); MASK1(P1, 10, LIM, OP, 32); MASK1(P1, 11, LIM, OP, 32); MASK1(P1, 12, LIM, OP, 32); MASK1(P1, 13, LIM, OP, 32); MASK1(P1, 14, LIM, OP, 32); MASK1(P1, 15, LIM, OP, 32); } while (0)
#define ATT_SOFTMAX(P0, P1, C, PW) do { \
                _Pragma("unroll") for (int r = 0; r < 16; ++r) { P0[r] = __builtin_amdgcn_exp2f(P0[r]); P1[r] = __builtin_amdgcn_exp2f(P1[r]); } \
                if (needmask) {        \
                    int mhi = qabs - 64 * t - 4 * hi; asm volatile("" : "+v"(mhi)); \
                    MASK16(P0, P1, mhi, "v_cmp_le_i32_e32"); \
                } \
                float s_ = 0.f; \
                _Pragma("unroll") for (int r = 0; r < 16; ++r) s_ += P0[r] + P1[r]; \
                lsum[C] += s_; \
                PW[0] = (u32x4){cvtpk(P0[0], P0[1]), cvtpk(P0[2], P0[3]), cvtpk(P0[4], P0[5]), cvtpk(P0[6], P0[7])}; \
                PW[1] = (u32x4){cvtpk(P0[8], P0[9]), cvtpk(P0[10], P0[11]), cvtpk(P0[12], P0[13]), cvtpk(P0[14], P0[15])}; \
                PW[2] = (u32x4){cvtpk(P1[0], P1[1]), cvtpk(P1[2], P1[3]), cvtpk(P1[4], P1[5]), cvtpk(P1[6], P1[7])}; \
                PW[3] = (u32x4){cvtpk(P1[8], P1[9]), cvtpk(P1[10], P1[11]), cvtpk(P1[12], P1[13]), cvtpk(P1[14], P1[15])}; } while (0)
            u32x4 pwA[4], pwB[4];
            ATT_SOFTMAX(sA0, sA1, 0, pwA);
            __builtin_amdgcn_sched_barrier(0);
            ATT_SOFTMAX(sB0, sB1, 1, pwB);
            __builtin_amdgcn_sched_barrier(0);
            {
                bf16x8 vr[4];
#define V_LOAD(i_) do { const s16x4 lo_ = vtr(vp + ((i_) & 3) * 4096 + ((i_) >> 2) * 1024), hh_ = vtr(vp + ((i_) & 3) * 4096 + ((i_) >> 2) * 1024 + 512); \
                                vr[(i_) & 3] = (bf16x8){lo_[0], lo_[1], lo_[2], lo_[3], hh_[0], hh_[1], hh_[2], hh_[3]}; } while (0)
                V_LOAD(0); V_LOAD(1); V_LOAD(2);
                __builtin_amdgcn_sched_barrier(0);
#pragma unroll
                for (int i_ = 0; i_ < 16; ++i_) {
                    if (i_ + 3 < 16) V_LOAD(i_ + 3);
                    o[0][i_ & 3] = __builtin_amdgcn_mfma_f32_32x32x16_bf16(__builtin_bit_cast(bf16x8, pwA[i_ >> 2]), vr[i_ & 3], o[0][i_ & 3], 0, 0, 0);
                    o[1][i_ & 3] = __builtin_amdgcn_mfma_f32_32x32x16_bf16(__builtin_bit_cast(bf16x8, pwB[i_ >> 2]), vr[i_ & 3], o[1][i_ & 3], 0, 0, 0);
                    __builtin_amdgcn_sched_barrier(0);
                }
#undef V_LOAD
            }
#undef ATT_SOFTMAX
#undef MASK1
#undef MASK16
        }
    }
    if (active) {
        const int lane_e = pg8::lane_id_v(), r32 = lane_e & 31, hi = lane_e >> 5;
        float l0 = lsum[0], l1 = lsum[1];
        l0 += xor32(l0); l1 += xor32(l1);
        LAS float* wsf = (LAS float*)(lds + WSF_OFF) + wid * 64;
        if (hi == 0) { wsf[r32] = l0; wsf[32 + r32] = l1; }
        asm volatile("s_waitcnt lgkmcnt(0)" ::: "memory");
#pragma unroll
        for (int r = 0; r < 16; ++r) { const float a0 = wsf[crow(r, hi)], a1 = wsf[32 + crow(r, hi)];
            const float rl0 = a0 > 0.f ? __builtin_amdgcn_rcpf(a0) : 0.f, rl1 = a1 > 0.f ? lam * __builtin_amdgcn_rcpf(a1) : 0.f; float s = 0.f;
#pragma unroll
            for (int db = 0; db < 4; ++db) { const float v = o[0][db][r] * rl0 - o[1][db][r] * rl1; o[0][db][r] = v; s += v * v; }
            s += swz_xor<1>(s); s += swz_xor<2>(s); s += swz_xor<4>(s); s += swz_xor<8>(s); s += swz_xor<16>(s);
            const float rn = rsqrtf(s * (1.0f / 128.0f) + 1e-6f) * 0.8f;
#pragma unroll
            for (int db = 0; db < 4; ++db) o[0][db][r] *= rn; }
        LAS unsigned short* stg = (LAS unsigned short*)(lds + OST_OFF + wid * OST_WAVE);
#pragma unroll
        for (int db = 0; db < 4; ++db) { const float sg = subg[db * 32 + r32];
#pragma unroll
            for (int r = 0; r < 16; ++r) { const unsigned w = cvtpk(o[0][db][r] * sg, 0.f); stg[crow(r, hi) * (OST_PITCH / 2) + db * 32 + r32] = (unsigned short)(w & 0xffffu); } }
        asm volatile("s_waitcnt lgkmcnt(0)" ::: "memory");
        int lsel = lane_e;
        bf16_t* Ow = O + (size_t)(rowbase + qfirst - 64 + (lsel >> 4)) * 1024 + h * 128 + (lsel & 15) * 8;
        const LAS unsigned char* sp = (const LAS unsigned char*)stg + (lsel >> 4) * OST_PITCH + (lsel & 15) * 16;
#pragma unroll
        for (int it = 0; it < 8; ++it) { const u32x4 v = *(const LAS u32x4*)(sp + it * 4 * OST_PITCH); *(u32x4*)Ow = v; Ow += 4 * 1024; asm volatile("" : "+v"(Ow)); }
    }
    __syncthreads();
}
}
typedef unsigned short bf16;
typedef unsigned v4u __attribute__((ext_vector_type(4)));
typedef float f32x4 __attribute__((ext_vector_type(4)));
typedef short bf16x8 __attribute__((ext_vector_type(8)));
constexpr int NWAVES = 8;
#ifndef MK_PER_PHASE
#define MK_PER_PHASE 0
#endif
constexpr int NPHASE = 13;
#ifndef PROBE_DUP
#define PROBE_DUP -1
#endif
#define REPS(k) for (int rep_ = 0; rep_ < ((PROBE_DUP) == (k) ? 2 : 1); ++rep_)
constexpr int D = 1024, NB = 32, SEQ = 2048, LTOK = 2064, NMETA = 16, LP = 2048, MP = NB * LP;
constexpr int NQKV = 3072, DFF = 2816, NGU = 5632;
constexpr size_t al256(size_t x) { return (x + 255) & ~(size_t)255; }
constexpr size_t WS_WQKV = 0;
constexpr size_t WS_WO   = WS_WQKV + (size_t)NQKV * D * 2;
constexpr size_t WS_WGU0 = WS_WO + (size_t)D * D * 2;
constexpr size_t WS_WD0  = WS_WGU0 + (size_t)NGU * D * 2;
constexpr size_t WS_WIN  = WS_WD0 + (size_t)D * DFF * 2;
constexpr size_t WS_WOUT = WS_WIN + (size_t)NQKV * D * 2;
constexpr size_t WS_WGU1 = WS_WOUT + (size_t)D * D * 2;
constexpr size_t WS_WD1  = WS_WGU1 + (size_t)NGU * D * 2;
constexpr size_t WS_ROPE = WS_WD1 + (size_t)D * DFF * 2;
constexpr size_t WS_SSP  = WS_ROPE + al256((size_t)LTOK * 32 * 2 * 4);
constexpr size_t WS_H    = WS_SSP + (size_t)MP * 16 * 4;
constexpr size_t WS_XB   = WS_H;
constexpr size_t WS_BIG  = WS_XB + (size_t)MP * D * 2;
constexpr size_t WS_O    = WS_BIG + (size_t)MP * NQKV * 2;
constexpr size_t WS_MXB  = WS_O + (size_t)MP * D * 2;
constexpr size_t WS_MRS  = WS_MXB + 16 * 1024 * 2;
constexpr size_t WS_MC1  = WS_MRS + 256;
constexpr size_t WS_MQKV = WS_MC1 + 16 * 3072 * 4;
constexpr size_t WS_MOM  = WS_MQKV + 64 * 3072 * 2;
constexpr size_t WS_MC2  = WS_MOM + 16 * 1024 * 2;
constexpr size_t WS_MC3  = WS_MC2 + 16 * 1024 * 4;
constexpr size_t WS_MH1  = WS_MC3 + 16 * 5632 * 4;
constexpr size_t WS_MHID = WS_MH1 + 16 * 1024 * 4;
constexpr size_t WS_MC4  = WS_MHID + 16 * 2816 * 2;
constexpr size_t WS_MC5  = WS_MC4 + 16 * 1024 * 4;
constexpr size_t WS_MZ   = WS_MC5 + 16 * 2048 * 4;
constexpr size_t WS_RS0  = WS_MZ + 16 * 1024 * 2;
constexpr size_t WS_CTL  = WS_RS0 + (size_t)MP * 4;
constexpr size_t CTL_BYTES = 16384;
constexpr size_t WS_END  = WS_CTL + CTL_BYTES;
constexpr int LDS_BYTES = 149504;
static_assert(att::ATT_LDS <= LDS_BYTES && pg8::STAGE_BYTES <= LDS_BYTES, "LDS map");

__device__ __forceinline__ unsigned f2bf(float f) { unsigned u = __builtin_bit_cast(unsigned, f); return (u + 0x7fffu + ((u >> 16) & 1u)) >> 16; }
__device__ __forceinline__ unsigned pk2(float lo, float hi) { return f2bf(lo) | (f2bf(hi) << 16); }
__device__ __forceinline__ float wave_sum(float v) {
#pragma unroll
    for (int o = 1; o < 64; o <<= 1) v += __shfl_xor(v, o);
    return v;
}
__device__ __forceinline__ float wave_max(float v) {
#pragma unroll
    for (int o = 1; o < 64; o <<= 1) v = fmaxf(v, __shfl_xor(v, o));
    return v;
}
__device__ __forceinline__ int col_perm(int mode, int n) {
    if (mode == 1) return (n & ~255) + 128 * ((n >> 5) & 1) + 32 * ((n >> 6) & 3) + (n & 31);
    if (mode == 2) { const int up = n >= DFF ? 1 : 0, j = n - up * DFF; return 256 * (j >> 7) + 128 * up + (j & 127); }
    if (mode == 3) { if (n < 1024) return 2048 + n; const int up = n >= 2048 ? 1 : 0, j = (n - 1024) & 1023; return 256 * (j >> 7) + 128 * up + (j & 127); }
    return n;
}
__device__ __forceinline__ void transpose_item(const float* W, int K, int N, bf16* WT, const float* gain, int mode, LAS float* scr, int item, int lane) {
    const int nblk = N / 32, kb = item / nblk, nb = item % nblk, k0 = 64 * kb, n0 = 32 * nb;
#pragma unroll 8
    for (int i = 0; i < 32; ++i) { const int kk = 2 * i + (lane >> 5); scr[kk * 33 + (lane & 31)] = W[(size_t)(k0 + kk) * N + n0 + (lane & 31)]; }
    asm volatile("s_waitcnt lgkmcnt(0)" ::: "memory");
    const int c = lane & 7;
    float gv[8];
#pragma unroll
    for (int e = 0; e < 8; ++e) gv[e] = gain ? gain[k0 + 8 * c + e] : 1.0f;
#pragma unroll
    for (int j = 0; j < 4; ++j) { const int n = (lane >> 3) + 8 * j; const LAS float* s = scr + (8 * c) * 33 + n;
        v4u o; o.x = pk2(s[0 * 33] * gv[0], s[1 * 33] * gv[1]); o.y = pk2(s[2 * 33] * gv[2], s[3 * 33] * gv[3]); o.z = pk2(s[4 * 33] * gv[4], s[5 * 33] * gv[5]); o.w = pk2(s[6 * 33] * gv[6], s[7 * 33] * gv[7]);
        *(v4u*)(WT + (size_t)col_perm(mode, n0 + n) * K + k0 + 8 * c) = o; }
    asm volatile("s_waitcnt lgkmcnt(0)" ::: "memory");
}
__device__ __forceinline__ void sincos_acc(float angf, float& c, float& s) {
    const double TWO_PI = 6.283185307179586476925286766559;
    double a = (double)angf; const double n = rint(a / TWO_PI); double r = a - n * TWO_PI;
    const double r2 = r * r; double cs = 1.0, sn = r, tc = 1.0, ts = r;
#pragma unroll 1
    for (int k = 1; k <= 14; ++k) { tc = -tc * r2 / (double)((2 * k - 1) * (2 * k)); ts = -ts * r2 / (double)((2 * k) * (2 * k + 1)); cs += tc; sn += ts; }
    c = (float)cs; s = (float)sn;
}

#define XB_TMO      128
#define XB_XCNT(j)  (256  + 64 * (j))
#define XB_XSUB(j)  (1280 + 64 * (j))
#define XB_XGEN(j)  (2304 + 64 * (j))
#define XB_TOP      3328
#define XB_TOPGEN   3392
#define XCD_BAR_WORDS 3456
#define XB_SPIN_CAP (1u << 18)

__device__ __forceinline__ unsigned xb_ld(unsigned* p)              { return __hip_atomic_load(p, __ATOMIC_RELAXED, __HIP_MEMORY_SCOPE_AGENT); }
__device__ __forceinline__ unsigned xb_add(unsigned* p, unsigned v) { return __hip_atomic_fetch_add(p, v, __ATOMIC_RELAXED, __HIP_MEMORY_SCOPE_AGENT); }
__device__ __forceinline__ unsigned xb_xcc_id() { return (unsigned)__builtin_amdgcn_s_getreg((3 << 11) | 20) & 0xFu; }
#define XB_SPIN(cond, bar) do { unsigned _sp = 0; while (cond) { __builtin_amdgcn_s_sleep(1); \
    if ((++_sp & 255u) == 0u) { if (xb_ld(&(bar)[XB_TMO])) break; if (_sp > XB_SPIN_CAP) { atomicAdd(&(bar)[XB_TMO], 1u); break; } } } } while (0)

struct XcdBarrier {
    unsigned* bar; unsigned x;
    volatile LAS unsigned* st;
};

__device__ __forceinline__ XcdBarrier xcd_barrier_post(unsigned* bar, volatile LAS unsigned* st) {
    XcdBarrier b; b.bar = bar; b.x = xb_xcc_id(); b.st = st;
    if (threadIdx.x == 0) (void)xb_add(&bar[XB_XCNT(b.x)], 1u);
    return b;
}
__device__ __forceinline__ void xcd_barrier_complete(unsigned* bar, unsigned x, unsigned& nloc, unsigned& nx) {
    const unsigned G = gridDim.x * gridDim.y * gridDim.z;
    unsigned sum, cnt, mine, sp = 0u;
    for (;;) {
        sum = 0u; cnt = 0u; mine = 0u;
#pragma unroll
        for (unsigned j = 0; j < 16; ++j) { const unsigned c = xb_ld(&bar[XB_XCNT(j)]); sum += c; cnt += (c > 0u) ? 1u : 0u; mine = (j == x) ? c : mine; }
        if (sum == G) break;
        __builtin_amdgcn_s_sleep(1);
        if ((++sp & 255u) == 0u) { if (xb_ld(&bar[XB_TMO])) break; if (sp > XB_SPIN_CAP) { atomicAdd(&bar[XB_TMO], 1u); break; } }
    }
    nloc = mine > 0u ? mine : 1u; nx = cnt > 0u ? cnt : 1u;
}

__device__ __forceinline__ void xcd_barrier(const XcdBarrier& b) {
    asm volatile("s_waitcnt vmcnt(0)" ::: "memory");
    __syncthreads();
    if (threadIdx.x == 0) {
        unsigned* bar = b.bar;
        __builtin_amdgcn_s_waitcnt(0);
        unsigned nloc = b.st[0], nx = b.st[1];
        if (nloc == 0u) { xcd_barrier_complete(bar, b.x, nloc, nx); b.st[0] = nloc; b.st[1] = nx; }
        const unsigned old = xb_add(&bar[XB_XSUB(b.x)], 1u);
        const unsigned gen = old / nloc;
        if (old + 1u == (gen + 1u) * nloc) {
            __builtin_amdgcn_fence(__ATOMIC_RELEASE, "agent");
            asm volatile("s_waitcnt vmcnt(0)" ::: "memory");
            const unsigned og = xb_add(&bar[XB_TOP], 1u);
            const unsigned tg = og / nx;
            if (og + 1u == (tg + 1u) * nx) xb_add(&bar[XB_TOPGEN], 1u);
            else XB_SPIN(xb_ld(&bar[XB_TOPGEN]) == tg, bar);
            __builtin_amdgcn_fence(__ATOMIC_ACQUIRE, "agent");
            xb_add(&bar[XB_XGEN(b.x)], 1u);
            asm volatile("s_waitcnt vmcnt(0)" ::: "memory");
        } else {
            XB_SPIN(xb_ld(&bar[XB_XGEN(b.x)]) == gen, bar);
            __builtin_amdgcn_fence(__ATOMIC_ACQUIRE, "agent");
            asm volatile("s_waitcnt vmcnt(0)" ::: "memory");
        }
    }
    __syncthreads();
}

constexpr int MISC_OFF = LDS_BYTES - 64;
struct Args { const float* in[18]; float* out; unsigned char* ws; int ph_lo, ph_hi; };

__device__ __forceinline__ void weight_items(const Args& a, LAS unsigned char* lds, int wave, int lane, int gw, int NGW, int it_lo, int it_hi) {
    unsigned char* ws = a.ws;
    LAS float* scr = (LAS float*)(lds + wave * 16384);
    const float* mix_g = a.in[2]; const float* ffn_g = a.in[3];
    constexpr int I_QKV = (D / 64) * (NQKV / 32), I_O = (D / 64) * (D / 32), I_GU = (D / 64) * (NGU / 32), I_DN = (DFF / 64) * (D / 32);
    for (int it = it_lo + gw; it < it_hi; it += NGW) {
        int r = it;
        if (r < I_QKV) { transpose_item(a.in[4], D, NQKV, (bf16*)(ws + WS_WQKV), mix_g, 1, scr, r, lane); continue; } r -= I_QKV;
        if (r < I_O)   { transpose_item(a.in[12], D, D, (bf16*)(ws + WS_WO), nullptr, 0, scr, r, lane); continue; } r -= I_O;
        if (r < I_GU)  { transpose_item(a.in[16], D, NGU, (bf16*)(ws + WS_WGU0), ffn_g, 2, scr, r, lane); continue; } r -= I_GU;
        if (r < I_DN)  { transpose_item(a.in[17], DFF, D, (bf16*)(ws + WS_WD0), nullptr, 0, scr, r, lane); continue; } r -= I_DN;
        if (r < I_QKV) { transpose_item(a.in[13], D, NQKV, (bf16*)(ws + WS_WIN), mix_g + D, 3, scr, r, lane); continue; } r -= I_QKV;
        if (r < I_O)   { transpose_item(a.in[15], D, D, (bf16*)(ws + WS_WOUT), nullptr, 0, scr, r, lane); continue; } r -= I_O;
        if (r < I_GU)  { transpose_item(a.in[16] + (size_t)D * NGU, D, NGU, (bf16*)(ws + WS_WGU1), ffn_g + D, 2, scr, r, lane); continue; } r -= I_GU;
        transpose_item(a.in[17] + (size_t)DFF * D, DFF, D, (bf16*)(ws + WS_WD1), nullptr, 0, scr, r, lane);
    }
}
constexpr int W_ITEMS_L0 = (D / 64) * (NQKV / 32) + (D / 64) * (D / 32) + (D / 64) * (NGU / 32) + (DFF / 64) * (D / 32), W_ITEMS = 2 * W_ITEMS_L0;
__device__ __forceinline__ void prologue(const Args& a, LAS unsigned char* lds, int wave, int lane, int gw, int NGW) {
    unsigned char* ws = a.ws;
    weight_items(a, lds, wave, lane, gw, NGW, 0, W_ITEMS_L0);
    { float* rope = (float*)(ws + WS_ROPE);
      for (int e = gw * 64 + lane; e < LTOK * 32; e += NGW * 64) { const int pos = e >> 5, i = e & 31;
          const float inv = (float)exp(-9.210340371976184 * (double)(2 * i) / 64.0);
          const float ang = (float)pos * inv; float c, s; sincos_acc(ang, c, s); rope[2 * e] = c; rope[2 * e + 1] = s; } }
    { const float* x = a.in[0]; bf16* XB = (bf16*)(ws + WS_XB); float* rs0 = (float*)(ws + WS_RS0);
      for (int m = gw; m < MP; m += NGW) {
          const float* src = x + (size_t)m * D;
          f32x4 v[4]; float s = 0.f;
#pragma unroll
          for (int j = 0; j < 4; ++j) { v[j] = *((const f32x4*)src + 64 * j + lane); s += (v[j][0] * v[j][0] + v[j][1] * v[j][1]) + (v[j][2] * v[j][2] + v[j][3] * v[j][3]); }
          s = wave_sum(s);
#pragma unroll
          for (int j = 0; j < 4; ++j) *((unsigned long long*)(XB + (size_t)m * D) + 64 * j + lane) = (unsigned long long)pk2(v[j][0], v[j][1]) | ((unsigned long long)pk2(v[j][2], v[j][3]) << 32);
          if (lane == 0) rs0[m] = s; } }
    { const float* meta = a.in[1]; bf16* MXB = (bf16*)(ws + WS_MXB); float* mrs = (float*)(ws + WS_MRS);
      if (gw < NMETA) { const int m = gw; const float* src = meta + (size_t)m * D; f32x4 v[4]; float s = 0.f;
#pragma unroll
          for (int j = 0; j < 4; ++j) { v[j] = *((const f32x4*)src + 64 * j + lane); s += (v[j][0] * v[j][0] + v[j][1] * v[j][1]) + (v[j][2] * v[j][2] + v[j][3] * v[j][3]); }
          s = wave_sum(s);
#pragma unroll
          for (int j = 0; j < 4; ++j) *((unsigned long long*)(MXB + (size_t)m * D) + 64 * j + lane) = (unsigned long long)pk2(v[j][0], v[j][1]) | ((unsigned long long)pk2(v[j][2], v[j][3]) << 32);
          if (lane == 0) mrs[m] = s; }
      v4u* mz = (v4u*)(ws + WS_MQKV + 16 * 3072 * 2);
      for (int e = gw * 64 + lane; e < 48 * 3072 * 2 / 16; e += NGW * 64) mz[e] = (v4u){0u, 0u, 0u, 0u};
      for (int e = gw * 64 + lane; e < 16 * 3072 / 4; e += NGW * 64) ((v4u*)(ws + WS_MC1))[e] = (v4u){0u, 0u, 0u, 0u};
      for (int e = gw * 64 + lane; e < 16 * 1024 / 4; e += NGW * 64) { ((v4u*)(ws + WS_MC2))[e] = (v4u){0u, 0u, 0u, 0u}; ((v4u*)(ws + WS_MC4))[e] = (v4u){0u, 0u, 0u, 0u}; }
      for (int e = gw * 64 + lane; e < 16 * 5632 / 4; e += NGW * 64) ((v4u*)(ws + WS_MC3))[e] = (v4u){0u, 0u, 0u, 0u};
      for (int e = gw * 64 + lane; e < 16 * 2048 / 4; e += NGW * 64) ((v4u*)(ws + WS_MC5))[e] = (v4u){0u, 0u, 0u, 0u}; }
}
constexpr int SK_KS = 8;
template <int AMODE> __device__ __forceinline__ void skinny_gemm(const bf16* A, const float* P, const float* Q, int K, const bf16* Bt, int mode, int n_src0, int ntiles, float* C, int ldc, int gwp, int NGW, int lane) {
    const int fr = lane & 15, fq = lane >> 4, kslice = K / SK_KS;
    for (int task = gwp; task < ntiles * SK_KS; task += NGW) {
        const int tile = task / SK_KS, k0 = (task % SK_KS) * kslice;
        const bf16* bp = Bt + (size_t)col_perm(mode, n_src0 + tile * 16 + fr) * K + 8 * fq;
        f32x4 acc = {0.f, 0.f, 0.f, 0.f};
#pragma unroll 4
        for (int kk = k0; kk < k0 + kslice; kk += 32) {
            bf16x8 av;
            if (AMODE == 0) av = *(const bf16x8*)(A + (size_t)fr * K + kk + 8 * fq);
            else { const float* pp = P + (size_t)fr * K + kk + 8 * fq; const float* qq = Q + (size_t)fr * K + kk + 8 * fq;
                const f32x4 p0 = *(const f32x4*)pp, p1 = *(const f32x4*)(pp + 4), q0 = *(const f32x4*)qq, q1 = *(const f32x4*)(qq + 4);
                v4u t; t.x = pk2(p0[0] + q0[0], p0[1] + q0[1]); t.y = pk2(p0[2] + q0[2], p0[3] + q0[3]); t.z = pk2(p1[0] + q1[0], p1[1] + q1[1]); t.w = pk2(p1[2] + q1[2], p1[3] + q1[3]);
                av = __builtin_bit_cast(bf16x8, t); }
            const bf16x8 bv = *(const bf16x8*)(bp + kk);
            acc = __builtin_amdgcn_mfma_f32_16x16x32_bf16(av, bv, acc, 0, 0, 0);
        }
#pragma unroll
        for (int j = 0; j < 4; ++j) __hip_atomic_fetch_add(C + (size_t)(4 * fq + j) * ldc + tile * 16 + fr, acc[j], __ATOMIC_RELAXED, __HIP_MEMORY_SCOPE_AGENT);
    }
}
__device__ __forceinline__ void meta_e1(const Args& a, LAS unsigned char* lds, int wave, int lane, int h, int r) {
    unsigned char* ws = a.ws;
    const float* C1 = (const float*)(ws + WS_MC1); const float* mrs = (const float*)(ws + WS_MRS); const float* rope = (const float*)(ws + WS_ROPE);
    bf16* MQ = (bf16*)(ws + WS_MQKV); bf16* OM = (bf16*)(ws + WS_MOM);
    const float* qg = a.in[5]; const float* kg = a.in[6]; const float* subg = a.in[11];
    const float lam = expf(wave_sum(a.in[7][lane] * a.in[8][lane])) - expf(wave_sum(a.in[9][lane] * a.in[10][lane])) + 0.2f;
    LAS float* kl = (LAS float*)(lds + wave * 16384);
    LAS float* vl = kl + 2048;
    const int i = lane & 31; const float kgl = kg[lane];
#pragma unroll 4
    for (int rp = 0; rp <= r; ++rp) {
        const float rs = rsqrtf(mrs[rp] * (1.0f / 1024.0f) + 1e-6f);
        const float cs = rope[(rp * 32 + i) * 2], sn = rope[(rp * 32 + i) * 2 + 1];
#pragma unroll
        for (int c = 0; c < 2; ++c) {
            float x = C1[(size_t)rp * 3072 + 1024 + h * 128 + c * 64 + lane] * rs;
            const float ss = wave_sum(x * x); x = x * rsqrtf(ss * (1.0f / 64.0f) + 1e-6f) * kgl;
            const float pr = __shfl_xor(x, 32); const float o = lane < 32 ? x * cs - pr * sn : x * cs + pr * sn;
            kl[(c * 16 + rp) * 64 + lane] = o;
            if (rp == r) MQ[(size_t)r * 3072 + 1024 + h * 128 + c * 64 + lane] = (bf16)f2bf(o);
        }
#pragma unroll
        for (int hf = 0; hf < 2; ++hf) { const float v = C1[(size_t)rp * 3072 + 2048 + h * 128 + hf * 64 + lane] * rs; vl[rp * 128 + hf * 64 + lane] = v;
            if (rp == r) MQ[(size_t)r * 3072 + 2048 + h * 128 + hf * 64 + lane] = (bf16)f2bf(v); }
    }
    asm volatile("s_waitcnt lgkmcnt(0)" ::: "memory");
    {
        const float rs = rsqrtf(mrs[r] * (1.0f / 1024.0f) + 1e-6f);
        const float cs = rope[(r * 32 + i) * 2], sn = rope[(r * 32 + i) * 2 + 1];
        float q0, q1;
        { float x = C1[(size_t)r * 3072 + h * 128 + lane] * rs; const float ss = wave_sum(x * x); x = x * rsqrtf(ss * (1.0f / 64.0f) + 1e-6f) * qg[lane];
          const float pr = __shfl_xor(x, 32); q0 = (lane < 32 ? x * cs - pr * sn : x * cs + pr * sn) * pg8::QSCALE_; }
        { float x = C1[(size_t)r * 3072 + h * 128 + 64 + lane] * rs; const float ss = wave_sum(x * x); x = x * rsqrtf(ss * (1.0f / 64.0f) + 1e-6f) * qg[lane];
          const float pr = __shfl_xor(x, 32); q1 = (lane < 32 ? x * cs - pr * sn : x * cs + pr * sn) * pg8::QSCALE_; }
        float l0 = 0.f, l1 = 0.f, o0a = 0.f, o0b = 0.f, o1a = 0.f, o1b = 0.f;
#pragma unroll 4
        for (int rp = 0; rp <= r; ++rp) {
            const float s0 = wave_sum(q0 * kl[rp * 64 + lane]), s1 = wave_sum(q1 * kl[(16 + rp) * 64 + lane]);
            const float p0 = __builtin_amdgcn_exp2f(s0), p1 = __builtin_amdgcn_exp2f(s1); l0 += p0; l1 += p1;
            const float va = vl[rp * 128 + lane], vb = vl[rp * 128 + 64 + lane];
            o0a += p0 * va; o0b += p0 * vb; o1a += p1 * va; o1b += p1 * vb;
        }
        const float oa = o0a / l0 - lam * o1a / l1, ob = o0b / l0 - lam * o1b / l1;
        const float rn = rsqrtf(wave_sum(oa * oa + ob * ob) * (1.0f / 128.0f) + 1e-6f) * 0.8f;
        OM[(size_t)r * 1024 + h * 128 + lane] = (bf16)f2bf(oa * rn * subg[lane]); OM[(size_t)r * 1024 + h * 128 + 64 + lane] = (bf16)f2bf(ob * rn * subg[64 + lane]);
    }
    asm volatile("s_waitcnt lgkmcnt(0)" ::: "memory");
}
__device__ __forceinline__ void meta_e3(const Args& a, int gwp, int NGW, int lane) {
    unsigned char* ws = a.ws; const float* meta = a.in[1]; const float* C2 = (const float*)(ws + WS_MC2); float* H1 = (float*)(ws + WS_MH1);
    const float* C3 = (const float*)(ws + WS_MC3); bf16* HID = (bf16*)(ws + WS_MHID);
    for (int task = gwp; task < 16 * (DFF / 64); task += NGW) { const int r = task / (DFF / 64), ch = task - r * (DFF / 64); float s = 0.f; f32x4 v[4];
#pragma unroll
        for (int j = 0; j < 4; ++j) { v[j] = *((const f32x4*)(meta + (size_t)r * D) + 64 * j + lane) + *((const f32x4*)(C2 + (size_t)r * D) + 64 * j + lane); s += (v[j][0] * v[j][0] + v[j][1] * v[j][1]) + (v[j][2] * v[j][2] + v[j][3] * v[j][3]); }
        if (ch == 0) {
#pragma unroll
            for (int j = 0; j < 4; ++j) *((f32x4*)(H1 + (size_t)r * D) + 64 * j + lane) = v[j]; }
        const float rs = rsqrtf(wave_sum(s) * (1.0f / 1024.0f) + 1e-6f);
        const int j = 64 * ch + lane; const float g = C3[(size_t)r * NGU + j] * rs, u = C3[(size_t)r * NGU + DFF + j] * rs;
        HID[(size_t)r * DFF + j] = (bf16)f2bf(g * __builtin_amdgcn_rcpf(1.0f + __expf(-g)) * u); }
}
__device__ __forceinline__ void meta_e5(const Args& a, int gwp, int NGW, int lane) {
    unsigned char* ws = a.ws; const float* H1 = (const float*)(ws + WS_MH1); const float* C4 = (const float*)(ws + WS_MC4);
    const float* C5 = (const float*)(ws + WS_MC5); bf16* MZ = (bf16*)(ws + WS_MZ);
    for (int task = gwp; task < 16 * (D / 64); task += NGW) { const int r = task >> 4, ch = task & 15; float s = 0.f;
#pragma unroll
        for (int j = 0; j < 4; ++j) { const f32x4 v = *((const f32x4*)(H1 + (size_t)r * D) + 64 * j + lane) + *((const f32x4*)(C4 + (size_t)r * D) + 64 * j + lane); s += (v[0] * v[0] + v[1] * v[1]) + (v[2] * v[2] + v[3] * v[3]); }
        const float rs = rsqrtf(wave_sum(s) * (1.0f / 1024.0f) + 1e-6f);
        const int j = 64 * ch + lane;
        MZ[(size_t)r * D + j] = (bf16)f2bf((C5[(size_t)r * 2048 + j] * rs) * (C5[(size_t)r * 2048 + 1024 + j] * rs)); }
}
__device__ __forceinline__ void conv_phase(const Args& a, int lane, int gw, int NGW) {
    const bf16* Z = (const bf16*)(a.ws + WS_BIG); const bf16* GB = Z + (size_t)MP * D; bf16* Y = (bf16*)(a.ws + WS_O); const float* cw = a.in[14];
    for (int it = gw; it < (MP / 16) * 2; it += NGW) {
        const int rb = (MP / 16 - 1) - (it >> 1), col = (it & 1) * 512 + lane * 8, row0 = rb * 16, p0 = row0 % LP;
        float w0[8], w1[8], w2[8], zm2[8], zm1[8];
#pragma unroll
        for (int e = 0; e < 8; ++e) { w0[e] = cw[col + e]; w1[e] = cw[D + col + e]; w2[e] = cw[2 * D + col + e]; zm2[e] = 0.f; zm1[e] = 0.f; }
        { const bf16* MZ = (const bf16*)(a.ws + WS_MZ);
          const v4u a2 = *(const v4u*)(p0 != 0 ? Z + (size_t)(row0 - 2) * D + col : MZ + 14 * D + col), a1 = *(const v4u*)(p0 != 0 ? Z + (size_t)(row0 - 1) * D + col : MZ + 15 * D + col);
#pragma unroll
            for (int e = 0; e < 4; ++e) { zm2[2 * e] = __uint_as_float(a2[e] << 16); zm2[2 * e + 1] = __uint_as_float(a2[e] & 0xffff0000u); zm1[2 * e] = __uint_as_float(a1[e] << 16); zm1[2 * e + 1] = __uint_as_float(a1[e] & 0xffff0000u); } }
#pragma unroll 4
        for (int i = 0; i < 16; ++i) { const size_t off = (size_t)(row0 + i) * D + col; const v4u zz = *(const v4u*)(Z + off), gg = *(const v4u*)(GB + off);
            float z[8], g[8], y[8];
#pragma unroll
            for (int e = 0; e < 4; ++e) { z[2 * e] = __uint_as_float(zz[e] << 16); z[2 * e + 1] = __uint_as_float(zz[e] & 0xffff0000u); g[2 * e] = __uint_as_float(gg[e] << 16); g[2 * e + 1] = __uint_as_float(gg[e] & 0xffff0000u); }
#pragma unroll
            for (int e = 0; e < 8; ++e) { y[e] = g[e] * (w0[e] * zm2[e] + w1[e] * zm1[e] + w2[e] * z[e]); zm2[e] = zm1[e]; zm1[e] = z[e]; }
            v4u o; o.x = pk2(y[0], y[1]); o.y = pk2(y[2], y[3]); o.z = pk2(y[4], y[5]); o.w = pk2(y[6], y[7]);
            *(v4u*)(Y + off) = o; }
    }
}

__global__ void __launch_bounds__(NWAVES * 64, 2) mega_fwd(Args args) {
    extern __shared__ __attribute__((aligned(16))) unsigned char lds_raw[];
    LAS unsigned char* lds = (LAS unsigned char*)lds_raw;
    cg::grid_group grid = cg::this_grid();
    const int wave = __builtin_amdgcn_readfirstlane(threadIdx.x >> 6);
    const int G = gridDim.x, gw = blockIdx.x * NWAVES + wave, NGW = G * NWAVES, gwp = wave * G + (int)blockIdx.x;
    unsigned char* ws = args.ws;
    bf16* XB = (bf16*)(ws + WS_XB); float* SSP = (float*)(ws + WS_SSP); bf16* BIG = (bf16*)(ws + WS_BIG); bf16* OB = (bf16*)(ws + WS_O);
    const int lo = args.ph_lo, hi = args.ph_hi;
    if (threadIdx.x < 16) ((LAS unsigned*)(lds + MISC_OFF))[threadIdx.x] = 0u;
    __syncthreads();
    XcdBarrier bar = xcd_barrier_post((unsigned*)(ws + WS_CTL), (volatile LAS unsigned*)(lds + MISC_OFF));
#ifndef PHASE_MASK
#define PHASE_MASK 0x1fff
#endif
#define IN(k) (((PHASE_MASK >> (k)) & 1) && lo <= (k) && (k) < hi)
#define SEAM(k) do { if (IN(k) && IN((k) + 1)) { if ((k) == 0) grid.sync(); else xcd_barrier(bar); } } while (0)
    bf16* MXB = (bf16*)(ws + WS_MXB); const bf16* MQKV = (const bf16*)(ws + WS_MQKV);
    if (IN(0)) REPS(0) { prologue(args, lds, wave, pg8::lane_id_v(), gw, NGW); }
    SEAM(0);
    if (IN(1)) {
        skinny_gemm<0>(MXB, nullptr, nullptr, D, (const bf16*)(ws + WS_WQKV), 1, 0, NQKV / 16, (float*)(ws + WS_MC1), NQKV, gwp, NGW, pg8::lane_id_v());
    }
    SEAM(1);
    if (IN(2)) {
        if (gwp < 128) meta_e1(args, lds, wave, pg8::lane_id_v(), gwp & 7, 15 - (gwp >> 3));
        else weight_items(args, lds, wave, pg8::lane_id_v(), gwp - 128, NGW - 128, W_ITEMS_L0, W_ITEMS);
    }
    SEAM(2);
    if (IN(3)) REPS(3) {
        skinny_gemm<0>((const bf16*)(ws + WS_MOM), nullptr, nullptr, D, (const bf16*)(ws + WS_WO), 0, 0, D / 16, (float*)(ws + WS_MC2), D, gwp, NGW, pg8::lane_id_v());
        pg8::Gemm g{XB, (const bf16*)(ws + WS_WQKV), MP, NQKV, D}; pg8::StaticOrder S; S.init(MP, NQKV, G, (int)blockIdx.x);
        pg8::EpiQKV E{BIG, (const float*)(ws + WS_RS0), (const float*)(ws + WS_ROPE), args.in[5], args.in[6], lds + pg8::SSPL_OFF};
        pg8::gemm_phase<pg8::EpiQKV, pg8::StaticOrder, true, true>(lds, g, S, E, wave);
    }
    SEAM(3);
    if (IN(4)) REPS(4) {
        skinny_gemm<1>(nullptr, args.in[1], (const float*)(ws + WS_MC2), D, (const bf16*)(ws + WS_WGU0), 2, 0, NGU / 16, (float*)(ws + WS_MC3), NGU, gwp, NGW, pg8::lane_id_v());
        const int lane = pg8::lane_id_v();
        float s1 = wave_sum(args.in[7][lane] * args.in[8][lane]), s2 = wave_sum(args.in[9][lane] * args.in[10][lane]);
        const float lam = expf(s1) - expf(s2) + 0.2f;
        if (wave >= 4) __builtin_amdgcn_s_setprio(1);
        for (int bh = blockIdx.x; bh < NB * 8; bh += G) { const int b = bh >> 3, h = bh & 7;
#pragma unroll 1
            for (int j = 0; j < 8; ++j) att::attn_unit<WS_BIG, WS_MQKV, WS_O>(lds, ws, b, h, 64 + 256 * j, 8, lam, args.in[11], wave); }
        __builtin_amdgcn_s_setprio(0);
    }
    SEAM(4);
    if (IN(5)) {
        meta_e3(args, gwp, NGW, pg8::lane_id_v());
        pg8::Gemm g{OB, (const bf16*)(ws + WS_WO), MP, D, D}; pg8::StaticOrder S; S.init(MP, D, G, (int)blockIdx.x);
        pg8::EpiRes<1> E{nullptr, XB, SSP, nullptr};
        pg8::gemm_phase<pg8::EpiRes<1>, pg8::StaticOrder, true, true>(lds, g, S, E, wave);
    }
    SEAM(5);
    if (IN(6)) REPS(6) {
        skinny_gemm<0>((const bf16*)(ws + WS_MHID), nullptr, nullptr, DFF, (const bf16*)(ws + WS_WD0), 0, 0, D / 16, (float*)(ws + WS_MC4), D, gwp, NGW, pg8::lane_id_v());
        pg8::Gemm g{XB, (const bf16*)(ws + WS_WGU0), MP, NGU, D}; pg8::StaticOrder S; S.init(MP, NGU, G, (int)blockIdx.x);
        pg8::EpiGateUp E{BIG, SSP, lds + pg8::SSPL_OFF};
        pg8::gemm_phase<pg8::EpiGateUp, pg8::StaticOrder, true, true>(lds, g, S, E, wave);
    }
    SEAM(6);
    if (IN(7)) {
        skinny_gemm<1>(nullptr, (const float*)(ws + WS_MH1), (const float*)(ws + WS_MC4), D, (const bf16*)(ws + WS_WIN), 3, 1024, 2048 / 16, (float*)(ws + WS_MC5), 2048, gwp, NGW, pg8::lane_id_v());
        pg8::Gemm g{BIG, (const bf16*)(ws + WS_WD0), MP, D, DFF}; pg8::StaticOrder S; S.init(MP, D, G, (int)blockIdx.x, 1);
        pg8::EpiRes<1> E{nullptr, XB, SSP, nullptr};
        pg8::gemm_phase<pg8::EpiRes<1>, pg8::StaticOrder, true, true>(lds, g, S, E, wave);
    }
    SEAM(7);
    if (IN(8)) REPS(8) {
        meta_e5(args, gwp, NGW, pg8::lane_id_v());
        pg8::Gemm g{XB, (const bf16*)(ws + WS_WIN), MP, NQKV, D}; pg8::StaticOrder S; S.init(MP, NQKV, G, (int)blockIdx.x);
        pg8::EpiWin E{BIG, BIG + (size_t)MP * D, SSP, lds + pg8::SSPL_OFF};
        pg8::gemm_phase<pg8::EpiWin, pg8::StaticOrder, true, true>(lds, g, S, E, wave);
    }
    SEAM(8);
    if (IN(9)) REPS(9) { conv_phase(args, pg8::lane_id_v(), gw, NGW); }
    SEAM(9);
    if (IN(10)) {
        pg8::Gemm g{OB, (const bf16*)(ws + WS_WOUT), MP, D, D}; pg8::StaticOrder S; S.init(MP, D, G, (int)blockIdx.x);
        pg8::EpiRes<1> E{nullptr, XB, SSP, nullptr};
        pg8::gemm_phase<pg8::EpiRes<1>, pg8::StaticOrder, true, true>(lds, g, S, E, wave);
    }
    SEAM(10);
    if (IN(11)) REPS(11) {
        pg8::Gemm g{XB, (const bf16*)(ws + WS_WGU1), MP, NGU, D}; pg8::StaticOrder S; S.init(MP, NGU, G, (int)blockIdx.x);
        pg8::EpiGateUp E{BIG, SSP, lds + pg8::SSPL_OFF};
        pg8::gemm_phase<pg8::EpiGateUp, pg8::StaticOrder, true, true>(lds, g, S, E, wave);
    }
    SEAM(11);
    if (IN(12)) {
        pg8::Gemm g{BIG, (const bf16*)(ws + WS_WD1), MP, D, DFF}; pg8::StaticOrder S; S.init(MP, D, G, (int)blockIdx.x, 1);
        pg8::EpiRes<2> E{nullptr, XB, nullptr, args.out};
        pg8::gemm_phase<pg8::EpiRes<2>, pg8::StaticOrder, true, true>(lds, g, S, E, wave);
    }
#undef IN
#undef SEAM
}

extern "C" void kernel_launch(void* const* d_in, const int* in_sizes, int n_in, void* d_out, int out_size, void* d_ws, size_t ws_size, hipStream_t stream) {
    static int grid = 0;
    if (grid == 0) {
        if (n_in != 18 || ws_size < WS_END) { fprintf(stderr, "kernel_launch: need 18 inputs and %zu bytes of workspace (got %d, %zu)\n", (size_t)WS_END, n_in, ws_size); grid = -1; return; }
        int dev = 0, cus = 0, per_cu = 0;
        hipGetDevice(&dev); hipDeviceGetAttribute(&cus, hipDeviceAttributeMultiprocessorCount, dev);
        if (hipFuncSetAttribute((const void*)mega_fwd, hipFuncAttributeMaxDynamicSharedMemorySize, LDS_BYTES) != hipSuccess) { fprintf(stderr, "kernel_launch: hipFuncSetAttribute failed\n"); grid = -1; return; }
        if (hipOccupancyMaxActiveBlocksPerMultiprocessor(&per_cu, (const void*)mega_fwd, NWAVES * 64, LDS_BYTES) != hipSuccess || per_cu < 1) { fprintf(stderr, "kernel_launch: occupancy query says %d\n", per_cu); per_cu = 1; }
        (void)hipGetLastError();
        grid = cus * per_cu;
    }
    if (grid < 0) return;
    Args a{};
    for (int i = 0; i < 18; ++i) a.in[i] = (const float*)d_in[i];
    a.out = (float*)d_out; a.ws = (unsigned char*)d_ws;
#if MK_PER_PHASE
    for (int p = 0; p < NPHASE; ++p) { a.ph_lo = p; a.ph_hi = p + 1; hipLaunchKernelGGL(mega_fwd, dim3(grid), dim3(NWAVES * 64), LDS_BYTES, stream, a); }
#else
    a.ph_lo = 0; a.ph_hi = NPHASE;
    if (hipMemsetAsync((char*)d_ws + WS_CTL, 0, CTL_BYTES, stream) != hipSuccess) { fprintf(stderr, "kernel_launch: memset failed\n"); return; }
    void* kargs[] = {&a};
    hipError_t e = hipLaunchCooperativeKernel((const void*)mega_fwd, dim3(grid), dim3(NWAVES * 64), kargs, LDS_BYTES, stream);
    if (e != hipSuccess) fprintf(stderr, "kernel_launch: cooperative launch failed: %s (grid %d)\n", hipGetErrorString(e), grid);
#endif
}
```
